# Optimizing an MI355X kernel written in HIP

```python
import math
import jax, jax.numpy as jnp
from jax import lax
import numpy as np

D_MODEL = 2048
BATCH = 4
SEQ = 2048
DEPTH = 2

HEAD_DIM = 128
N_HEADS_TOTAL = D_MODEL // HEAD_DIM
MIX_WIDTH = N_HEADS_TOTAL * HEAD_DIM
N_HEADS_A = (3 * N_HEADS_TOTAL) // 8
N_HEADS_B = N_HEADS_TOTAL // 4
N_HEADS_C = N_HEADS_TOTAL - N_HEADS_A - N_HEADS_B
DIFF_QK_DIM = HEAD_DIM // 2
PROJ_WIDTH = 3 * MIX_WIDTH
DILATED_PATTERNS = ((128, 1), (512, 4), (2048, 16))
DILATED_BLOCK = 128
BLOCK = 128
D_FF = 4 * D_MODEL
NUM_BUCKETS = 32
MAX_DISTANCE = 2048
EPS = 1e-6
NEG_INF = -1e30

kernel_name = "hybrid_dilated_diff_stickbreaking_block"


def rmsnorm(x, g):
    xf = x.astype(jnp.float32)
    y = xf * lax.rsqrt(jnp.mean(xf * xf, axis=-1, keepdims=True) + EPS)
    return y.astype(x.dtype) * g


def t5_bucket(dist):
    n = jnp.maximum(dist, 0)
    max_exact = NUM_BUCKETS // 2
    nf = jnp.maximum(n, max_exact).astype(jnp.float32)
    large = max_exact + (jnp.log(nf / max_exact) / math.log(MAX_DISTANCE / max_exact)
                         * (NUM_BUCKETS - max_exact)).astype(jnp.int32)
    large = jnp.minimum(large, NUM_BUCKETS - 1)
    return jnp.where(n < max_exact, n, large)


def dilated_pattern(q, k, v, table, window, dil):
    B, S, H, D = q.shape
    L = S // dil
    nk = window // dil
    blk = DILATED_BLOCK
    nb = -(-L // blk)
    Lp = nb * blk
    scale = 1.0 / math.sqrt(D)

    def to_strided(t):
        t = jnp.swapaxes(t.reshape(B, L, dil, H, D), 1, 2)
        return jnp.pad(t, ((0, 0), (0, 0), (0, Lp - L), (0, 0), (0, 0)))

    def band(t):
        ts = jnp.pad(to_strided(t), ((0, 0), (0, 0), (blk, 0), (0, 0), (0, 0)))
        ts = ts.reshape(B, dil, nb + 1, blk, H, D)
        return jnp.concatenate([ts[:, :, :-1], ts[:, :, 1:]], axis=3)

    qs = to_strided(q).reshape(B, dil, nb, blk, H, D)
    kb, vb = band(k), band(v)
    i = jnp.arange(blk)[:, None]
    c = jnp.arange(2 * blk)[None, :]
    steps = i + blk - c
    bidx = jnp.arange(nb)[:, None, None]
    valid = (steps >= 0) & (steps <= nk) & (bidx * blk + c - blk >= 0)
    bias = jnp.moveaxis(table[t5_bucket(steps * dil)], -1, 0).astype(jnp.float32)
    logits = jnp.einsum('brnihd,brnchd->brnhic', qs, kb).astype(jnp.float32) * scale + bias
    logits = jnp.where(valid[:, None], logits, NEG_INF)
    lse = jax.nn.logsumexp(logits, axis=-1)
    p = jnp.exp(logits - lse[..., None])
    out = jnp.einsum('brnhic,brnchd->brnihd', p.astype(v.dtype), vb)

    def from_strided(y):
        y = jnp.swapaxes(y[:, :, :L], 1, 2)
        return y.reshape((B, S) + y.shape[3:])

    out = from_strided(out.reshape(B, dil, Lp, H, D))
    lse = from_strided(jnp.swapaxes(lse, 3, 4).reshape(B, dil, Lp, H))
    return out, lse


def dilated_attention(q, k, v, table):
    outs, lses = [], []
    for window, dil in DILATED_PATTERNS:
        o, l = dilated_pattern(q, k, v, table, window, dil)
        outs.append(o)
        lses.append(l)
    w = jax.nn.softmax(jnp.stack(lses), axis=0)
    return jnp.einsum('pbsh,pbshd->bshd', w.astype(q.dtype), jnp.stack(outs))


def diff_attention(q, k, v, table, lam, lam_init, g):
    B, S, H, _, Dq = q.shape
    nb = S // BLOCK
    scale = 1.0 / math.sqrt(Dq)
    qblocks = jnp.moveaxis(q.reshape(B, nb, BLOCK, H, 2, Dq), 1, 0)
    s_pos = jnp.arange(S)

    def one(args):
        qi, bi = args
        t = bi * BLOCK + jnp.arange(BLOCK)
        dist = t[:, None] - s_pos[None, :]
        bias = jnp.moveaxis(table[t5_bucket(dist)], -1, 0).astype(jnp.float32)
        logits = jnp.einsum('bihpd,bshpd->bphis', qi, k).astype(jnp.float32) * scale + bias
        logits = jnp.where(dist >= 0, logits, NEG_INF)
        p = jax.nn.softmax(logits, axis=-1)
        a = p[:, 0] - lam * p[:, 1]
        return jnp.einsum('bhis,bshd->bihd', a.astype(v.dtype), v)

    out = lax.map(one, (qblocks, jnp.arange(nb)))
    out = jnp.moveaxis(out, 0, 1).reshape(B, S, H, v.shape[-1])
    return rmsnorm(out, g) * (1.0 - lam_init)


def stick_breaking_attention(q, k, v):
    B, S, H, D = q.shape
    nb = S // BLOCK
    scale = 1.0 / math.sqrt(D)
    qblocks = jnp.moveaxis(q.reshape(B, nb, BLOCK, H, D), 1, 0)
    s_pos = jnp.arange(S)

    def one(args):
        qi, bi = args
        t = bi * BLOCK + jnp.arange(BLOCK)
        mask = s_pos[None, :] < t[:, None]
        z = jnp.einsum('bihd,bshd->bhis', qi, k).astype(jnp.float32) * scale
        u = jnp.where(mask, jax.nn.log_sigmoid(-z), 0.0)
        r = lax.cumsum(u, axis=3, reverse=True) - u
        a = jnp.where(mask, jnp.exp(jax.nn.log_sigmoid(z) + r), 0.0)
        return jnp.einsum('bhis,bshd->bihd', a.astype(v.dtype), v)

    out = lax.map(one, (qblocks, jnp.arange(nb)))
    return jnp.moveaxis(out, 0, 1).reshape(B, S, H, D)


def setup_inputs(seed: int = 0) -> dict:
    key = jax.random.key(seed)
    ks = jax.random.split(key, 16)
    f32 = jnp.float32
    return {
        "x": jax.random.normal(ks[0], (BATCH, SEQ, D_MODEL), f32),
        "w_in": jax.random.normal(ks[1], (DEPTH, D_MODEL, PROJ_WIDTH), f32) * D_MODEL ** -0.5,
        "w_out": jax.random.normal(ks[2], (DEPTH, MIX_WIDTH, D_MODEL), f32) * MIX_WIDTH ** -0.5,
        "g_attn": 1.0 + 0.02 * jax.random.normal(ks[3], (DEPTH, D_MODEL), f32),
        "g_mlp": 1.0 + 0.02 * jax.random.normal(ks[4], (DEPTH, D_MODEL), f32),
        "w_mlp_in": jax.random.normal(ks[5], (DEPTH, D_MODEL, D_FF), f32) * D_MODEL ** -0.5,
        "w_mlp_out": jax.random.normal(ks[6], (DEPTH, D_FF, D_MODEL), f32) * D_FF ** -0.5,
        "rel_bias_table": 0.5 * jax.random.normal(ks[7], (NUM_BUCKETS, N_HEADS_A + N_HEADS_B), f32),
        "diff_lam_q1": 0.1 * jax.random.normal(ks[8], (DEPTH, DIFF_QK_DIM), f32),
        "diff_lam_k1": 0.1 * jax.random.normal(ks[9], (DEPTH, DIFF_QK_DIM), f32),
        "diff_lam_q2": 0.1 * jax.random.normal(ks[10], (DEPTH, DIFF_QK_DIM), f32),
        "diff_lam_k2": 0.1 * jax.random.normal(ks[11], (DEPTH, DIFF_QK_DIM), f32),
        "diff_subln_g": 1.0 + 0.02 * jax.random.normal(ks[12], (DEPTH, HEAD_DIM), f32),
        "g_final": 1.0 + 0.02 * jax.random.normal(ks[13], (D_MODEL,), f32),
    }


def reference(x, w_in, w_out, g_attn, g_mlp, w_mlp_in, w_mlp_out, rel_bias_table,
              diff_lam_q1, diff_lam_k1, diff_lam_q2, diff_lam_k2, diff_subln_g, g_final):
    B, S, _ = x.shape
    table_a = rel_bias_table[:, :N_HEADS_A]
    table_b = rel_bias_table[:, N_HEADS_A:]
    split_a = 3 * N_HEADS_A * HEAD_DIM
    split_b = split_a + 3 * N_HEADS_B * HEAD_DIM
    for l in range(DEPTH):
        h = rmsnorm(x, g_attn[l])
        proj = h @ w_in[l]
        part_a, part_b, part_c = jnp.split(proj, [split_a, split_b], axis=-1)
        qa, ka, va = [t.reshape(B, S, N_HEADS_A, HEAD_DIM) for t in jnp.split(part_a, 3, axis=-1)]
        qb, kb, vb = jnp.split(part_b, 3, axis=-1)
        qb = qb.reshape(B, S, N_HEADS_B, 2, DIFF_QK_DIM)
        kb = kb.reshape(B, S, N_HEADS_B, 2, DIFF_QK_DIM)
        vb = vb.reshape(B, S, N_HEADS_B, HEAD_DIM)
        qc, kc, vc = [t.reshape(B, S, N_HEADS_C, HEAD_DIM) for t in jnp.split(part_c, 3, axis=-1)]

        lam_init = 0.8 - 0.6 * math.exp(-0.3 * l)
        lam = (jnp.exp(jnp.sum(diff_lam_q1[l].astype(jnp.float32) * diff_lam_k1[l].astype(jnp.float32)))
               - jnp.exp(jnp.sum(diff_lam_q2[l].astype(jnp.float32) * diff_lam_k2[l].astype(jnp.float32)))
               + lam_init)

        out_a = dilated_attention(qa, ka, va, table_a)
        out_b = diff_attention(qb, kb, vb, table_b, lam, lam_init, diff_subln_g[l])
        out_c = stick_breaking_attention(qc, kc, vc)
        mixed = jnp.concatenate([out_a.reshape(B, S, -1), out_b.reshape(B, S, -1),
                                 out_c.reshape(B, S, -1)], axis=-1)
        x = x + mixed @ w_out[l]
        h = rmsnorm(x, g_mlp[l])
        x = x + jnp.square(jax.nn.relu(h @ w_mlp_in[l])) @ w_mlp_out[l]
    return rmsnorm(x, g_final)
```

```cpp
#include <hip/hip_runtime.h>
#include <cstdio>
#include <cstdint>
#include <cmath>
namespace pg8 {
#define PG8_LAS __attribute__((address_space(3)))
typedef unsigned short bf16_t;
typedef short bf16x8 __attribute__((ext_vector_type(8)));
typedef float f32x4 __attribute__((ext_vector_type(4)));
typedef unsigned u32x4 __attribute__((ext_vector_type(4)));
constexpr int BM = 256, BK = 64, HALF = 128, HTB = HALF * BK * 2  , STAGE_BYTES = 8 * HTB, NXCD = 8, WGM = 8;

__host__ __device__ __forceinline__ int lds_byte(int r, int c) { const int st = (r >> 4) * 2 + (c >> 5), rr = r & 15, cc = c & 31, ob = rr * 64 + cc * 2; return st * 1024 + (ob ^ (((ob >> 9) & 1) << 5)); }
__host__ __device__ __forceinline__ void stage_rc(int b, int& R, int& C) { const int st = b / 1024, sb = b % 1024, swz = sb ^ (((sb >> 9) & 1) << 5); R = (st >> 1) * 16 + swz / 64; C = (st & 1) * 32 + (swz % 64) / 2; }
__host__ __device__ __forceinline__ int perm32(int rho) { const int n = rho >> 4, i = rho & 15; return 8 * (i >> 2) + 4 * n + (i & 3); }

struct Unit { int pm, pn; };
struct Gemm { const bf16_t* A; const bf16_t* Bt; int M, N, K; };

struct StaticOrder {
    int nM, nN, nwg, G, c;
    __host__ __device__ void init(int M, int N, int G_, int c_) { nM = M / BM; nN = N / BM; nwg = nM * nN; G = G_; c = c_; }
    __host__ __device__ bool next(int i, Unit& u) const {
        const long L = (long)i * G + c; if (L >= nwg) return false;
        int wgid = (int)L; { const int q = nwg / NXCD, r = nwg % NXCD, xcd = wgid % NXCD, off = wgid / NXCD; wgid = (xcd < r ? xcd * (q + 1) : r * (q + 1) + (xcd - r) * q) + off; }
        const int nig = WGM * nN, gid = wgid / nig, fm = gid * WGM, gsz = (nM - fm) < WGM ? (nM - fm) : WGM;
        u.pm = fm + ((wgid % nig) % gsz); u.pn = (wgid % nig) / gsz; return true;
    }
    __device__ __forceinline__ void a_ready(const Unit&) const {}
    __device__ __forceinline__ void done(const Unit&) const {}
};

__device__ __forceinline__ unsigned cvt_pk_bf16(float lo, float hi) { unsigned r; asm volatile("v_cvt_pk_bf16_f32 %0, %1, %2" : "=v"(r) : "v"(lo), "v"(hi)); return r; }
typedef float f32x2 __attribute__((ext_vector_type(2)));

struct EpiAny {
    static constexpr bool AFTER_DRAIN = false;
    int mode; bool perm; bf16_t* O; const float* base; float* out; int ldc;
    __device__ __forceinline__ void operator()(const f32x4 (&acc)[2][2][4][2], const Unit& u, int wr, int wc, int fr, int fq) const {
        if (mode != 2) {
            const int row0 = u.pm * BM + wr * 64 + fr; const int col0 = u.pn * BM + wc * 32 + 8 * fq;
#pragma unroll
            for (int ai = 0; ai < 2; ++ai)
#pragma unroll
                for (int m = 0; m < 4; ++m) { bf16_t* rowp = O + (size_t)(row0 + ai * HALF + m * 16) * ldc + col0;
#pragma unroll
                    for (int bj = 0; bj < 2; ++bj) { f32x4 v0 = acc[ai][bj][m][0], v1 = acc[ai][bj][m][1];
                        if (mode == 1) {
#pragma unroll
                            for (int e = 0; e < 4; ++e) { const float a = v0[e] > 0.f ? v0[e] : 0.f, b = v1[e] > 0.f ? v1[e] : 0.f; v0[e] = a * a; v1[e] = b * b; } }
                        u32x4 w; w.x = cvt_pk_bf16(v0[0], v0[1]); w.y = cvt_pk_bf16(v0[2], v0[3]); w.z = cvt_pk_bf16(v1[0], v1[1]); w.w = cvt_pk_bf16(v1[2], v1[3]);
                        *(u32x4*)(rowp + bj * HALF) = w; } }
        } else {
            const int col0 = u.pn * BM + wc * 32 + 4 * fq;
#pragma unroll
            for (int ai = 0; ai < 2; ++ai)
#pragma unroll
                for (int m = 0; m < 4; ++m) { const size_t off = (size_t)(u.pm * BM + ai * HALF + wr * 64 + m * 16 + fr) * ldc + col0;
                    f32x4 bs[2][2];
#pragma unroll
                    for (int bj = 0; bj < 2; ++bj)
#pragma unroll
                        for (int n = 0; n < 2; ++n) bs[bj][n] = *(const f32x4*)(base + off + bj * HALF + n * 16);
#pragma unroll
                    for (int bj = 0; bj < 2; ++bj)
#pragma unroll
                        for (int n = 0; n < 2; ++n) *(f32x4*)(out + off + bj * HALF + n * 16) = bs[bj][n] + acc[ai][bj][m][n];
                    asm volatile("" ::: "memory"); }
        }
    }
};

template <class Epi, class Sched, bool ALIGN_EPI = false, bool SP2 = false>
__device__ __forceinline__ void gemm_phase(PG8_LAS unsigned char* lds, const Gemm g, const Sched& S, const Epi& E) {
    int tid = threadIdx.x; asm volatile("" : "+v"(tid));
    const int wid = __builtin_amdgcn_readfirstlane(tid >> 6), lane = tid & 63, wr = wid >> 2, wc = wid & 3, fr = lane & 15, fq = lane >> 4;
    const int K = g.K, nt = K / BK;
    unsigned voffA[2], voffB[2];
#pragma unroll
    for (int i = 0; i < 2; ++i) { int R, C; stage_rc(tid * 16 + i * 8192, R, C); const int Rb = E.perm ? ((R & ~31) + perm32(R & 31)) : R;
        voffA[i] = (unsigned)(R * K + C) * 2u; voffB[i] = (unsigned)(Rb * K + C) * 2u; }
    const size_t kstep = (size_t)(BK * 2);
    const size_t hstep = (size_t)HALF * K * 2;
    const size_t tstep = 2 * hstep;
    const unsigned ldsw = (unsigned)wid * 1024u;
    const int aoff = lds_byte(wr * 64 + fr, fq * 8), boff = lds_byte(wc * 32 + fr, fq * 8);
#define PG8_SA(b, h) (((b) * 2 + (h)) * HTB)
#define PG8_SB(b, h) ((4 + (b) * 2 + (h)) * HTB)
#define PG8_STAGE(bufoff, gbase, voff) do { _Pragma("unroll") for (int _i = 0; _i < 2; ++_i) \
        __builtin_amdgcn_global_load_lds((const unsigned*)((const char*)(gbase) + (voff)[_i]), (PG8_LAS unsigned*)(lds + (bufoff) + ldsw + _i * 8192), 16, 0, 0); } while (0)
#define PG8_LDA(dst, b, h) do { _Pragma("unroll") for (int m = 0; m < 4; ++m) _Pragma("unroll") for (int k = 0; k < 2; ++k) dst[m][k] = *(const PG8_LAS bf16x8*)(lds + PG8_SA(b, h) + aoff + m * 2048 + k * 1024); } while (0)
#define PG8_LDB(dst, b, h) do { _Pragma("unroll") for (int n = 0; n < 2; ++n) _Pragma("unroll") for (int k = 0; k < 2; ++k) dst[n][k] = *(const PG8_LAS bf16x8*)(lds + PG8_SB(b, h) + boff + n * 2048 + k * 1024); } while (0)
#define PG8_MMA(ai, bj, At, Bt) do { __builtin_amdgcn_s_setprio(1); _Pragma("unroll") for (int m = 0; m < 4; ++m) _Pragma("unroll") for (int n = 0; n < 2; ++n) _Pragma("unroll") for (int k = 0; k < 2; ++k) \
        acc[ai][bj][m][n] = __builtin_amdgcn_mfma_f32_16x16x32_bf16(Bt[n][k], At[m][k], acc[ai][bj][m][n], 0, 0, 0); __builtin_amdgcn_s_setprio(0); } while (0)
#define PG8_WAIT_V(n) asm volatile("s_waitcnt vmcnt(" #n ")" ::: "memory")
#define PG8_WAIT_L(n) asm volatile("s_waitcnt lgkmcnt(" #n ")" ::: "memory")
#define PG8_BAR __builtin_amdgcn_s_barrier()
#define PG8_SCHED __builtin_amdgcn_sched_barrier(0)
    Unit cur, nxt; int ui = 0;
    if (!S.next(0, cur)) return;
    f32x4 acc[2][2][4][2];
#pragma unroll
    for (int a = 0; a < 2; ++a)
#pragma unroll
        for (int b = 0; b < 2; ++b)
#pragma unroll
            for (int m = 0; m < 4; ++m)
#pragma unroll
                for (int n = 0; n < 2; ++n) acc[a][b][m][n] = (f32x4){0.f, 0.f, 0.f, 0.f};
    bf16x8 At[4][2], B0[2][2], B1[2][2];
    const char* cA = (const char*)g.A + (size_t)cur.pm * tstep; const char* cB = (const char*)g.Bt + (size_t)cur.pn * tstep;
    S.a_ready(cur);
    if constexpr (SP2) {
        PG8_STAGE(PG8_SB(0, 0), cB, voffB); PG8_STAGE(PG8_SB(0, 1), cB + hstep, voffB); PG8_STAGE(PG8_SA(0, 0), cA, voffA); PG8_STAGE(PG8_SA(0, 1), cA + hstep, voffA);
        if (wr == 1) PG8_BAR;
        PG8_WAIT_V(2); PG8_BAR;
        PG8_STAGE(PG8_SB(1, 0), cB + kstep, voffB); PG8_STAGE(PG8_SA(1, 0), cA + kstep, voffA); PG8_STAGE(PG8_SB(1, 1), cB + hstep + kstep, voffB);
        PG8_WAIT_V(6); PG8_BAR;
    } else {
        PG8_STAGE(PG8_SB(0, 0), cB, voffB); PG8_STAGE(PG8_SA(0, 0), cA, voffA); PG8_STAGE(PG8_SB(0, 1), cB + hstep, voffB); PG8_STAGE(PG8_SA(0, 1), cA + hstep, voffA);
        if (wr == 1) PG8_BAR;
        PG8_WAIT_V(4); PG8_BAR;
        PG8_STAGE(PG8_SB(1, 0), cB + kstep, voffB); PG8_STAGE(PG8_SA(1, 0), cA + kstep, voffA); PG8_STAGE(PG8_SB(1, 1), cB + hstep + kstep, voffB);
        PG8_WAIT_V(6); PG8_BAR;
    }
    for (;;) {
        const bool has_next = S.next(ui + 1, nxt);
        const char* nA = has_next ? (const char*)g.A + (size_t)nxt.pm * tstep : cA; const char* nB = has_next ? (const char*)g.Bt + (size_t)nxt.pn * tstep : cB;
        for (int t = 0; t < nt; t += 2) {
            const bool last = (t == nt - 2);
            const char* a1 = cA + (size_t)(t + 1) * kstep;
            const char* a2 = last ? nA : cA + (size_t)(t + 2) * kstep; const char* b2 = last ? nB : cB + (size_t)(t + 2) * kstep;
            const char* a3 = a2 + kstep; const char* b3 = b2 + kstep;
            if (last && has_next) S.a_ready(nxt);
            if constexpr (SP2) {
            PG8_LDB(B0, 0, 0); PG8_LDB(B1, 0, 1); PG8_SCHED; PG8_LDA(At, 0, 0); PG8_STAGE(PG8_SA(1, 1), a1 + hstep, voffA);
            PG8_WAIT_V(8); PG8_WAIT_L(0); PG8_BAR; PG8_MMA(0, 0, At, B0); PG8_MMA(0, 1, At, B1); PG8_BAR; PG8_SCHED;
            PG8_LDA(At, 0, 1); PG8_STAGE(PG8_SB(0, 0), b2, voffB); PG8_STAGE(PG8_SB(0, 1), b2 + hstep, voffB); PG8_STAGE(PG8_SA(0, 0), a2, voffA);
            PG8_WAIT_V(8); PG8_WAIT_L(0); PG8_BAR; PG8_MMA(1, 0, At, B0); PG8_MMA(1, 1, At, B1); PG8_BAR; PG8_SCHED;
            PG8_LDB(B0, 1, 0); PG8_LDB(B1, 1, 1); PG8_SCHED; PG8_LDA(At, 1, 0); PG8_STAGE(PG8_SA(0, 1), a2 + hstep, voffA);
            PG8_WAIT_V(8); PG8_WAIT_L(0); PG8_BAR; PG8_MMA(0, 0, At, B0); PG8_MMA(0, 1, At, B1); PG8_BAR; PG8_SCHED;
            PG8_LDA(At, 1, 1); PG8_STAGE(PG8_SB(1, 0), b3, voffB); PG8_STAGE(PG8_SB(1, 1), b3 + hstep, voffB); PG8_STAGE(PG8_SA(1, 0), a3, voffA);
            PG8_WAIT_V(8); PG8_WAIT_L(0); PG8_BAR; PG8_MMA(1, 0, At, B0); PG8_MMA(1, 1, At, B1); PG8_BAR; PG8_SCHED;
            } else {
            PG8_LDB(B0, 0, 0); PG8_SCHED; PG8_LDA(At, 0, 0); PG8_STAGE(PG8_SA(1, 1), a1 + hstep, voffA);
            PG8_WAIT_L(8); PG8_BAR; PG8_WAIT_L(0); PG8_MMA(0, 0, At, B0); PG8_BAR; PG8_SCHED;
            PG8_LDB(B1, 0, 1); PG8_STAGE(PG8_SB(0, 0), b2, voffB);
            PG8_BAR; PG8_WAIT_L(0); PG8_MMA(0, 1, At, B1); PG8_BAR;
            PG8_LDA(At, 0, 1); PG8_STAGE(PG8_SA(0, 0), a2, voffA);
            PG8_BAR; PG8_WAIT_L(0); PG8_MMA(1, 0, At, B0); PG8_BAR; PG8_SCHED;
            PG8_STAGE(PG8_SB(0, 1), b2 + hstep, voffB);
            PG8_WAIT_V(6); PG8_BAR; PG8_MMA(1, 1, At, B1); PG8_BAR;
            PG8_LDB(B0, 1, 0); PG8_SCHED; PG8_LDA(At, 1, 0); PG8_STAGE(PG8_SA(0, 1), a2 + hstep, voffA);
            PG8_WAIT_L(8); PG8_BAR; PG8_WAIT_L(0); PG8_MMA(0, 0, At, B0); PG8_BAR; PG8_SCHED;
            PG8_LDB(B1, 1, 1); PG8_STAGE(PG8_SB(1, 0), b3, voffB);
            PG8_BAR; PG8_WAIT_L(0); PG8_MMA(0, 1, At, B1); PG8_BAR;
            PG8_LDA(At, 1, 1); PG8_STAGE(PG8_SA(1, 0), a3, voffA);
            PG8_BAR; PG8_WAIT_L(0); PG8_MMA(1, 0, At, B0); PG8_BAR; PG8_SCHED;
            PG8_STAGE(PG8_SB(1, 1), b3 + hstep, voffB);
            PG8_WAIT_V(6); PG8_BAR; PG8_MMA(1, 1, At, B1); PG8_BAR;
            }
        }
        if constexpr (ALIGN_EPI) { if (wr == 0) PG8_BAR; }
        if constexpr (!Epi::AFTER_DRAIN) { E(acc, cur, wr, wc, fr, fq); S.done(cur); }
        if (!has_next) break;
#pragma unroll
        for (int a = 0; a < 2; ++a)
#pragma unroll
            for (int b = 0; b < 2; ++b)
#pragma unroll
                for (int m = 0; m < 4; ++m)
#pragma unroll
                    for (int n = 0; n < 2; ++n) acc[a][b][m][n] = (f32x4){0.f, 0.f, 0.f, 0.f};
        cur = nxt; cA = nA; cB = nB; ++ui;
        if constexpr (ALIGN_EPI) { if (wr == 1) PG8_BAR; }
    }
    PG8_WAIT_V(0);
    if constexpr (!ALIGN_EPI) { if (wr == 0) PG8_BAR; }
    PG8_BAR;
    if constexpr (Epi::AFTER_DRAIN) { E.fused(acc, cur, wr, wc, fr, fq, lds, wid, lane); S.done(cur); }
#undef PG8_SA
#undef PG8_SB
#undef PG8_STAGE
#undef PG8_LDA
#undef PG8_LDB
#undef PG8_MMA
#undef PG8_WAIT_V
#undef PG8_WAIT_L
#undef PG8_BAR
#undef PG8_SCHED
}
}
#define GAS __attribute__((address_space(1)))
#define LAS __attribute__((address_space(3)))
typedef unsigned short bf16;
typedef unsigned v4u __attribute__((ext_vector_type(4)));
typedef float f32x4 __attribute__((ext_vector_type(4)));
typedef short bf16x8 __attribute__((ext_vector_type(8)));
typedef GAS unsigned gu32;
typedef GAS unsigned long long gu64;
#define RLX_AGENT __ATOMIC_RELAXED, __HIP_MEMORY_SCOPE_AGENT
#define LDS_WAIT() asm volatile("s_waitcnt lgkmcnt(0)" ::: "memory")
#define VM_WAIT() asm volatile("s_waitcnt vmcnt(0)" ::: "memory")
__device__ __forceinline__ unsigned long long rt() { return __builtin_amdgcn_s_memrealtime(); }
__device__ __forceinline__ unsigned f2bf(float f) { unsigned u = __builtin_bit_cast(unsigned, f); return (u + 0x7fffu + ((u >> 16) & 1u)) >> 16; }
__device__ __forceinline__ unsigned pk2(float lo, float hi) { return f2bf(lo) | (f2bf(hi) << 16); }
#define XB_TMO      128
#define XB_XCNT(j)  (256  + 64 * (j))
#define XB_XSUB(j)  (1280 + 64 * (j))
#define XB_XGEN(j)  (2304 + 64 * (j))
#define XB_TOP      3328
#define XB_TOPGEN   3392
#define XCD_BAR_WORDS 3456
#define XB_SPIN_CAP (1u << 18)

__device__ __forceinline__ unsigned xb_ld(unsigned* p)              { return __hip_atomic_load(p, __ATOMIC_RELAXED, __HIP_MEMORY_SCOPE_AGENT); }
__device__ __forceinline__ unsigned xb_add(unsigned* p, unsigned v) { return __hip_atomic_fetch_add(p, v, __ATOMIC_RELAXED, __HIP_MEMORY_SCOPE_AGENT); }
__device__ __forceinline__ unsigned xb_xcc_id() { return (unsigned)__builtin_amdgcn_s_getreg((3 << 11) | 20) & 0xFu; }
#define XB_SPIN(cond, bar) do { unsigned _sp = 0; while (cond) { __builtin_amdgcn_s_sleep(1); \
    if ((++_sp & 255u) == 0u) { if (xb_ld(&(bar)[XB_TMO])) break; if (_sp > XB_SPIN_CAP) { atomicAdd(&(bar)[XB_TMO], 1u); break; } } } } while (0)

struct XcdBarrier {
    unsigned* bar; unsigned x;
    volatile LAS unsigned* st;
};

__device__ __forceinline__ XcdBarrier xcd_barrier_post(unsigned* bar, volatile LAS unsigned* st) {
    XcdBarrier b; b.bar = bar; b.x = xb_xcc_id(); b.st = st;
    if (threadIdx.x == 0) (void)xb_add(&bar[XB_XCNT(b.x)], 1u);
    return b;
}
__device__ __forceinline__ void xcd_barrier_complete(unsigned* bar, unsigned x, unsigned& nloc, unsigned& nx) {
    const unsigned G = gridDim.x * gridDim.y * gridDim.z;
    unsigned sum, cnt, mine, sp = 0u;
    for (;;) {
        sum = 0u; cnt = 0u; mine = 0u;
#pragma unroll
        for (unsigned j = 0; j < 16; ++j) { const unsigned c = xb_ld(&bar[XB_XCNT(j)]); sum += c; cnt += (c > 0u) ? 1u : 0u; mine = (j == x) ? c : mine; }
        if (sum == G) break;
        __builtin_amdgcn_s_sleep(1);
        if ((++sp & 255u) == 0u) { if (xb_ld(&bar[XB_TMO])) break; if (sp > XB_SPIN_CAP) { atomicAdd(&bar[XB_TMO], 1u); break; } }
    }
    nloc = mine > 0u ? mine : 1u; nx = cnt > 0u ? cnt : 1u;
}

__device__ __forceinline__ void xcd_barrier(const XcdBarrier& b) {
    asm volatile("s_waitcnt vmcnt(0)" ::: "memory");
    __syncthreads();
    if (threadIdx.x == 0) {
        unsigned* bar = b.bar;
        __builtin_amdgcn_s_waitcnt(0);
        unsigned nloc = b.st[0], nx = b.st[1];
        if (nloc == 0u) { xcd_barrier_complete(bar, b.x, nloc, nx); b.st[0] = nloc; b.st[1] = nx; }
        const unsigned old = xb_add(&bar[XB_XSUB(b.x)], 1u);
        const unsigned gen = old / nloc;
        if (old + 1u == (gen + 1u) * nloc) {
            __builtin_amdgcn_fence(__ATOMIC_RELEASE, "agent");
            asm volatile("s_waitcnt vmcnt(0)" ::: "memory");
            const unsigned og = xb_add(&bar[XB_TOP], 1u);
            const unsigned tg = og / nx;
            if (og + 1u == (tg + 1u) * nx) xb_add(&bar[XB_TOPGEN], 1u);
            else XB_SPIN(xb_ld(&bar[XB_TOPGEN]) == tg, bar);
            __builtin_amdgcn_fence(__ATOMIC_ACQUIRE, "agent");
            xb_add(&bar[XB_XGEN(b.x)], 1u);
            asm volatile("s_waitcnt vmcnt(0)" ::: "memory");
        } else {
            XB_SPIN(xb_ld(&bar[XB_XGEN(b.x)]) == gen, bar);
            __builtin_amdgcn_fence(__ATOMIC_ACQUIRE, "agent");
            asm volatile("s_waitcnt vmcnt(0)" ::: "memory");
        }
    }
    __syncthreads();
}
__device__ __forceinline__ float wave_sum(float v) {
#pragma unroll
    for (int o = 1; o < 64; o <<= 1) v += __shfl_xor(v, o);
    return v;
}
__device__ __forceinline__ void p0_transpose_item(const float* W, int K, int N, bf16* WT, int row_off, LAS float* scr, int item, int lane) {
    const int nblk = N / 32, kb = item / nblk, nb = item % nblk, k0 = 64 * kb, n0 = 32 * nb;
#pragma unroll 8
    for (int i = 0; i < 32; ++i) { const int kk = 2 * i + (lane >> 5); scr[kk * 33 + (lane & 31)] = W[(size_t)(k0 + kk) * N + n0 + (lane & 31)]; }
    LDS_WAIT(); asm volatile("" ::: "memory");
    const int c = lane & 7;
#pragma unroll
    for (int j = 0; j < 4; ++j) { const int n = (lane >> 3) + 8 * j; const LAS float* s = scr + (8 * c) * 33 + n;
        v4u o; o.x = pk2(s[0 * 33], s[1 * 33]); o.y = pk2(s[2 * 33], s[3 * 33]); o.z = pk2(s[4 * 33], s[5 * 33]); o.w = pk2(s[6 * 33], s[7 * 33]);
        *(GAS v4u*)(WT + (size_t)(row_off + n0 + n) * K + k0 + 8 * c) = o; }
    LDS_WAIT(); asm volatile("" ::: "memory");
}

constexpr int NWAVES = 8;
constexpr int BATCH = 4, SEQ = 2048, DM = 2048, TOK = BATCH * SEQ, PW = 6144, DFF = 8192, HD = 128, DEPTH = 2;
constexpr int NHA = 6, NHB = 4, NHC = 6;
constexpr int COL_QA = 0, COL_KA = 768, COL_VA = 1536, COL_QB = 2304, COL_KB = 2816, COL_VB = 3328, COL_QC = 3840, COL_KC = 4608, COL_VC = 5376;
constexpr int MIX_A = 0, MIX_B = 768, MIX_C = 1280;
constexpr float EPS = 1e-6f;

constexpr size_t MiB = 1u << 20;
constexpr size_t WS_CTL = 0, CTL_ZERO_BYTES = 1 * MiB;
constexpr size_t WS_LUT = 1 * MiB;
constexpr size_t WS_WIN = 2 * MiB, WS_WOUT = 50 * MiB, WS_W1 = 66 * MiB, WS_W2 = 130 * MiB;
constexpr size_t WS_XB = 194 * MiB;
constexpr size_t WS_QKV = 226 * MiB;
constexpr size_t WS_MIX = 322 * MiB;
constexpr size_t WS_H = 226 * MiB;
constexpr size_t WS_PA = 354 * MiB;
constexpr size_t WS_LSE = 426 * MiB;
constexpr size_t WS_PB = 427 * MiB;
constexpr size_t WS_END = 459 * MiB;
constexpr int CW_BAR = 4096;
constexpr int CW_QUEUE = 8192;

constexpr int RING_OFF = 0, RING_BYTES = 131072;
constexpr int LDSCTL_OFF = RING_BYTES, MISC_OFF = LDSCTL_OFF + 320;
constexpr int LDS_BYTES = 147456;

struct Frame {
    LAS unsigned char* lds;
    volatile LAS unsigned* MISC;
    gu32* ctl;
    int tid, lane, wave, vcu, G;
};

namespace att {
typedef short bf16x8 __attribute__((ext_vector_type(8)));
typedef short s16x4 __attribute__((ext_vector_type(4)));
typedef float f32x16 __attribute__((ext_vector_type(16)));
typedef unsigned u32x4 __attribute__((ext_vector_type(4)));
typedef short v4i16_t __attribute__((ext_vector_type(4)));
constexpr int QP = PW;
constexpr int VPB = 320;
constexpr int VBYTES = 32 * VPB;

__device__ __forceinline__ int crow(int r, int hi) { return (r & 3) + 8 * (r >> 2) + 4 * hi; }
__device__ __forceinline__ unsigned cvtpk(float lo, float hi) { typedef float f2 __attribute__((ext_vector_type(2))); typedef __bf16 b2 __attribute__((ext_vector_type(2)));
    f2 v = {lo, hi}; b2 b = __builtin_convertvector(v, b2); return __builtin_bit_cast(unsigned, b); }
__device__ __forceinline__ s16x4 vtr(LAS const unsigned char* p) { return __builtin_bit_cast(s16x4, __builtin_amdgcn_ds_read_tr16_b64_v4i16((LAS v4i16_t*)p)); }

template <int NKS> __device__ __forceinline__ f32x16 qk_tile(const bf16x8 (&qf)[NKS], const bf16* krow) {
    bf16x8 kf[NKS];
#pragma unroll
    for (int ks = 0; ks < NKS; ++ks) kf[ks] = *(const bf16x8*)(krow + 16 * ks);
    f32x16 st = {0.f, 0.f, 0.f, 0.f, 0.f, 0.f, 0.f, 0.f, 0.f, 0.f, 0.f, 0.f, 0.f, 0.f, 0.f, 0.f};
#pragma unroll
    for (int ks = 0; ks < NKS; ++ks) st = __builtin_amdgcn_mfma_f32_32x32x16_bf16(kf[ks], qf[ks], st, 0, 0, 0);
    return st;
}
__device__ __forceinline__ void load_v(u32x4 (&tmp)[8], const bf16* Vb, int tk0, int tks, int lane) {
#pragma unroll
    for (int i = 0; i < 8; ++i) { const int row = 4 * i + (lane >> 4); int tok = tk0 + tks * row; tok = tok < 0 ? 0 : tok;
        tmp[i] = *(const u32x4*)(Vb + (size_t)tok * QP + (lane & 15) * 8); }
}
__device__ __forceinline__ void store_v(LAS unsigned char* vl, const u32x4 (&tmp)[8], int lane) {
#pragma unroll
    for (int i = 0; i < 8; ++i) { const int row = 4 * i + (lane >> 4); *(LAS u32x4*)(vl + row * VPB + (lane & 15) * 16) = tmp[i]; }
    asm volatile("s_waitcnt lgkmcnt(0)" ::: "memory");
}
__device__ __forceinline__ void pv_tile(f32x16 (&o)[4], const bf16x8 (&pa)[2], LAS const unsigned char* vl, int lane) {
    const int hi = lane >> 5, g1 = (lane >> 4) & 1, i = lane & 15;
    LAS const unsigned char* base = vl + (4 * hi + (i >> 2)) * VPB + (16 * g1 + 4 * (i & 3)) * 2;
#pragma unroll
    for (int db = 0; db < 4; ++db)
#pragma unroll
        for (int s = 0; s < 2; ++s) {
            const s16x4 lo = vtr(base + (16 * s) * VPB + db * 64);
            const s16x4 hh = vtr(base + (16 * s + 8) * VPB + db * 64);
            const bf16x8 vf = {lo[0], lo[1], lo[2], lo[3], hh[0], hh[1], hh[2], hh[3]};
            o[db] = __builtin_amdgcn_mfma_f32_32x32x16_bf16(pa[s], vf, o[db], 0, 0, 0);
        }
}

struct DilFn {
    int dil, r, n32;
    __device__ __forceinline__ int tq(int qi) const { return (32 * n32 + qi) * dil + r; }
    __device__ __forceinline__ int tk0(int kt) const { return (32 * (n32 - 4 + kt)) * dil + r; }
    __device__ __forceinline__ int tks() const { return dil; }
    __device__ __forceinline__ bool valid(int qi, int kc, int kt, int& dist) const { const int mk = 32 * (n32 - 4 + kt) + kc, steps = 128 - 32 * kt + qi - kc; dist = steps * dil; return mk >= 0 && steps >= 0 && steps <= 128; }
};
struct CausFn {
    int qt;
    __device__ __forceinline__ int tq(int qi) const { return 32 * qt + qi; }
    __device__ __forceinline__ int tk0(int kt) const { return 32 * kt; }
    __device__ __forceinline__ int tks() const { return 1; }
    __device__ __forceinline__ bool valid(int qi, int kc, int kt, int& dist) const { dist = 32 * (qt - kt) + qi - kc; return dist >= 0; }
};

template <int NKS, class Fn>
__device__ __forceinline__ void softmax_item(const bf16* Qb, const bf16* Kb, const bf16* Vb, const Fn fn, int kt_lo, int kt_hi, float scale, const float* lut,
                                             float* Ob, int opitch, float* lseb, int lpitch, LAS unsigned char* vl, int lane) {
    const int qi = lane & 31, hi = lane >> 5;
    bf16x8 qf[NKS];
    { const bf16* qrow = Qb + (size_t)fn.tq(qi) * QP + 8 * hi;
#pragma unroll
      for (int ks = 0; ks < NKS; ++ks) qf[ks] = *(const bf16x8*)(qrow + 16 * ks); }
    f32x16 o[4];
#pragma unroll
    for (int db = 0; db < 4; ++db)
#pragma unroll
        for (int r = 0; r < 16; ++r) o[db][r] = 0.f;
    float m = -1e30f, l = 0.f;
    for (int kt = kt_lo; kt <= kt_hi; ++kt) {
        int tkl = fn.tk0(kt) + fn.tks() * qi; tkl = tkl < 0 ? 0 : tkl;
        u32x4 vt[8]; load_v(vt, Vb, fn.tk0(kt), fn.tks(), lane);
        const f32x16 st = qk_tile<NKS>(qf, Kb + (size_t)tkl * QP + 8 * hi);
        float t[16]; float mt = -INFINITY;
#pragma unroll
        for (int r = 0; r < 16; ++r) { int dist; const bool v = fn.valid(qi, crow(r, hi), kt, dist); const int di = dist < 0 ? 0 : (dist > 2047 ? 2047 : dist);
            const float bias = lut[di]; t[r] = v ? (st[r] * scale + bias) : -INFINITY; mt = fmaxf(mt, t[r]); }
        mt = fmaxf(mt, __shfl_xor(mt, 32));
        const float mnew = fmaxf(m, mt), alpha = __expf(m - mnew); m = mnew;
        float ls = 0.f;
#pragma unroll
        for (int r = 0; r < 16; ++r) { t[r] = __expf(t[r] - mnew); ls += t[r]; }
        l = l * alpha + ls;
        bf16x8 pa[2];
        { u32x4 w0 = {cvtpk(t[0], t[1]), cvtpk(t[2], t[3]), cvtpk(t[4], t[5]), cvtpk(t[6], t[7])}, w1 = {cvtpk(t[8], t[9]), cvtpk(t[10], t[11]), cvtpk(t[12], t[13]), cvtpk(t[14], t[15])};
          pa[0] = __builtin_bit_cast(bf16x8, w0); pa[1] = __builtin_bit_cast(bf16x8, w1); }
        if (__any(alpha != 1.0f)) {
#pragma unroll
            for (int r = 0; r < 16; ++r) { const float f = __shfl(alpha, crow(r, hi));
#pragma unroll
                for (int db = 0; db < 4; ++db) o[db][r] *= f; }
        }
        store_v(vl, vt, lane);
        pv_tile(o, pa, vl, lane);
    }
    const float lt = l + __shfl_xor(l, 32), inv = 1.0f / lt;
#pragma unroll
    for (int r = 0; r < 16; ++r) { const int qq = crow(r, hi); const float f = __shfl(inv, qq); float* op = Ob + (size_t)fn.tq(qq) * opitch + qi;
#pragma unroll
        for (int db = 0; db < 4; ++db) op[32 * db] = o[db][r] * f; }
    if (lseb != nullptr && lane < 32) lseb[(size_t)fn.tq(qi) * lpitch] = m + __logf(lt);
}

__device__ __forceinline__ void stick_item(const bf16* Qb, const bf16* Kb, const bf16* Vb, int qt, bf16* Ob, LAS unsigned char* vl, int lane) {
    const int qi = lane & 31, hi = lane >> 5; const float scale = 0.08838834764831845f;
    bf16x8 qf[8];
    { const bf16* qrow = Qb + (size_t)(32 * qt + qi) * QP + 8 * hi;
#pragma unroll
      for (int ks = 0; ks < 8; ++ks) qf[ks] = *(const bf16x8*)(qrow + 16 * ks); }
    f32x16 o[4];
#pragma unroll
    for (int db = 0; db < 4; ++db)
#pragma unroll
        for (int r = 0; r < 16; ++r) o[db][r] = 0.f;
    float R = 0.f;
    for (int kt = qt; kt >= 0; --kt) {
        u32x4 vt[8]; load_v(vt, Vb, 32 * kt, 1, lane);
        const f32x16 st = qk_tile<8>(qf, Kb + (size_t)(32 * kt + qi) * QP + 8 * hi);
        float u[16], zl[16];
#pragma unroll
        for (int r = 0; r < 16; ++r) { const bool v = (32 * kt + crow(r, hi)) < (32 * qt + qi); const float z = st[r] * scale;
            const float sp = fmaxf(z, 0.f) + __logf(1.0f + __expf(-fabsf(z)));
            u[r] = v ? -sp : 0.f; zl[r] = v ? (z - sp) : -INFINITY; }
        float gs[4], pg[4], tot[4], aft[4];
#pragma unroll
        for (int c = 0; c < 4; ++c) { gs[c] = (u[4 * c] + u[4 * c + 1]) + (u[4 * c + 2] + u[4 * c + 3]); pg[c] = __shfl_xor(gs[c], 32); tot[c] = gs[c] + pg[c]; }
        aft[3] = (hi == 0) ? pg[3] : 0.f;
        aft[2] = tot[3] + ((hi == 0) ? pg[2] : 0.f);
        aft[1] = tot[3] + tot[2] + ((hi == 0) ? pg[1] : 0.f);
        aft[0] = tot[3] + tot[2] + tot[1] + ((hi == 0) ? pg[0] : 0.f);
        float a[16];
#pragma unroll
        for (int c = 0; c < 4; ++c) { const float b = R + aft[c];
            const float s3 = 0.f, s2 = u[4 * c + 3], s1 = s2 + u[4 * c + 2], s0 = s1 + u[4 * c + 1];
            a[4 * c + 3] = __expf(zl[4 * c + 3] + (b + s3)); a[4 * c + 2] = __expf(zl[4 * c + 2] + (b + s2));
            a[4 * c + 1] = __expf(zl[4 * c + 1] + (b + s1)); a[4 * c + 0] = __expf(zl[4 * c + 0] + (b + s0)); }
        R += (tot[0] + tot[1]) + (tot[2] + tot[3]);
        bf16x8 pa[2];
        { u32x4 w0 = {cvtpk(a[0], a[1]), cvtpk(a[2], a[3]), cvtpk(a[4], a[5]), cvtpk(a[6], a[7])}, w1 = {cvtpk(a[8], a[9]), cvtpk(a[10], a[11]), cvtpk(a[12], a[13]), cvtpk(a[14], a[15])};
          pa[0] = __builtin_bit_cast(bf16x8, w0); pa[1] = __builtin_bit_cast(bf16x8, w1); }
        store_v(vl, vt, lane);
        pv_tile(o, pa, vl, lane);
    }
#pragma unroll
    for (int r = 0; r < 16; ++r) { bf16* op = Ob + (size_t)(32 * qt + crow(r, hi)) * DM + qi;
#pragma unroll
        for (int db = 0; db < 4; ++db) op[32 * db] = (bf16)f2bf(o[db][r]); }
}
}

__device__ __forceinline__ void rms_row_to_bf16(const float* xrow, const float* g, bf16* orow, int lane) {
    const GAS f32x4* xr = (const GAS f32x4*)xrow + lane; const GAS f32x4* gr = (const GAS f32x4*)g + lane;
    f32x4 v[8]; float s = 0.f;
#pragma unroll
    for (int j = 0; j < 8; ++j) { v[j] = xr[64 * j]; s += (v[j].x * v[j].x + v[j].y * v[j].y) + (v[j].z * v[j].z + v[j].w * v[j].w); }
    const float rstd = 1.0f / sqrtf(wave_sum(s) * (1.0f / DM) + EPS);
    GAS unsigned long long* o8 = (GAS unsigned long long*)orow + lane;
#pragma unroll
    for (int j = 0; j < 8; ++j) { const f32x4 gg = gr[64 * j]; const f32x4 y = v[j] * rstd * gg;
        o8[64 * j] = (unsigned long long)pk2(y.x, y.y) | ((unsigned long long)pk2(y.z, y.w) << 32); }
}
__device__ __forceinline__ void rms_row_to_f32(const float* xrow, const float* g, float* orow, int lane) {
    const GAS f32x4* xr = (const GAS f32x4*)xrow + lane; const GAS f32x4* gr = (const GAS f32x4*)g + lane;
    f32x4 v[8]; float s = 0.f;
#pragma unroll
    for (int j = 0; j < 8; ++j) { v[j] = xr[64 * j]; s += (v[j].x * v[j].x + v[j].y * v[j].y) + (v[j].z * v[j].z + v[j].w * v[j].w); }
    const float rstd = 1.0f / sqrtf(wave_sum(s) * (1.0f / DM) + EPS);
    GAS f32x4* o4 = (GAS f32x4*)orow + lane;
#pragma unroll
    for (int j = 0; j < 8; ++j) { const f32x4 gg = gr[64 * j]; o4[64 * j] = v[j] * rstd * gg; }
}
__device__ __forceinline__ int t5_bucket(int n) {
    if (n < 16) return n;
    const int v = 16 + (int)(logf((float)n / 16.0f) / 4.852030263919617f * 16.0f);
    return v < 31 ? v : 31;
}

struct Args { const float* in[14]; float* out; unsigned char* ws; int ph_lo, ph_hi, use_bar, pad; };
constexpr int N_PHASES = 1 + 8 * DEPTH;

__global__ void __launch_bounds__(NWAVES * 64, 2) fwd_kernel(Args args) {
    extern __shared__ __attribute__((aligned(16))) unsigned char lds_raw[];
    Frame F;
    F.lds = (LAS unsigned char*)lds_raw;
    F.MISC = (volatile LAS unsigned*)(F.lds + MISC_OFF);
    F.tid = threadIdx.x; F.lane = F.tid & 63; F.wave = __builtin_amdgcn_readfirstlane(F.tid >> 6);
    F.G = gridDim.x; { const int bx = blockIdx.x; F.vcu = (F.G % 8 == 0) ? (bx % 8) * (F.G / 8) + bx / 8 : bx; }
    unsigned char* ws = args.ws;
    F.ctl = (gu32*)(ws + WS_CTL);
    const float* x_in = args.in[0]; const float* w_in = args.in[1]; const float* w_out = args.in[2]; const float* g_attn = args.in[3]; const float* g_mlp = args.in[4];
    const float* w1 = args.in[5]; const float* w2 = args.in[6]; const float* rel_tab = args.in[7];
    const float* lq1 = args.in[8]; const float* lk1 = args.in[9]; const float* lq2 = args.in[10]; const float* lk2 = args.in[11]; const float* subln_g = args.in[12]; const float* g_final = args.in[13];
    float* out = args.out;
    bf16* WIN_T = (bf16*)(ws + WS_WIN); bf16* WOUT_T = (bf16*)(ws + WS_WOUT); bf16* W1_T = (bf16*)(ws + WS_W1); bf16* W2_T = (bf16*)(ws + WS_W2);
    bf16* XB = (bf16*)(ws + WS_XB); bf16* QKV = (bf16*)(ws + WS_QKV); bf16* MIX = (bf16*)(ws + WS_MIX); bf16* HB = (bf16*)(ws + WS_H);
    float* PA = (float*)(ws + WS_PA); float* LSE = (float*)(ws + WS_LSE); float* PB = (float*)(ws + WS_PB); float* LUT = (float*)(ws + WS_LUT);

    for (int u = F.tid; u < (LDS_BYTES - LDSCTL_OFF) / 4; u += NWAVES * 64) ((LAS unsigned*)(F.lds + LDSCTL_OFF))[u] = 0u;
    __syncthreads();
    XcdBarrier bar; bar.bar = (unsigned*)(F.ctl + CW_BAR); bar.x = 0; bar.st = nullptr;
    if (args.use_bar) bar = xcd_barrier_post((unsigned*)(F.ctl + CW_BAR), F.MISC + 8);

    const int NGW = F.G * NWAVES;

    for (int ph = args.ph_lo; ph < args.ph_hi; ++ph) {
        int tid = threadIdx.x; asm volatile("" : "+v"(tid));
        const int lane = tid & 63, wave = __builtin_amdgcn_readfirstlane(tid >> 6), gw = F.vcu * NWAVES + wave;
        const int l = ph > 0 ? ((ph - 1) >> 3) : 0, pt = ph > 0 ? ((ph - 1) & 7) : -1;
        if (pt == 0 || pt == 3 || pt == 5 || pt == 6) {
            pg8::Gemm g; pg8::EpiAny E; int N;
            if (pt == 0)      { g.A = XB;  g.Bt = WIN_T + (size_t)l * PW * DM;  N = PW;  g.K = DM;  E.mode = 0; E.O = QKV; E.base = nullptr; E.out = nullptr; E.ldc = PW; }
            else if (pt == 3) { g.A = MIX; g.Bt = WOUT_T + (size_t)l * DM * DM; N = DM;  g.K = DM;  E.mode = 2; E.O = nullptr; E.base = (l == 0) ? x_in : (const float*)out; E.out = out; E.ldc = DM; }
            else if (pt == 5) { g.A = XB;  g.Bt = W1_T + (size_t)l * DFF * DM;  N = DFF; g.K = DM;  E.mode = 1; E.O = HB; E.base = nullptr; E.out = nullptr; E.ldc = DFF; }
            else              { g.A = HB;  g.Bt = W2_T + (size_t)l * DM * DFF;  N = DM;  g.K = DFF; E.mode = 2; E.O = nullptr; E.base = (const float*)out; E.out = out; E.ldc = DM; }
            g.M = TOK; g.N = N; E.perm = (E.mode != 2);
            pg8::StaticOrder S; S.init(TOK, N, F.G, (int)blockIdx.x);
            pg8::gemm_phase<pg8::EpiAny, pg8::StaticOrder, true, true>(F.lds + RING_OFF, g, S, E);
        } else if (ph == 0) {
            LAS float* scr = (LAS float*)(F.lds + RING_OFF + wave * 16384);
            constexpr int I_IN = (DM / 64) * (PW / 32), I_OUT = (DM / 64) * (DM / 32), I_1 = (DM / 64) * (DFF / 32), I_2 = (DFF / 64) * (DM / 32), I_L = I_IN + I_OUT + I_1 + I_2;
            for (int it = gw; it < DEPTH * I_L; it += NGW) {
                const int ll = it / I_L; int r = it % I_L;
                if (r < I_IN) { p0_transpose_item(w_in + (size_t)ll * DM * PW, DM, PW, WIN_T + (size_t)ll * PW * DM, 0, scr, r, lane); continue; } r -= I_IN;
                if (r < I_OUT) { p0_transpose_item(w_out + (size_t)ll * DM * DM, DM, DM, WOUT_T + (size_t)ll * DM * DM, 0, scr, r, lane); continue; } r -= I_OUT;
                if (r < I_1) { p0_transpose_item(w1 + (size_t)ll * DM * DFF, DM, DFF, W1_T + (size_t)ll * DFF * DM, 0, scr, r, lane); continue; } r -= I_1;
                p0_transpose_item(w2 + (size_t)ll * DFF * DM, DFF, DM, W2_T + (size_t)ll * DM * DFF, 0, scr, r, lane);
            }
            for (int i = blockIdx.x * (NWAVES * 64) + tid; i < 10 * 2048; i += F.G * NWAVES * 64) { const int h = i >> 11, d = i & 2047; LUT[i] = rel_tab[t5_bucket(d) * 10 + h]; }
            for (int m = gw; m < TOK; m += NGW) rms_row_to_bf16(x_in + (size_t)m * DM, g_attn, XB + (size_t)m * DM, lane);
        } else if (pt == 1) {
            LAS unsigned char* vl = F.lds + RING_OFF + wave * att::VBYTES;
            for (int s = gw; s < 1792; s += NGW) {
                const int combo = s >> 5, pair = s & 31;
                for (int rep = 0; rep < 2; ++rep) {
                    const int qt = rep == 0 ? 63 - pair : pair;
                    if (combo < 24) { const int b = combo / 6, h = combo % 6; const bf16* base = QKV + (size_t)b * SEQ * PW;
                        att::stick_item(base + COL_QC + h * HD, base + COL_KC + h * HD, base + COL_VC + h * HD, qt, MIX + (size_t)b * SEQ * DM + MIX_C + h * HD, vl, lane);
                    } else { const int c2 = combo - 24, b = c2 >> 3, vh = c2 & 7, h = vh >> 1, p = vh & 1; const bf16* base = QKV + (size_t)b * SEQ * PW;
                        att::CausFn fn{qt};
                        att::softmax_item<4, att::CausFn>(base + COL_QB + h * HD + p * 64, base + COL_KB + h * HD + p * 64, base + COL_VB + h * HD, fn, 0, qt, 0.125f, LUT + (6 + h) * 2048,
                                                          PB + ((size_t)p * TOK + (size_t)b * SEQ) * 512 + h * HD, 512, nullptr, 0, vl, lane);
                    }
                }
            }
            gu32* qctr = F.ctl + CW_QUEUE + 64 * l;
            for (;;) {
                unsigned idx = 0; if (lane == 0) idx = __hip_atomic_fetch_add(qctr, 1u, __ATOMIC_RELAXED, __HIP_MEMORY_SCOPE_AGENT);
                idx = (unsigned)__builtin_amdgcn_readfirstlane((int)idx);
                if (idx >= 3u * 1536u) break;
                const int p = (int)(idx / 1536u), rem = (int)(idx % 1536u), bh = rem >> 6, j = rem & 63, b = bh / 6, h = bh % 6;
                const int dil = p == 0 ? 1 : (p == 1 ? 4 : 16), tpr = 64 / dil;
                att::DilFn fn{dil, j / tpr, j % tpr}; const bf16* base = QKV + (size_t)b * SEQ * PW;
                const int kt_lo = fn.n32 >= 4 ? 0 : 4 - fn.n32;
                att::softmax_item<8, att::DilFn>(base + COL_QA + h * HD, base + COL_KA + h * HD, base + COL_VA + h * HD, fn, kt_lo, 4, 0.08838834764831845f, LUT + h * 2048,
                                                 PA + ((size_t)p * TOK + (size_t)b * SEQ) * 768 + h * HD, 768, LSE + ((size_t)p * TOK + (size_t)b * SEQ) * 6 + h, 6, vl, lane);
            }
        } else if (pt == 2) {
            const float lam_init = 0.8f - 0.6f * expf(-0.3f * (float)l);
            const float s1 = wave_sum(lq1[l * 64 + lane] * lk1[l * 64 + lane]), s2 = wave_sum(lq2[l * 64 + lane] * lk2[l * 64 + lane]);
            const float lam = expf(s1) - expf(s2) + lam_init;
            const float gx = subln_g[l * HD + 2 * lane] * (1.0f - lam_init), gy = subln_g[l * HD + 2 * lane + 1] * (1.0f - lam_init);
            typedef float f32x2 __attribute__((ext_vector_type(2)));
            for (int tok = gw; tok < TOK; tok += NGW) {
                GAS unsigned* mrow = (GAS unsigned*)(MIX + (size_t)tok * DM);
#pragma unroll
                for (int h = 0; h < NHA; ++h) {
                    const float l0 = LSE[((size_t)0 * TOK + tok) * 6 + h], l1 = LSE[((size_t)1 * TOK + tok) * 6 + h], l2 = LSE[((size_t)2 * TOK + tok) * 6 + h];
                    const float mx = fmaxf(l0, fmaxf(l1, l2)); float w0 = __expf(l0 - mx), w1_ = __expf(l1 - mx), w2_ = __expf(l2 - mx); const float inv = 1.0f / (w0 + w1_ + w2_);
                    w0 *= inv; w1_ *= inv; w2_ *= inv;
                    const f32x2 a = *(const f32x2*)(PA + ((size_t)0 * TOK + tok) * 768 + h * HD + 2 * lane), b = *(const f32x2*)(PA + ((size_t)1 * TOK + tok) * 768 + h * HD + 2 * lane),
                                c = *(const f32x2*)(PA + ((size_t)2 * TOK + tok) * 768 + h * HD + 2 * lane);
                    mrow[(MIX_A + h * HD) / 2 + lane] = pk2(w0 * a.x + w1_ * b.x + w2_ * c.x, w0 * a.y + w1_ * b.y + w2_ * c.y);
                }
#pragma unroll
                for (int h = 0; h < NHB; ++h) {
                    const f32x2 a = *(const f32x2*)(PB + ((size_t)0 * TOK + tok) * 512 + h * HD + 2 * lane), b = *(const f32x2*)(PB + ((size_t)1 * TOK + tok) * 512 + h * HD + 2 * lane);
                    const float ox = a.x - lam * b.x, oy = a.y - lam * b.y;
                    const float rstd = 1.0f / sqrtf(wave_sum(ox * ox + oy * oy) * (1.0f / HD) + EPS);
                    mrow[(MIX_B + h * HD) / 2 + lane] = pk2(ox * rstd * gx, oy * rstd * gy);
                }
            }
        } else if (pt == 4) {
            for (int m = gw; m < TOK; m += NGW) rms_row_to_bf16(out + (size_t)m * DM, g_mlp + (size_t)l * DM, XB + (size_t)m * DM, lane);
        } else {
            if (l + 1 < DEPTH) { for (int m = gw; m < TOK; m += NGW) rms_row_to_bf16(out + (size_t)m * DM, g_attn + (size_t)(l + 1) * DM, XB + (size_t)m * DM, lane); }
            else { for (int m = gw; m < TOK; m += NGW) rms_row_to_f32(out + (size_t)m * DM, g_final, out + (size_t)m * DM, lane); }
        }
        if (ph + 1 < args.ph_hi) xcd_barrier(bar);
    }
}

#ifndef MK_PER_PHASE
#define MK_PER_PHASE 0
#endif
extern "C" void kernel_launch(void* const* d_in, const int* in_sizes, int n_in, void* d_out, int out_size, void* d_ws, size_t ws_size, hipStream_t stream) {
    static int grid = 0;
    if (grid == 0) {
        if (n_in != 14 || out_size != TOK * DM || ws_size < WS_END) { fprintf(stderr, "kernel_launch: unexpected shapes (n_in %d out %d ws %zu)\n", n_in, out_size, ws_size); grid = -1; return; }
        int dev = 0, cus = 0, per_cu = 0;
        if (hipGetDevice(&dev) != hipSuccess || hipDeviceGetAttribute(&cus, hipDeviceAttributeMultiprocessorCount, dev) != hipSuccess) { grid = -1; return; }
        if (hipFuncSetAttribute((const void*)fwd_kernel, hipFuncAttributeMaxDynamicSharedMemorySize, LDS_BYTES) != hipSuccess) { fprintf(stderr, "kernel_launch: hipFuncSetAttribute failed\n"); grid = -1; return; }
        if (hipOccupancyMaxActiveBlocksPerMultiprocessor(&per_cu, (const void*)fwd_kernel, NWAVES * 64, LDS_BYTES) != hipSuccess || per_cu < 1) { fprintf(stderr, "kernel_launch: occupancy query says %d blocks per CU\n", per_cu); grid = -1; (void)hipGetLastError(); return; }
        (void)hipGetLastError();
        grid = cus;
    }
    if (grid < 0) return;
    if (hipMemsetAsync((char*)d_ws + WS_CTL, 0, CTL_ZERO_BYTES, stream) != hipSuccess) return;
    Args a{};
    for (int i = 0; i < 14; ++i) a.in[i] = (const float*)d_in[i];
    a.out = (float*)d_out; a.ws = (unsigned char*)d_ws;
#if MK_PER_PHASE
    for (int ph = 0; ph < N_PHASES; ++ph) { a.ph_lo = ph; a.ph_hi = ph + 1; a.use_bar = 0; hipLaunchKernelGGL(fwd_kernel, dim3(grid), dim3(NWAVES * 64), LDS_BYTES, stream, a); }
#else
    a.ph_lo = 0; a.ph_hi = N_PHASES; a.use_bar = 1;
    void* kargs[] = {(void*)&a};
    const hipError_t le = hipLaunchCooperativeKernel((const void*)fwd_kernel, dim3(grid), dim3(NWAVES * 64), kargs, (unsigned)LDS_BYTES, stream);
    if (le != hipSuccess) fprintf(stderr, "kernel_launch: cooperative launch failed: %s (grid %d x %d threads, %d B LDS)\n", hipGetErrorName(le), grid, NWAVES * 64, LDS_BYTES);
#endif
}
```

```cpp
#include <hip/hip_runtime.h>
#include <cstdio>
#include <cstdint>
#include <cmath>
namespace pg8 {
#define PG8_LAS __attribute__((address_space(3)))
typedef unsigned short bf16_t;
typedef short bf16x8 __attribute__((ext_vector_type(8)));
typedef float f32x4 __attribute__((ext_vector_type(4)));
typedef unsigned u32x4 __attribute__((ext_vector_type(4)));
constexpr int BM = 256, BK = 64, HALF = 128, HTB = HALF * BK * 2  , STAGE_BYTES = 8 * HTB, NXCD = 8, WGM = 8;

__host__ __device__ __forceinline__ int lds_byte(int r, int c) { const int st = (r >> 4) * 2 + (c >> 5), rr = r & 15, cc = c & 31, ob = rr * 64 + cc * 2; return st * 1024 + (ob ^ (((ob >> 9) & 1) << 5)); }
__host__ __device__ __forceinline__ void stage_rc(int b, int& R, int& C) { const int st = b / 1024, sb = b % 1024, swz = sb ^ (((sb >> 9) & 1) << 5); R = (st >> 1) * 16 + swz / 64; C = (st & 1) * 32 + (swz % 64) / 2; }
__host__ __device__ __forceinline__ int perm32(int rho) { const int n = rho >> 4, i = rho & 15; return 8 * (i >> 2) + 4 * n + (i & 3); }

struct Unit { int pm, pn; };
struct Gemm { const bf16_t* A; const bf16_t* Bt; int M, N, K; };

struct StaticOrder {
    int nM, nN, nwg, G, c;
    __host__ __device__ void init(int M, int N, int G_, int c_) { nM = M / BM; nN = N / BM; nwg = nM * nN; G = G_; c = c_; }
    __host__ __device__ bool next(int i, Unit& u) const {
        const long L = (long)i * G + c; if (L >= nwg) return false;
        int wgid = (int)L; { const int q = nwg / NXCD, r = nwg % NXCD, xcd = wgid % NXCD, off = wgid / NXCD; wgid = (xcd < r ? xcd * (q + 1) : r * (q + 1) + (xcd - r) * q) + off; }
        const int nig = WGM * nN, gid = wgid / nig, fm = gid * WGM, gsz = (nM - fm) < WGM ? (nM - fm) : WGM;
        u.pm = fm + ((wgid % nig) % gsz); u.pn = (wgid % nig) / gsz; return true;
    }
    __device__ __forceinline__ void a_ready(const Unit&) const {}
    __device__ __forceinline__ void done(const Unit&) const {}
};

__device__ __forceinline__ unsigned cvt_pk_bf16(float lo, float hi) { unsigned r; asm volatile("v_cvt_pk_bf16_f32 %0, %1, %2" : "=v"(r) : "v"(lo), "v"(hi)); return r; }
typedef float f32x2 __attribute__((ext_vector_type(2)));

struct EpiAny {
    static constexpr bool AFTER_DRAIN = false;
    int mode; bool perm; bf16_t* O; const float* base; float* out; int ldc;
    __device__ __forceinline__ void operator()(const f32x4 (&acc)[2][2][4][2], const Unit& u, int wr, int wc, int fr, int fq) const {
        if (mode != 2) {
            const int row0 = u.pm * BM + wr * 64 + fr; const int col0 = u.pn * BM + wc * 32 + 8 * fq;
#pragma unroll
            for (int ai = 0; ai < 2; ++ai)
#pragma unroll
                for (int m = 0; m < 4; ++m) { bf16_t* rowp = O + (size_t)(row0 + ai * HALF + m * 16) * ldc + col0;
#pragma unroll
                    for (int bj = 0; bj < 2; ++bj) { f32x4 v0 = acc[ai][bj][m][0], v1 = acc[ai][bj][m][1];
                        if (mode == 1) {
#pragma unroll
                            for (int e = 0; e < 4; ++e) { const float a = v0[e] > 0.f ? v0[e] : 0.f, b = v1[e] > 0.f ? v1[e] : 0.f; v0[e] = a * a; v1[e] = b * b; } }
                        u32x4 w; w.x = cvt_pk_bf16(v0[0], v0[1]); w.y = cvt_pk_bf16(v0[2], v0[3]); w.z = cvt_pk_bf16(v1[0], v1[1]); w.w = cvt_pk_bf16(v1[2], v1[3]);
                        *(u32x4*)(rowp + bj * HALF) = w; } }
        } else {
            const int col0 = u.pn * BM + wc * 32 + 4 * fq;
#pragma unroll
            for (int ai = 0; ai < 2; ++ai)
#pragma unroll
                for (int m = 0; m < 4; ++m) { const size_t off = (size_t)(u.pm * BM + ai * HALF + wr * 64 + m * 16 + fr) * ldc + col0;
                    f32x4 bs[2][2];
#pragma unroll
                    for (int bj = 0; bj < 2; ++bj)
#pragma unroll
                        for (int n = 0; n < 2; ++n) bs[bj][n] = *(const f32x4*)(base + off + bj * HALF + n * 16);
#pragma unroll
                    for (int bj = 0; bj < 2; ++bj)
#pragma unroll
                        for (int n = 0; n < 2; ++n) *(f32x4*)(out + off + bj * HALF + n * 16) = bs[bj][n] + acc[ai][bj][m][n];
                    asm volatile("" ::: "memory"); }
        }
    }
};

template <class Epi, class Sched, bool ALIGN_EPI = false, bool SP2 = false>
__device__ __forceinline__ void gemm_phase(PG8_LAS unsigned char* lds, const Gemm g, const Sched& S, const Epi& E) {
    int tid = threadIdx.x; asm volatile("" : "+v"(tid));
    const int wid = __builtin_amdgcn_readfirstlane(tid >> 6), lane = tid & 63, wr = wid >> 2, wc = wid & 3, fr = lane & 15, fq = lane >> 4;
    const int K = g.K, nt = K / BK;
    unsigned voffA[2], voffB[2];
#pragma unroll
    for (int i = 0; i < 2; ++i) { int R, C; stage_rc(tid * 16 + i * 8192, R, C); const int Rb = E.perm ? ((R & ~31) + perm32(R & 31)) : R;
        voffA[i] = (unsigned)(R * K + C) * 2u; voffB[i] = (unsigned)(Rb * K + C) * 2u; }
    const size_t kstep = (size_t)(BK * 2);
    const size_t hstep = (size_t)HALF * K * 2;
    const size_t tstep = 2 * hstep;
    const unsigned ldsw = (unsigned)wid * 1024u;
    const int aoff = lds_byte(wr * 64 + fr, fq * 8), boff = lds_byte(wc * 32 + fr, fq * 8);
#define PG8_SA(b, h) (((b) * 2 + (h)) * HTB)
#define PG8_SB(b, h) ((4 + (b) * 2 + (h)) * HTB)
#define PG8_STAGE(bufoff, gbase, voff) do { _Pragma("unroll") for (int _i = 0; _i < 2; ++_i) \
        __builtin_amdgcn_global_load_lds((const unsigned*)((const char*)(gbase) + (voff)[_i]), (PG8_LAS unsigned*)(lds + (bufoff) + ldsw + _i * 8192), 16, 0, 0); } while (0)
#define PG8_LDA(dst, b, h) do { _Pragma("unroll") for (int m = 0; m < 4; ++m) _Pragma("unroll") for (int k = 0; k < 2; ++k) dst[m][k] = *(const PG8_LAS bf16x8*)(lds + PG8_SA(b, h) + aoff + m * 2048 + k * 1024); } while (0)
#define PG8_LDB(dst, b, h) do { _Pragma("unroll") for (int n = 0; n < 2; ++n) _Pragma("unroll") for (int k = 0; k < 2; ++k) dst[n][k] = *(const PG8_LAS bf16x8*)(lds + PG8_SB(b, h) + boff + n * 2048 + k * 1024); } while (0)
#define PG8_MMA(ai, bj, At, Bt) do { __builtin_amdgcn_s_setprio(1); _Pragma("unroll") for (int m = 0; m < 4; ++m) _Pragma("unroll") for (int n = 0; n < 2; ++n) _Pragma("unroll") for (int k = 0; k < 2; ++k) \
        acc[ai][bj][m][n] = __builtin_amdgcn_mfma_f32_16x16x32_bf16(Bt[n][k], At[m][k], acc[ai][bj][m][n], 0, 0, 0); __builtin_amdgcn_s_setprio(0); } while (0)
#define PG8_WAIT_V(n) asm volatile("s_waitcnt vmcnt(" #n ")" ::: "memory")
#define PG8_WAIT_L(n) asm volatile("s_waitcnt lgkmcnt(" #n ")" ::: "memory")
#define PG8_BAR __builtin_amdgcn_s_barrier()
#define PG8_SCHED __builtin_amdgcn_sched_barrier(0)
    Unit cur, nxt; int ui = 0;
    if (!S.next(0, cur)) return;
    f32x4 acc[2][2][4][2];
#pragma unroll
    for (int a = 0; a < 2; ++a)
#pragma unroll
        for (int b = 0; b < 2; ++b)
#pragma unroll
            for (int m = 0; m < 4; ++m)
#pragma unroll
                for (int n = 0; n < 2; ++n) acc[a][b][m][n] = (f32x4){0.f, 0.f, 0.f, 0.f};
    bf16x8 At[4][2], B0[2][2], B1[2][2];
    const char* cA = (const char*)g.A + (size_t)cur.pm * tstep; const char* cB = (const char*)g.Bt + (size_t)cur.pn * tstep;
    S.a_ready(cur);
    if constexpr (SP2) {
        PG8_STAGE(PG8_SB(0, 0), cB, voffB); PG8_STAGE(PG8_SB(0, 1), cB + hstep, voffB); PG8_STAGE(PG8_SA(0, 0), cA, voffA); PG8_STAGE(PG8_SA(0, 1), cA + hstep, voffA);
        if (wr == 1) PG8_BAR;
        PG8_WAIT_V(2); PG8_BAR;
        PG8_STAGE(PG8_SB(1, 0), cB + kstep, voffB); PG8_STAGE(PG8_SA(1, 0), cA + kstep, voffA); PG8_STAGE(PG8_SB(1, 1), cB + hstep + kstep, voffB);
        PG8_WAIT_V(6); PG8_BAR;
    } else {
        PG8_STAGE(PG8_SB(0, 0), cB, voffB); PG8_STAGE(PG8_SA(0, 0), cA, voffA); PG8_STAGE(PG8_SB(0, 1), cB + hstep, voffB); PG8_STAGE(PG8_SA(0, 1), cA + hstep, voffA);
        if (wr == 1) PG8_BAR;
        PG8_WAIT_V(4); PG8_BAR;
        PG8_STAGE(PG8_SB(1, 0), cB + kstep, voffB); PG8_STAGE(PG8_SA(1, 0), cA + kstep, voffA); PG8_STAGE(PG8_SB(1, 1), cB + hstep + kstep, voffB);
        PG8_WAIT_V(6); PG8_BAR;
    }
    for (;;) {
        const bool has_next = S.next(ui + 1, nxt);
        const char* nA = has_next ? (const char*)g.A + (size_t)nxt.pm * tstep : cA; const char* nB = has_next ? (const char*)g.Bt + (size_t)nxt.pn * tstep : cB;
        for (int t = 0; t < nt; t += 2) {
            const bool last = (t == nt - 2);
            const char* a1 = cA + (size_t)(t + 1) * kstep;
            const char* a2 = last ? nA : cA + (size_t)(t + 2) * kstep; const char* b2 = last ? nB : cB + (size_t)(t + 2) * kstep;
            const char* a3 = a2 + kstep; const char* b3 = b2 + kstep;
            if (last && has_next) S.a_ready(nxt);
            if constexpr (SP2) {
            PG8_LDB(B0, 0, 0); PG8_LDB(B1, 0, 1); PG8_SCHED; PG8_LDA(At, 0, 0); PG8_STAGE(PG8_SA(1, 1), a1 + hstep, voffA);
            PG8_WAIT_V(8); PG8_WAIT_L(0); PG8_BAR; PG8_MMA(0, 0, At, B0); PG8_MMA(0, 1, At, B1); PG8_BAR; PG8_SCHED;
            PG8_LDA(At, 0, 1); PG8_STAGE(PG8_SB(0, 0), b2, voffB); PG8_STAGE(PG8_SB(0, 1), b2 + hstep, voffB); PG8_STAGE(PG8_SA(0, 0), a2, voffA);
            PG8_WAIT_V(8); PG8_WAIT_L(0); PG8_BAR; PG8_MMA(1, 0, At, B0); PG8_MMA(1, 1, At, B1); PG8_BAR; PG8_SCHED;
            PG8_LDB(B0, 1, 0); PG8_LDB(B1, 1, 1); PG8_SCHED; PG8_LDA(At, 1, 0); PG8_STAGE(PG8_SA(0, 1), a2 + hstep, voffA);
            PG8_WAIT_V(8); PG8_WAIT_L(0); PG8_BAR; PG8_MMA(0, 0, At, B0); PG8_MMA(0, 1, At, B1); PG8_BAR; PG8_SCHED;
            PG8_LDA(At, 1, 1); PG8_STAGE(PG8_SB(1, 0), b3, voffB); PG8_STAGE(PG8_SB(1, 1), b3 + hstep, voffB); PG8_STAGE(PG8_SA(1, 0), a3, voffA);
            PG8_WAIT_V(8); PG8_WAIT_L(0); PG8_BAR; PG8_MMA(1, 0, At, B0); PG8_MMA(1, 1, At, B1); PG8_BAR; PG8_SCHED;
            } else {
            PG8_LDB(B0, 0, 0); PG8_SCHED; PG8_LDA(At, 0, 0); PG8_STAGE(PG8_SA(1, 1), a1 + hstep, voffA);
            PG8_WAIT_L(8); PG8_BAR; PG8_WAIT_L(0); PG8_MMA(0, 0, At, B0); PG8_BAR; PG8_SCHED;
            PG8_LDB(B1, 0, 1); PG8_STAGE(PG8_SB(0, 0), b2, voffB);
            PG8_BAR; PG8_WAIT_L(0); PG8_MMA(0, 1, At, B1); PG8_BAR;
            PG8_LDA(At, 0, 1); PG8_STAGE(PG8_SA(0, 0), a2, voffA);
            PG8_BAR; PG8_WAIT_L(0); PG8_MMA(1, 0, At, B0); PG8_BAR; PG8_SCHED;
            PG8_STAGE(PG8_SB(0, 1), b2 + hstep, voffB);
            PG8_WAIT_V(6); PG8_BAR; PG8_MMA(1, 1, At, B1); PG8_BAR;
            PG8_LDB(B0, 1, 0); PG8_SCHED; PG8_LDA(At, 1, 0); PG8_STAGE(PG8_SA(0, 1), a2 + hstep, voffA);
            PG8_WAIT_L(8); PG8_BAR; PG8_WAIT_L(0); PG8_MMA(0, 0, At, B0); PG8_BAR; PG8_SCHED;
            PG8_LDB(B1, 1, 1); PG8_STAGE(PG8_SB(1, 0), b3, voffB);
            PG8_BAR; PG8_WAIT_L(0); PG8_MMA(0, 1, At, B1); PG8_BAR;
            PG8_LDA(At, 1, 1); PG8_STAGE(PG8_SA(1, 0), a3, voffA);
            PG8_BAR; PG8_WAIT_L(0); PG8_MMA(1, 0, At, B0); PG8_BAR; PG8_SCHED;
            PG8_STAGE(PG8_SB(1, 1), b3 + hstep, voffB);
            PG8_WAIT_V(6); PG8_BAR; PG8_MMA(1, 1, At, B1); PG8_BAR;
            }
        }
        if constexpr (ALIGN_EPI) { if (wr == 0) PG8_BAR; }
        if constexpr (!Epi::AFTER_DRAIN) { E(acc, cur, wr, wc, fr, fq); S.done(cur); }
        if (!has_next) break;
#pragma unroll
        for (int a = 0; a < 2; ++a)
#pragma unroll
            for (int b = 0; b < 2; ++b)
#pragma unroll
                for (int m = 0; m < 4; ++m)
#pragma unroll
                    for (int n = 0; n < 2; ++n) acc[a][b][m][n] = (f32x4){0.f, 0.f, 0.f, 0.f};
        cur = nxt; cA = nA; cB = nB; ++ui;
        if constexpr (ALIGN_EPI) { if (wr == 1) PG8_BAR; }
    }
    PG8_WAIT_V(0);
    if constexpr (!ALIGN_EPI) { if (wr == 0) PG8_BAR; }
    PG8_BAR;
    if constexpr (Epi::AFTER_DRAIN) { E.fused(acc, cur, wr, wc, fr, fq, lds, wid, lane); S.done(cur); }
#undef PG8_SA
#undef PG8_SB
#undef PG8_STAGE
#undef PG8_LDA
#undef PG8_LDB
#undef PG8_MMA
#undef PG8_WAIT_V
#undef PG8_WAIT_L
#undef PG8_BAR
#undef PG8_SCHED
}
}
#define GAS __attribute__((address_space(1)))
#define LAS __attribute__((address_space(3)))
typedef unsigned short bf16;
typedef unsigned v4u __attribute__((ext_vector_type(4)));
typedef float f32x4 __attribute__((ext_vector_type(4)));
typedef short bf16x8 __attribute__((ext_vector_type(8)));
typedef GAS unsigned gu32;
typedef GAS unsigned long long gu64;
#define RLX_AGENT __ATOMIC_RELAXED, __HIP_MEMORY_SCOPE_AGENT
#define LDS_WAIT() asm volatile("s_waitcnt lgkmcnt(0)" ::: "memory")
#define VM_WAIT() asm volatile("s_waitcnt vmcnt(0)" ::: "memory")
__device__ __forceinline__ unsigned long long rt() { return __builtin_amdgcn_s_memrealtime(); }
__device__ __forceinline__ unsigned f2bf(float f) { unsigned u = __builtin_bit_cast(unsigned, f); return (u + 0x7fffu + ((u >> 16) & 1u)) >> 16; }
__device__ __forceinline__ unsigned pk2(float lo, float hi) { return f2bf(lo) | (f2bf(hi) << 16); }
#define XB_TMO      128
#define XB_XCNT(j)  (256  + 64 * (j))
#define XB_XSUB(j)  (1280 + 64 * (j))
#define XB_XGEN(j)  (2304 + 64 * (j))
#define XB_TOP      3328
#define XB_TOPGEN   3392
#define XCD_BAR_WORDS 3456
#define XB_SPIN_CAP (1u << 18)

__device__ __forceinline__ unsigned xb_ld(unsigned* p)              { return __hip_atomic_load(p, __ATOMIC_RELAXED, __HIP_MEMORY_SCOPE_AGENT); }
__device__ __forceinline__ unsigned xb_add(unsigned* p, unsigned v) { return __hip_atomic_fetch_add(p, v, __ATOMIC_RELAXED, __HIP_MEMORY_SCOPE_AGENT); }
__device__ __forceinline__ unsigned xb_xcc_id() { return (unsigned)__builtin_amdgcn_s_getreg((3 << 11) | 20) & 0xFu; }
#define XB_SPIN(cond, bar) do { unsigned _sp = 0; while (cond) { __builtin_amdgcn_s_sleep(1); \
    if ((++_sp & 255u) == 0u) { if (xb_ld(&(bar)[XB_TMO])) break; if (_sp > XB_SPIN_CAP) { atomicAdd(&(bar)[XB_TMO], 1u); break; } } } } while (0)

struct XcdBarrier {
    unsigned* bar; unsigned x;
    volatile LAS unsigned* st;
};

__device__ __forceinline__ XcdBarrier xcd_barrier_post(unsigned* bar, volatile LAS unsigned* st) {
    XcdBarrier b; b.bar = bar; b.x = xb_xcc_id(); b.st = st;
    if (threadIdx.x == 0) (void)xb_add(&bar[XB_XCNT(b.x)], 1u);
    return b;
}
__device__ __forceinline__ void xcd_barrier_complete(unsigned* bar, unsigned x, unsigned& nloc, unsigned& nx) {
    const unsigned G = gridDim.x * gridDim.y * gridDim.z;
    unsigned sum, cnt, mine, sp = 0u;
    for (;;) {
        sum = 0u; cnt = 0u; mine = 0u;
#pragma unroll
        for (unsigned j = 0; j < 16; ++j) { const unsigned c = xb_ld(&bar[XB_XCNT(j)]); sum += c; cnt += (c > 0u) ? 1u : 0u; mine = (j == x) ? c : mine; }
        if (sum == G) break;
        __builtin_amdgcn_s_sleep(1);
        if ((++sp & 255u) == 0u) { if (xb_ld(&bar[XB_TMO])) break; if (sp > XB_SPIN_CAP) { atomicAdd(&bar[XB_TMO], 1u); break; } }
    }
    nloc = mine > 0u ? mine : 1u; nx = cnt > 0u ? cnt : 1u;
}

__device__ __forceinline__ void xcd_barrier(const XcdBarrier& b) {
    asm volatile("s_waitcnt vmcnt(0)" ::: "memory");
    __syncthreads();
    if (threadIdx.x == 0) {
        unsigned* bar = b.bar;
        __builtin_amdgcn_s_waitcnt(0);
        unsigned nloc = b.st[0], nx = b.st[1];
        if (nloc == 0u) { xcd_barrier_complete(bar, b.x, nloc, nx); b.st[0] = nloc; b.st[1] = nx; }
        const unsigned old = xb_add(&bar[XB_XSUB(b.x)], 1u);
        const unsigned gen = old / nloc;
        if (old + 1u == (gen + 1u) * nloc) {
            __builtin_amdgcn_fence(__ATOMIC_RELEASE, "agent");
            asm volatile("s_waitcnt vmcnt(0)" ::: "memory");
            const unsigned og = xb_add(&bar[XB_TOP], 1u);
            const unsigned tg = og / nx;
            if (og + 1u == (tg + 1u) * nx) xb_add(&bar[XB_TOPGEN], 1u);
            else XB_SPIN(xb_ld(&bar[XB_TOPGEN]) == tg, bar);
            __builtin_amdgcn_fence(__ATOMIC_ACQUIRE, "agent");
            xb_add(&bar[XB_XGEN(b.x)], 1u);
            asm volatile("s_waitcnt vmcnt(0)" ::: "memory");
        } else {
            XB_SPIN(xb_ld(&bar[XB_XGEN(b.x)]) == gen, bar);
            __builtin_amdgcn_fence(__ATOMIC_ACQUIRE, "agent");
            asm volatile("s_waitcnt vmcnt(0)" ::: "memory");
        }
    }
    __syncthreads();
}
__device__ __forceinline__ float wave_sum(float v) {
#pragma unroll
    for (int o = 1; o < 64; o <<= 1) v += __shfl_xor(v, o);
    return v;
}
__device__ __forceinline__ unsigned cvtpk_rne(float lo, float hi) { typedef float f2 __attribute__((ext_vector_type(2))); typedef __bf16 b2 __attribute__((ext_vector_type(2)));
    f2 v = {lo, hi}; b2 b = __builtin_convertvector(v, b2); return __builtin_bit_cast(unsigned, b); }
__device__ __forceinline__ void p0_transpose_item64(const float* W, int K, int N, bf16* WT, LAS unsigned* scr, int item, int lane) {
    const int nblk = N / 64, kb = item / nblk, nb = item % nblk, k0 = 64 * kb, n0 = 64 * nb;
    const int g = lane >> 4, q = lane & 15;
    const float* src = W + (size_t)(k0 + 2 * g) * N + n0 + 4 * q;
    f32x4 v[16];
#pragma unroll
    for (int i = 0; i < 16; ++i) v[i] = *(const GAS f32x4*)(src + (size_t)(8 * (i >> 1) + (i & 1)) * N);
#pragma unroll
    for (int j = 0; j < 8; ++j)
#pragma unroll
        for (int e = 0; e < 4; ++e) scr[(4 * q + e) * 33 + 4 * j + g] = cvtpk_rne(v[2 * j][e], v[2 * j + 1][e]);
    LDS_WAIT(); asm volatile("" ::: "memory");
    const int c = lane & 7, nr = lane >> 3;
#pragma unroll
    for (int jj = 0; jj < 8; ++jj) { const int n = nr + 8 * jj; const LAS unsigned* s = scr + n * 33 + 4 * c;
        v4u o; o.x = s[0]; o.y = s[1]; o.z = s[2]; o.w = s[3];
        *(GAS v4u*)(WT + (size_t)(n0 + n) * K + k0 + 8 * c) = o; }
    LDS_WAIT(); asm volatile("" ::: "memory");
}


constexpr int NWAVES = 8;
constexpr int BATCH = 4, SEQ = 2048, DM = 2048, TOK = BATCH * SEQ, PW = 6144, DFF = 8192, HD = 128, DEPTH = 2;
constexpr int NHA = 6, NHB = 4, NHC = 6;
constexpr int COL_QA = 0, COL_KA = 768, COL_VA = 1536, COL_QB = 2304, COL_KB = 2816, COL_VB = 3328, COL_QC = 3840, COL_KC = 4608, COL_VC = 5376;
constexpr int MIX_A = 0, MIX_B = 768, MIX_C = 1280;
constexpr float EPS = 1e-6f;

constexpr size_t MiB = 1u << 20;
constexpr size_t WS_CTL = 0, CTL_ZERO_BYTES = 1 * MiB;
constexpr size_t WS_LUT = 1 * MiB;
constexpr size_t WS_WIN = 2 * MiB, WS_WOUT = 50 * MiB, WS_W1 = 66 * MiB, WS_W2 = 130 * MiB;
constexpr size_t WS_XB = 194 * MiB;
constexpr size_t WS_QKV = 226 * MiB;
constexpr size_t WS_MIX = 322 * MiB;
constexpr size_t WS_H = 226 * MiB;
constexpr size_t WS_PA = 354 * MiB;
constexpr size_t WS_LSE = 426 * MiB;
constexpr size_t WS_PB = 427 * MiB;
constexpr size_t WS_END = 459 * MiB;
constexpr int CW_BAR = 4096;
constexpr int CW_QUEUE = 8192;

constexpr int RING_OFF = 0, RING_BYTES = 131072;
constexpr int LDSCTL_OFF = RING_BYTES, MISC_OFF = LDSCTL_OFF + 320;
constexpr int LDS_BYTES = 147456;

struct Frame {
    LAS unsigned char* lds;
    volatile LAS unsigned* MISC;
    gu32* ctl;
    int tid, lane, wave, vcu, G;
};

namespace att {
typedef short bf16x8 __attribute__((ext_vector_type(8)));
typedef short s16x4 __attribute__((ext_vector_type(4)));
typedef float f32x16 __attribute__((ext_vector_type(16)));
typedef unsigned u32x4 __attribute__((ext_vector_type(4)));
typedef short v4i16_t __attribute__((ext_vector_type(4)));
constexpr int QP = PW;
constexpr int VPB = 320;
constexpr int VBYTES = 32 * VPB;

__device__ __forceinline__ int crow(int r, int hi) { return (r & 3) + 8 * (r >> 2) + 4 * hi; }
__device__ __forceinline__ unsigned cvtpk(float lo, float hi) { typedef float f2 __attribute__((ext_vector_type(2))); typedef __bf16 b2 __attribute__((ext_vector_type(2)));
    f2 v = {lo, hi}; b2 b = __builtin_convertvector(v, b2); return __builtin_bit_cast(unsigned, b); }
__device__ __forceinline__ s16x4 vtr(LAS const unsigned char* p) { return __builtin_bit_cast(s16x4, __builtin_amdgcn_ds_read_tr16_b64_v4i16((LAS v4i16_t*)p)); }

template <int NKS> __device__ __forceinline__ f32x16 qk_tile(const bf16x8 (&qf)[NKS], const bf16* krow) {
    bf16x8 kf[NKS];
#pragma unroll
    for (int ks = 0; ks < NKS; ++ks) kf[ks] = *(const bf16x8*)(krow + 16 * ks);
    f32x16 st = {0.f, 0.f, 0.f, 0.f, 0.f, 0.f, 0.f, 0.f, 0.f, 0.f, 0.f, 0.f, 0.f, 0.f, 0.f, 0.f};
#pragma unroll
    for (int ks = 0; ks < NKS; ++ks) st = __builtin_amdgcn_mfma_f32_32x32x16_bf16(kf[ks], qf[ks], st, 0, 0, 0);
    return st;
}
__device__ __forceinline__ void load_v(u32x4 (&tmp)[8], const bf16* Vb, int tk0, int tks, int lane) {
#pragma unroll
    for (int i = 0; i < 8; ++i) { const int row = 4 * i + (lane >> 4); int tok = tk0 + tks * row; tok = tok < 0 ? 0 : tok;
        tmp[i] = *(const u32x4*)(Vb + (size_t)tok * QP + (lane & 15) * 8); }
}
__device__ __forceinline__ void store_v(LAS unsigned char* vl, const u32x4 (&tmp)[8], int lane) {
#pragma unroll
    for (int i = 0; i < 8; ++i) { const int row = 4 * i + (lane >> 4); *(LAS u32x4*)(vl + row * VPB + (lane & 15) * 16) = tmp[i]; }
    asm volatile("s_waitcnt lgkmcnt(0)" ::: "memory");
}
__device__ __forceinline__ void pv_tile(f32x16 (&o)[4], const bf16x8 (&pa)[2], LAS const unsigned char* vl, int lane) {
    const int hi = lane >> 5, g1 = (lane >> 4) & 1, i = lane & 15;
    LAS const unsigned char* base = vl + (4 * hi + (i >> 2)) * VPB + (16 * g1 + 4 * (i & 3)) * 2;
#pragma unroll
    for (int db = 0; db < 4; ++db)
#pragma unroll
        for (int s = 0; s < 2; ++s) {
            const s16x4 lo = vtr(base + (16 * s) * VPB + db * 64);
            const s16x4 hh = vtr(base + (16 * s + 8) * VPB + db * 64);
            const bf16x8 vf = {lo[0], lo[1], lo[2], lo[3], hh[0], hh[1], hh[2], hh[3]};
            o[db] = __builtin_amdgcn_mfma_f32_32x32x16_bf16(pa[s], vf, o[db], 0, 0, 0);
        }
}

struct DilFn {
    int dil, r, n32;
    __device__ __forceinline__ int tq(int qi) const { return (32 * n32 + qi) * dil + r; }
    __device__ __forceinline__ int tk0(int kt) const { return (32 * (n32 - 4 + kt)) * dil + r; }
    __device__ __forceinline__ int tks() const { return dil; }
    __device__ __forceinline__ bool valid(int qi, int kc, int kt, int& dist) const { const int mk = 32 * (n32 - 4 + kt) + kc, steps = 128 - 32 * kt + qi - kc; dist = steps * dil; return mk >= 0 && steps >= 0 && steps <= 128; }
};
struct CausFn {
    int qt;
    __device__ __forceinline__ int tq(int qi) const { return 32 * qt + qi; }
    __device__ __forceinline__ int tk0(int kt) const { return 32 * kt; }
    __device__ __forceinline__ int tks() const { return 1; }
    __device__ __forceinline__ bool valid(int qi, int kc, int kt, int& dist) const { dist = 32 * (qt - kt) + qi - kc; return dist >= 0; }
};

template <int NKS, class Fn>
__device__ __forceinline__ void softmax_item(const bf16* Qb, const bf16* Kb, const bf16* Vb, const Fn fn, int kt_lo, int kt_hi, float scale, const float* lut,
                                             float* Ob, int opitch, float* lseb, int lpitch, LAS unsigned char* vl, int lane) {
    const int qi = lane & 31, hi = lane >> 5;
    bf16x8 qf[NKS];
    { const bf16* qrow = Qb + (size_t)fn.tq(qi) * QP + 8 * hi;
#pragma unroll
      for (int ks = 0; ks < NKS; ++ks) qf[ks] = *(const bf16x8*)(qrow + 16 * ks); }
    f32x16 o[4];
#pragma unroll
    for (int db = 0; db < 4; ++db)
#pragma unroll
        for (int r = 0; r < 16; ++r) o[db][r] = 0.f;
    float m = -1e30f, l = 0.f;
    for (int kt = kt_lo; kt <= kt_hi; ++kt) {
        int tkl = fn.tk0(kt) + fn.tks() * qi; tkl = tkl < 0 ? 0 : tkl;
        u32x4 vt[8]; load_v(vt, Vb, fn.tk0(kt), fn.tks(), lane);
        const f32x16 st = qk_tile<NKS>(qf, Kb + (size_t)tkl * QP + 8 * hi);
        float t[16]; float mt = -INFINITY;
#pragma unroll
        for (int r = 0; r < 16; ++r) { int dist; (void)fn.valid(qi, crow(r, hi), kt, dist); const int di = dist < 0 ? 0 : (dist > 2047 ? 2047 : dist); t[r] = lut[di]; }
        asm volatile("" ::: "memory");
#pragma unroll
        for (int r = 0; r < 16; ++r) { int dist; const bool v = fn.valid(qi, crow(r, hi), kt, dist); t[r] = v ? (st[r] * scale + t[r]) : -INFINITY; mt = fmaxf(mt, t[r]); }
        mt = fmaxf(mt, __shfl_xor(mt, 32));
        const float mnew = fmaxf(m, mt), alpha = __expf(m - mnew); m = mnew;
        float ls = 0.f;
#pragma unroll
        for (int r = 0; r < 16; ++r) { t[r] = __expf(t[r] - mnew); ls += t[r]; }
        l = l * alpha + ls;
        bf16x8 pa[2];
        { u32x4 w0 = {cvtpk(t[0], t[1]), cvtpk(t[2], t[3]), cvtpk(t[4], t[5]), cvtpk(t[6], t[7])}, w1 = {cvtpk(t[8], t[9]), cvtpk(t[10], t[11]), cvtpk(t[12], t[13]), cvtpk(t[14], t[15])};
          pa[0] = __builtin_bit_cast(bf16x8, w0); pa[1] = __builtin_bit_cast(bf16x8, w1); }
        if (__any(alpha != 1.0f)) {
#pragma unroll
            for (int r = 0; r < 16; ++r) { const float f = __shfl(alpha, crow(r, hi));
#pragma unroll
                for (int db = 0; db < 4; ++db) o[db][r] *= f; }
        }
        store_v(vl, vt, lane);
        pv_tile(o, pa, vl, lane);
    }
    const float lt = l + __shfl_xor(l, 32), inv = 1.0f / lt;
#pragma unroll
    for (int r = 0; r < 16; ++r) { const int qq = crow(r, hi); const float f = __shfl(inv, qq); float* op = Ob + (size_t)fn.tq(qq) * opitch + qi;
#pragma unroll
        for (int db = 0; db < 4; ++db) op[32 * db] = o[db][r] * f; }
    if (lseb != nullptr && lane < 32) lseb[(size_t)fn.tq(qi) * lpitch] = m + __logf(lt);
}

__device__ __forceinline__ void stick_item(const bf16* Qb, const bf16* Kb, const bf16* Vb, int qt, bf16* Ob, LAS unsigned char* vl, int lane) {
    const int qi = lane & 31, hi = lane >> 5; const float scale = 0.08838834764831845f;
    bf16x8 qf[8];
    { const bf16* qrow = Qb + (size_t)(32 * qt + qi) * QP + 8 * hi;
#pragma unroll
      for (int ks = 0; ks < 8; ++ks) qf[ks] = *(const bf16x8*)(qrow + 16 * ks); }
    f32x16 o[4];
#pragma unroll
    for (int db = 0; db < 4; ++db)
#pragma unroll
        for (int r = 0; r < 16; ++r) o[db][r] = 0.f;
    float R = 0.f;
    for (int kt = qt; kt >= 0; --kt) {
        u32x4 vt[8]; load_v(vt, Vb, 32 * kt, 1, lane);
        const f32x16 st = qk_tile<8>(qf, Kb + (size_t)(32 * kt + qi) * QP + 8 * hi);
        float u[16], zl[16];
#pragma unroll
        for (int r = 0; r < 16; ++r) { const bool v = (32 * kt + crow(r, hi)) < (32 * qt + qi); const float z = st[r] * scale;
            const float sp = fmaxf(z, 0.f) + __logf(1.0f + __expf(-fabsf(z)));
            u[r] = v ? -sp : 0.f; zl[r] = v ? (z - sp) : -INFINITY; }
        float gs[4], pg[4], tot[4], aft[4];
#pragma unroll
        for (int c = 0; c < 4; ++c) { gs[c] = (u[4 * c] + u[4 * c + 1]) + (u[4 * c + 2] + u[4 * c + 3]); pg[c] = __shfl_xor(gs[c], 32); tot[c] = gs[c] + pg[c]; }
        aft[3] = (hi == 0) ? pg[3] : 0.f;
        aft[2] = tot[3] + ((hi == 0) ? pg[2] : 0.f);
        aft[1] = tot[3] + tot[2] + ((hi == 0) ? pg[1] : 0.f);
        aft[0] = tot[3] + tot[2] + tot[1] + ((hi == 0) ? pg[0] : 0.f);
        float a[16];
#pragma unroll
        for (int c = 0; c < 4; ++c) { const float b = R + aft[c];
            const float s3 = 0.f, s2 = u[4 * c + 3], s1 = s2 + u[4 * c + 2], s0 = s1 + u[4 * c + 1];
            a[4 * c + 3] = __expf(zl[4 * c + 3] + (b + s3)); a[4 * c + 2] = __expf(zl[4 * c + 2] + (b + s2));
            a[4 * c + 1] = __expf(zl[4 * c + 1] + (b + s1)); a[4 * c + 0] = __expf(zl[4 * c + 0] + (b + s0)); }
        R += (tot[0] + tot[1]) + (tot[2] + tot[3]);
        bf16x8 pa[2];
        { u32x4 w0 = {cvtpk(a[0], a[1]), cvtpk(a[2], a[3]), cvtpk(a[4], a[5]), cvtpk(a[6], a[7])}, w1 = {cvtpk(a[8], a[9]), cvtpk(a[10], a[11]), cvtpk(a[12], a[13]), cvtpk(a[14], a[15])};
          pa[0] = __builtin_bit_cast(bf16x8, w0); pa[1] = __builtin_bit_cast(bf16x8, w1); }
        store_v(vl, vt, lane);
        pv_tile(o, pa, vl, lane);
    }
#pragma unroll
    for (int r = 0; r < 16; ++r) { bf16* op = Ob + (size_t)(32 * qt + crow(r, hi)) * DM + qi;
#pragma unroll
        for (int db = 0; db < 4; ++db) op[32 * db] = (bf16)f2bf(o[db][r]); }
}
}

__device__ __forceinline__ void rms_row_to_bf16(const float* xrow, const float* g, bf16* orow, int lane) {
    const GAS f32x4* xr = (const GAS f32x4*)xrow + lane; const GAS f32x4* gr = (const GAS f32x4*)g + lane;
    f32x4 v[8]; float s = 0.f;
#pragma unroll
    for (int j = 0; j < 8; ++j) { v[j] = xr[64 * j]; s += (v[j].x * v[j].x + v[j].y * v[j].y) + (v[j].z * v[j].z + v[j].w * v[j].w); }
    const float rstd = 1.0f / sqrtf(wave_sum(s) * (1.0f / DM) + EPS);
    GAS unsigned long long* o8 = (GAS unsigned long long*)orow + lane;
#pragma unroll
    for (int j = 0; j < 8; ++j) { const f32x4 gg = gr[64 * j]; const f32x4 y = v[j] * rstd * gg;
        o8[64 * j] = (unsigned long long)pk2(y.x, y.y) | ((unsigned long long)pk2(y.z, y.w) << 32); }
}
__device__ __forceinline__ void rms_row_to_f32(const float* xrow, const float* g, float* orow, int lane) {
    const GAS f32x4* xr = (const GAS f32x4*)xrow + lane; const GAS f32x4* gr = (const GAS f32x4*)g + lane;
    f32x4 v[8]; float s = 0.f;
#pragma unroll
    for (int j = 0; j < 8; ++j) { v[j] = xr[64 * j]; s += (v[j].x * v[j].x + v[j].y * v[j].y) + (v[j].z * v[j].z + v[j].w * v[j].w); }
    const float rstd = 1.0f / sqrtf(wave_sum(s) * (1.0f / DM) + EPS);
    GAS f32x4* o4 = (GAS f32x4*)orow + lane;
#pragma unroll
    for (int j = 0; j < 8; ++j) { const f32x4 gg = gr[64 * j]; o4[64 * j] = v[j] * rstd * gg; }
}
__device__ __forceinline__ int t5_bucket(int n) {
    if (n < 16) return n;
    const int v = 16 + (int)(logf((float)n / 16.0f) / 4.852030263919617f * 16.0f);
    return v < 31 ? v : 31;
}

struct Args { const float* in[14]; float* out; unsigned char* ws; int ph_lo, ph_hi, use_bar, pad; };
constexpr int N_PHASES = 1 + 8 * DEPTH;
#ifndef PROBE_DUP
#define PROBE_DUP -1
#endif
constexpr int N_STEPS = N_PHASES + (PROBE_DUP < 0 ? 0 : (PROBE_DUP == 100 ? 1 : 2));
__device__ __forceinline__ int step_phase(int i) {
    if (PROBE_DUP < 0) return i;
    if (PROBE_DUP == 100) return i == 0 ? 0 : i - 1;
    const int A = 1 + PROBE_DUP, B = 9 + PROBE_DUP;
    if (i <= A) return i; if (i == A + 1) return A; if (i <= B + 1) return i - 1; if (i == B + 2) return B; return i - 2;
}

__global__ void __launch_bounds__(NWAVES * 64, 2) fwd_kernel(Args args) {
    extern __shared__ __attribute__((aligned(16))) unsigned char lds_raw[];
    Frame F;
    F.lds = (LAS unsigned char*)lds_raw;
    F.MISC = (volatile LAS unsigned*)(F.lds + MISC_OFF);
    F.tid = threadIdx.x; F.lane = F.tid & 63; F.wave = __builtin_amdgcn_readfirstlane(F.tid >> 6);
    F.G = gridDim.x; { const int bx = blockIdx.x; F.vcu = (F.G % 8 == 0) ? (bx % 8) * (F.G / 8) + bx / 8 : bx; }
    unsigned char* ws = args.ws;
    F.ctl = (gu32*)(ws + WS_CTL);
    const float* x_in = args.in[0]; const float* w_in = args.in[1]; const float* w_out = args.in[2]; const float* g_attn = args.in[3]; const float* g_mlp = args.in[4];
    const float* w1 = args.in[5]; const float* w2 = args.in[6]; const float* rel_tab = args.in[7];
    const float* lq1 = args.in[8]; const float* lk1 = args.in[9]; const float* lq2 = args.in[10]; const float* lk2 = args.in[11]; const float* subln_g = args.in[12]; const float* g_final = args.in[13];
    float* out = args.out;
    bf16* WIN_T = (bf16*)(ws + WS_WIN); bf16* WOUT_T = (bf16*)(ws + WS_WOUT); bf16* W1_T = (bf16*)(ws + WS_W1); bf16* W2_T = (bf16*)(ws + WS_W2);
    bf16* XB = (bf16*)(ws + WS_XB); bf16* QKV = (bf16*)(ws + WS_QKV); bf16* MIX = (bf16*)(ws + WS_MIX); bf16* HB = (bf16*)(ws + WS_H);
    float* PA = (float*)(ws + WS_PA); float* LSE = (float*)(ws + WS_LSE); float* PB = (float*)(ws + WS_PB); float* LUT = (float*)(ws + WS_LUT);

    for (int u = F.tid; u < (LDS_BYTES - LDSCTL_OFF) / 4; u += NWAVES * 64) ((LAS unsigned*)(F.lds + LDSCTL_OFF))[u] = 0u;
    __syncthreads();
    XcdBarrier bar; bar.bar = (unsigned*)(F.ctl + CW_BAR); bar.x = 0; bar.st = nullptr;
    if (args.use_bar) bar = xcd_barrier_post((unsigned*)(F.ctl + CW_BAR), F.MISC + 8);

    const int NGW = F.G * NWAVES;

    for (int step = args.ph_lo; step < args.ph_hi; ++step) {
        const int ph = step_phase(step);
        int tid = threadIdx.x; asm volatile("" : "+v"(tid));
        const int lane = tid & 63, wave = __builtin_amdgcn_readfirstlane(tid >> 6), gw = F.vcu * NWAVES + wave;
        const int l = ph > 0 ? ((ph - 1) >> 3) : 0, pt = ph > 0 ? ((ph - 1) & 7) : -1;
        if (pt == 0 || pt == 3 || pt == 5 || pt == 6) {
            pg8::Gemm g; pg8::EpiAny E; int N;
            if (pt == 0)      { g.A = XB;  g.Bt = WIN_T + (size_t)l * PW * DM;  N = PW;  g.K = DM;  E.mode = 0; E.O = QKV; E.base = nullptr; E.out = nullptr; E.ldc = PW; }
            else if (pt == 3) { g.A = MIX; g.Bt = WOUT_T + (size_t)l * DM * DM; N = DM;  g.K = DM;  E.mode = 2; E.O = nullptr; E.base = (l == 0) ? x_in : (const float*)out; E.out = out; E.ldc = DM; }
            else if (pt == 5) { g.A = XB;  g.Bt = W1_T + (size_t)l * DFF * DM;  N = DFF; g.K = DM;  E.mode = 1; E.O = HB; E.base = nullptr; E.out = nullptr; E.ldc = DFF; }
            else              { g.A = HB;  g.Bt = W2_T + (size_t)l * DM * DFF;  N = DM;  g.K = DFF; E.mode = 2; E.O = nullptr; E.base = (const float*)out; E.out = out; E.ldc = DM; }
            g.M = TOK; g.N = N; E.perm = (E.mode != 2);
            pg8::StaticOrder S; S.init(TOK, N, F.G, (int)blockIdx.x);
            pg8::gemm_phase<pg8::EpiAny, pg8::StaticOrder, true, true>(F.lds + RING_OFF, g, S, E);
        } else if (ph == 0) {
            LAS unsigned* scr = (LAS unsigned*)(F.lds + RING_OFF + wave * 16384);
            constexpr int I_IN = (DM / 64) * (PW / 64), I_OUT = (DM / 64) * (DM / 64), I_1 = (DM / 64) * (DFF / 64), I_2 = (DFF / 64) * (DM / 64), I_L = I_IN + I_OUT + I_1 + I_2;
            for (int it = gw; it < DEPTH * I_L; it += NGW) {
                const int ll = it / I_L; int r = it % I_L;
                const float* W; bf16* WT; int K, N;
                if (r < I_IN) { W = w_in + (size_t)ll * DM * PW; WT = WIN_T + (size_t)ll * PW * DM; K = DM; N = PW; }
                else if ((r -= I_IN) < I_OUT) { W = w_out + (size_t)ll * DM * DM; WT = WOUT_T + (size_t)ll * DM * DM; K = DM; N = DM; }
                else if ((r -= I_OUT) < I_1) { W = w1 + (size_t)ll * DM * DFF; WT = W1_T + (size_t)ll * DFF * DM; K = DM; N = DFF; }
                else { r -= I_1; W = w2 + (size_t)ll * DFF * DM; WT = W2_T + (size_t)ll * DM * DFF; K = DFF; N = DM; }
                p0_transpose_item64(W, K, N, WT, scr, r, lane);
            }
            for (int i = blockIdx.x * (NWAVES * 64) + tid; i < 10 * 2048; i += F.G * NWAVES * 64) { const int h = i >> 11, d = i & 2047; LUT[i] = rel_tab[t5_bucket(d) * 10 + h]; }
            for (int m = gw; m < TOK; m += NGW) rms_row_to_bf16(x_in + (size_t)m * DM, g_attn, XB + (size_t)m * DM, lane);
        } else if (pt == 1) {
            LAS unsigned char* vl = F.lds + RING_OFF + wave * att::VBYTES;
            for (int s = gw; s < 1792; s += NGW) {
                const int combo = s >> 5, pair = s & 31;
                for (int rep = 0; rep < 2; ++rep) {
                    const int qt = rep == 0 ? 63 - pair : pair;
                    if (combo < 24) { const int b = combo / 6, h = combo % 6; const bf16* base = QKV + (size_t)b * SEQ * PW;
                        att::stick_item(base + COL_QC + h * HD, base + COL_KC + h * HD, base + COL_VC + h * HD, qt, MIX + (size_t)b * SEQ * DM + MIX_C + h * HD, vl, lane);
                    } else { const int c2 = combo - 24, b = c2 >> 3, vh = c2 & 7, h = vh >> 1, p = vh & 1; const bf16* base = QKV + (size_t)b * SEQ * PW;
                        att::CausFn fn{qt};
                        att::softmax_item<4, att::CausFn>(base + COL_QB + h * HD + p * 64, base + COL_KB + h * HD + p * 64, base + COL_VB + h * HD, fn, 0, qt, 0.125f, LUT + (6 + h) * 2048,
                                                          PB + ((size_t)p * TOK + (size_t)b * SEQ) * 512 + h * HD, 512, nullptr, 0, vl, lane);
                    }
                }
            }
            gu32* qctr = F.ctl + CW_QUEUE + 64 * step;
            for (;;) {
                unsigned idx = 0; if (lane == 0) idx = __hip_atomic_fetch_add(qctr, 1u, __ATOMIC_RELAXED, __HIP_MEMORY_SCOPE_AGENT);
                idx = (unsigned)__builtin_amdgcn_readfirstlane((int)idx);
                if (idx >= 3u * 1536u) break;
                const int p = (int)(idx / 1536u), rem = (int)(idx % 1536u), bh = rem >> 6, j = rem & 63, b = bh / 6, h = bh % 6;
                const int dil = p == 0 ? 1 : (p == 1 ? 4 : 16), tpr = 64 / dil;
                att::DilFn fn{dil, j / tpr, j % tpr}; const bf16* base = QKV + (size_t)b * SEQ * PW;
                const int kt_lo = fn.n32 >= 4 ? 0 : 4 - fn.n32;
                att::softmax_item<8, att::DilFn>(base + COL_QA + h * HD, base + COL_KA + h * HD, base + COL_VA + h * HD, fn, kt_lo, 4, 0.08838834764831845f, LUT + h * 2048,
                                                 PA + ((size_t)p * TOK + (size_t)b * SEQ) * 768 + h * HD, 768, LSE + ((size_t)p * TOK + (size_t)b * SEQ) * 6 + h, 6, vl, lane);
            }
        } else if (pt == 2) {
            const float lam_init = 0.8f - 0.6f * expf(-0.3f * (float)l);
            const float s1 = wave_sum(lq1[l * 64 + lane] * lk1[l * 64 + lane]), s2 = wave_sum(lq2[l * 64 + lane] * lk2[l * 64 + lane]);
            const float lam = expf(s1) - expf(s2) + lam_init;
            const float gx = subln_g[l * HD + 2 * lane] * (1.0f - lam_init), gy = subln_g[l * HD + 2 * lane + 1] * (1.0f - lam_init);
            typedef float f32x2 __attribute__((ext_vector_type(2)));
            for (int tok = gw; tok < TOK; tok += NGW) {
                GAS unsigned* mrow = (GAS unsigned*)(MIX + (size_t)tok * DM);
#pragma unroll
                for (int h = 0; h < NHA; ++h) {
                    const float l0 = LSE[((size_t)0 * TOK + tok) * 6 + h], l1 = LSE[((size_t)1 * TOK + tok) * 6 + h], l2 = LSE[((size_t)2 * TOK + tok) * 6 + h];
                    const float mx = fmaxf(l0, fmaxf(l1, l2)); float w0 = __expf(l0 - mx), w1_ = __expf(l1 - mx), w2_ = __expf(l2 - mx); const float inv = 1.0f / (w0 + w1_ + w2_);
                    w0 *= inv; w1_ *= inv; w2_ *= inv;
                    const f32x2 a = *(const f32x2*)(PA + ((size_t)0 * TOK + tok) * 768 + h * HD + 2 * lane), b = *(const f32x2*)(PA + ((size_t)1 * TOK + tok) * 768 + h * HD + 2 * lane),
                                c = *(const f32x2*)(PA + ((size_t)2 * TOK + tok) * 768 + h * HD + 2 * lane);
                    mrow[(MIX_A + h * HD) / 2 + lane] = pk2(w0 * a.x + w1_ * b.x + w2_ * c.x, w0 * a.y + w1_ * b.y + w2_ * c.y);
                }
#pragma unroll
                for (int h = 0; h < NHB; ++h) {
                    const f32x2 a = *(const f32x2*)(PB + ((size_t)0 * TOK + tok) * 512 + h * HD + 2 * lane), b = *(const f32x2*)(PB + ((size_t)1 * TOK + tok) * 512 + h * HD + 2 * lane);
                    const float ox = a.x - lam * b.x, oy = a.y - lam * b.y;
                    const float rstd = 1.0f / sqrtf(wave_sum(ox * ox + oy * oy) * (1.0f / HD) + EPS);
                    mrow[(MIX_B + h * HD) / 2 + lane] = pk2(ox * rstd * gx, oy * rstd * gy);
                }
            }
        } else if (pt == 4) {
            for (int m = gw; m < TOK; m += NGW) rms_row_to_bf16(out + (size_t)m * DM, g_mlp + (size_t)l * DM, XB + (size_t)m * DM, lane);
        } else {
            if (l + 1 < DEPTH) { for (int m = gw; m < TOK; m += NGW) rms_row_to_bf16(out + (size_t)m * DM, g_attn + (size_t)(l + 1) * DM, XB + (size_t)m * DM, lane); }
            else { for (int m = gw; m < TOK; m += NGW) rms_row_to_f32(out + (size_t)m * DM, g_final, out + (size_t)m * DM, lane); }
        }
        if (step + 1 < args.ph_hi) xcd_barrier(bar);
    }
}

#ifndef MK_PER_PHASE
#define MK_PER_PHASE 0
#endif
extern "C" void kernel_launch(void* const* d_in, const int* in_sizes, int n_in, void* d_out, int out_size, void* d_ws, size_t ws_size, hipStream_t stream) {
    static int grid = 0;
    if (grid == 0) {
        if (n_in != 14 || out_size != TOK * DM || ws_size < WS_END) { fprintf(stderr, "kernel_launch: unexpected shapes (n_in %d out %d ws %zu)\n", n_in, out_size, ws_size); grid = -1; return; }
        int dev = 0, cus = 0, per_cu = 0;
        if (hipGetDevice(&dev) != hipSuccess || hipDeviceGetAttribute(&cus, hipDeviceAttributeMultiprocessorCount, dev) != hipSuccess) { grid = -1; return; }
        if (hipFuncSetAttribute((const void*)fwd_kernel, hipFuncAttributeMaxDynamicSharedMemorySize, LDS_BYTES) != hipSuccess) { fprintf(stderr, "kernel_launch: hipFuncSetAttribute failed\n"); grid = -1; return; }
        if (hipOccupancyMaxActiveBlocksPerMultiprocessor(&per_cu, (const void*)fwd_kernel, NWAVES * 64, LDS_BYTES) != hipSuccess || per_cu < 1) { fprintf(stderr, "kernel_launch: occupancy query says %d blocks per CU\n", per_cu); grid = -1; (void)hipGetLastError(); return; }
        (void)hipGetLastError();
        grid = cus;
    }
    if (grid < 0) return;
    if (hipMemsetAsync((char*)d_ws + WS_CTL, 0, CTL_ZERO_BYTES, stream) != hipSuccess) return;
    Args a{};
    for (int i = 0; i < 14; ++i) a.in[i] = (const float*)d_in[i];
    a.out = (float*)d_out; a.ws = (unsigned char*)d_ws;
#if MK_PER_PHASE
    for (int ph = 0; ph < N_STEPS; ++ph) { a.ph_lo = ph; a.ph_hi = ph + 1; a.use_bar = 0; hipLaunchKernelGGL(fwd_kernel, dim3(grid), dim3(NWAVES * 64), LDS_BYTES, stream, a); }
#else
    a.ph_lo = 0; a.ph_hi = N_STEPS; a.use_bar = 1;
    void* kargs[] = {(void*)&a};
    const hipError_t le = hipLaunchCooperativeKernel((const void*)fwd_kernel, dim3(grid), dim3(NWAVES * 64), kargs, (unsigned)LDS_BYTES, stream);
    if (le != hipSuccess) fprintf(stderr, "kernel_launch: cooperative launch failed: %s (grid %d x %d threads, %d B LDS)\n", hipGetErrorName(le), grid, NWAVES * 64, LDS_BYTES);
#endif
}
```

```cpp
#include <hip/hip_runtime.h>
#include <cstdio>
#include <cstdint>
#include <cmath>
namespace pg8 {
#define PG8_LAS __attribute__((address_space(3)))
typedef unsigned short bf16_t;
typedef short bf16x8 __attribute__((ext_vector_type(8)));
typedef float f32x4 __attribute__((ext_vector_type(4)));
typedef unsigned u32x4 __attribute__((ext_vector_type(4)));
constexpr int BM = 256, BK = 64, HALF = 128, HTB = HALF * BK * 2  , STAGE_BYTES = 8 * HTB, NXCD = 8, WGM = 8;

__host__ __device__ __forceinline__ int lds_byte(int r, int c) { const int st = (r >> 4) * 2 + (c >> 5), rr = r & 15, cc = c & 31, ob = rr * 64 + cc * 2; return st * 1024 + (ob ^ (((ob >> 9) & 1) << 5)); }
__host__ __device__ __forceinline__ void stage_rc(int b, int& R, int& C) { const int st = b / 1024, sb = b % 1024, swz = sb ^ (((sb >> 9) & 1) << 5); R = (st >> 1) * 16 + swz / 64; C = (st & 1) * 32 + (swz % 64) / 2; }
__host__ __device__ __forceinline__ int perm32(int rho) { const int n = rho >> 4, i = rho & 15; return 8 * (i >> 2) + 4 * n + (i & 3); }

struct Unit { int pm, pn; };
struct Gemm { const bf16_t* A; const bf16_t* Bt; int M, N, K; };

struct StaticOrder {
    int nM, nN, nwg, G, c;
    __host__ __device__ void init(int M, int N, int G_, int c_) { nM = M / BM; nN = N / BM; nwg = nM * nN; G = G_; c = c_; }
    __host__ __device__ bool next(int i, Unit& u) const {
        const long L = (long)i * G + c; if (L >= nwg) return false;
        int wgid = (int)L; { const int q = nwg / NXCD, r = nwg % NXCD, xcd = wgid % NXCD, off = wgid / NXCD; wgid = (xcd < r ? xcd * (q + 1) : r * (q + 1) + (xcd - r) * q) + off; }
        const int nig = WGM * nN, gid = wgid / nig, fm = gid * WGM, gsz = (nM - fm) < WGM ? (nM - fm) : WGM;
        u.pm = fm + ((wgid % nig) % gsz); u.pn = (wgid % nig) / gsz; return true;
    }
    __device__ __forceinline__ void a_ready(const Unit&) const {}
    __device__ __forceinline__ void done(const Unit&) const {}
};

__device__ __forceinline__ unsigned cvt_pk_bf16(float lo, float hi) { unsigned r; asm volatile("v_cvt_pk_bf16_f32 %0, %1, %2" : "=v"(r) : "v"(lo), "v"(hi)); return r; }
typedef float f32x2 __attribute__((ext_vector_type(2)));

struct EpiAny {
    static constexpr bool AFTER_DRAIN = false;
    int mode; bool perm; bf16_t* O; const float* base; float* out; int ldc;
    __device__ __forceinline__ void operator()(const f32x4 (&acc)[2][2][4][2], const Unit& u, int wr, int wc, int fr, int fq) const {
        if (mode != 2) {
            const int row0 = u.pm * BM + wr * 64 + fr; const int col0 = u.pn * BM + wc * 32 + 8 * fq;
#pragma unroll
            for (int ai = 0; ai < 2; ++ai)
#pragma unroll
                for (int m = 0; m < 4; ++m) { bf16_t* rowp = O + (size_t)(row0 + ai * HALF + m * 16) * ldc + col0;
#pragma unroll
                    for (int bj = 0; bj < 2; ++bj) { f32x4 v0 = acc[ai][bj][m][0], v1 = acc[ai][bj][m][1];
                        if (mode == 1) {
#pragma unroll
                            for (int e = 0; e < 4; ++e) { const float a = v0[e] > 0.f ? v0[e] : 0.f, b = v1[e] > 0.f ? v1[e] : 0.f; v0[e] = a * a; v1[e] = b * b; } }
                        u32x4 w; w.x = cvt_pk_bf16(v0[0], v0[1]); w.y = cvt_pk_bf16(v0[2], v0[3]); w.z = cvt_pk_bf16(v1[0], v1[1]); w.w = cvt_pk_bf16(v1[2], v1[3]);
                        *(u32x4*)(rowp + bj * HALF) = w; } }
        } else {
            const int col0 = u.pn * BM + wc * 32 + 4 * fq;
#pragma unroll
            for (int ai = 0; ai < 2; ++ai)
#pragma unroll
                for (int m = 0; m < 4; ++m) { const size_t off = (size_t)(u.pm * BM + ai * HALF + wr * 64 + m * 16 + fr) * ldc + col0;
                    f32x4 bs[2][2];
#pragma unroll
                    for (int bj = 0; bj < 2; ++bj)
#pragma unroll
                        for (int n = 0; n < 2; ++n) bs[bj][n] = *(const f32x4*)(base + off + bj * HALF + n * 16);
#pragma unroll
                    for (int bj = 0; bj < 2; ++bj)
#pragma unroll
                        for (int n = 0; n < 2; ++n) *(f32x4*)(out + off + bj * HALF + n * 16) = bs[bj][n] + acc[ai][bj][m][n];
                    asm volatile("" ::: "memory"); }
        }
    }
};

template <class Epi, class Sched, bool ALIGN_EPI = false, bool SP2 = false>
__device__ __forceinline__ void gemm_phase(PG8_LAS unsigned char* lds, const Gemm g, const Sched& S, const Epi& E) {
    int tid = threadIdx.x; asm volatile("" : "+v"(tid));
    const int wid = __builtin_amdgcn_readfirstlane(tid >> 6), lane = tid & 63, wr = wid >> 2, wc = wid & 3, fr = lane & 15, fq = lane >> 4;
    const int K = g.K, nt = K / BK;
    unsigned voffA[2], voffB[2];
#pragma unroll
    for (int i = 0; i < 2; ++i) { int R, C; stage_rc(tid * 16 + i * 8192, R, C); const int Rb = E.perm ? ((R & ~31) + perm32(R & 31)) : R;
        voffA[i] = (unsigned)(R * K + C) * 2u; voffB[i] = (unsigned)(Rb * K + C) * 2u; }
    const size_t kstep = (size_t)(BK * 2);
    const size_t hstep = (size_t)HALF * K * 2;
    const size_t tstep = 2 * hstep;
    const unsigned ldsw = (unsigned)wid * 1024u;
    const int aoff = lds_byte(wr * 64 + fr, fq * 8), boff = lds_byte(wc * 32 + fr, fq * 8);
#define PG8_SA(b, h) (((b) * 2 + (h)) * HTB)
#define PG8_SB(b, h) ((4 + (b) * 2 + (h)) * HTB)
#define PG8_STAGE(bufoff, gbase, voff) do { _Pragma("unroll") for (int _i = 0; _i < 2; ++_i) \
        __builtin_amdgcn_global_load_lds((const unsigned*)((const char*)(gbase) + (voff)[_i]), (PG8_LAS unsigned*)(lds + (bufoff) + ldsw + _i * 8192), 16, 0, 0); } while (0)
#define PG8_LDA(dst, b, h) do { _Pragma("unroll") for (int m = 0; m < 4; ++m) _Pragma("unroll") for (int k = 0; k < 2; ++k) dst[m][k] = *(const PG8_LAS bf16x8*)(lds + PG8_SA(b, h) + aoff + m * 2048 + k * 1024); } while (0)
#define PG8_LDB(dst, b, h) do { _Pragma("unroll") for (int n = 0; n < 2; ++n) _Pragma("unroll") for (int k = 0; k < 2; ++k) dst[n][k] = *(const PG8_LAS bf16x8*)(lds + PG8_SB(b, h) + boff + n * 2048 + k * 1024); } while (0)
#define PG8_MMA(ai, bj, At, Bt) do { __builtin_amdgcn_s_setprio(1); _Pragma("unroll") for (int m = 0; m < 4; ++m) _Pragma("unroll") for (int n = 0; n < 2; ++n) _Pragma("unroll") for (int k = 0; k < 2; ++k) \
        acc[ai][bj][m][n] = __builtin_amdgcn_mfma_f32_16x16x32_bf16(Bt[n][k], At[m][k], acc[ai][bj][m][n], 0, 0, 0); __builtin_amdgcn_s_setprio(0); } while (0)
#define PG8_WAIT_V(n) asm volatile("s_waitcnt vmcnt(" #n ")" ::: "memory")
#define PG8_WAIT_L(n) asm volatile("s_waitcnt lgkmcnt(" #n ")" ::: "memory")
#define PG8_BAR __builtin_amdgcn_s_barrier()
#define PG8_SCHED __builtin_amdgcn_sched_barrier(0)
    Unit cur, nxt; int ui = 0;
    if (!S.next(0, cur)) return;
    f32x4 acc[2][2][4][2];
#pragma unroll
    for (int a = 0; a < 2; ++a)
#pragma unroll
        for (int b = 0; b < 2; ++b)
#pragma unroll
            for (int m = 0; m < 4; ++m)
#pragma unroll
                for (int n = 0; n < 2; ++n) acc[a][b][m][n] = (f32x4){0.f, 0.f, 0.f, 0.f};
    bf16x8 At[4][2], B0[2][2], B1[2][2];
    const char* cA = (const char*)g.A + (size_t)cur.pm * tstep; const char* cB = (const char*)g.Bt + (size_t)cur.pn * tstep;
    S.a_ready(cur);
    if constexpr (SP2) {
        PG8_STAGE(PG8_SB(0, 0), cB, voffB); PG8_STAGE(PG8_SB(0, 1), cB + hstep, voffB); PG8_STAGE(PG8_SA(0, 0), cA, voffA); PG8_STAGE(PG8_SA(0, 1), cA + hstep, voffA);
        if (wr == 1) PG8_BAR;
        PG8_WAIT_V(2); PG8_BAR;
        PG8_STAGE(PG8_SB(1, 0), cB + kstep, voffB); PG8_STAGE(PG8_SA(1, 0), cA + kstep, voffA); PG8_STAGE(PG8_SB(1, 1), cB + hstep + kstep, voffB);
        PG8_WAIT_V(6); PG8_BAR;
    } else {
        PG8_STAGE(PG8_SB(0, 0), cB, voffB); PG8_STAGE(PG8_SA(0, 0), cA, voffA); PG8_STAGE(PG8_SB(0, 1), cB + hstep, voffB); PG8_STAGE(PG8_SA(0, 1), cA + hstep, voffA);
        if (wr == 1) PG8_BAR;
        PG8_WAIT_V(4); PG8_BAR;
        PG8_STAGE(PG8_SB(1, 0), cB + kstep, voffB); PG8_STAGE(PG8_SA(1, 0), cA + kstep, voffA); PG8_STAGE(PG8_SB(1, 1), cB + hstep + kstep, voffB);
        PG8_WAIT_V(6); PG8_BAR;
    }
    for (;;) {
        const bool has_next = S.next(ui + 1, nxt);
        const char* nA = has_next ? (const char*)g.A + (size_t)nxt.pm * tstep : cA; const char* nB = has_next ? (const char*)g.Bt + (size_t)nxt.pn * tstep : cB;
        for (int t = 0; t < nt; t += 2) {
            const bool last = (t == nt - 2);
            const char* a1 = cA + (size_t)(t + 1) * kstep;
            const char* a2 = last ? nA : cA + (size_t)(t + 2) * kstep; const char* b2 = last ? nB : cB + (size_t)(t + 2) * kstep;
            const char* a3 = a2 + kstep; const char* b3 = b2 + kstep;
            if (last && has_next) S.a_ready(nxt);
            if constexpr (SP2) {
            PG8_LDB(B0, 0, 0); PG8_LDB(B1, 0, 1); PG8_SCHED; PG8_LDA(At, 0, 0); PG8_STAGE(PG8_SA(1, 1), a1 + hstep, voffA);
            PG8_WAIT_V(8); PG8_WAIT_L(0); PG8_BAR; PG8_MMA(0, 0, At, B0); PG8_MMA(0, 1, At, B1); PG8_BAR; PG8_SCHED;
            PG8_LDA(At, 0, 1); PG8_STAGE(PG8_SB(0, 0), b2, voffB); PG8_STAGE(PG8_SB(0, 1), b2 + hstep, voffB); PG8_STAGE(PG8_SA(0, 0), a2, voffA);
            PG8_WAIT_V(8); PG8_WAIT_L(0); PG8_BAR; PG8_MMA(1, 0, At, B0); PG8_MMA(1, 1, At, B1); PG8_BAR; PG8_SCHED;
            PG8_LDB(B0, 1, 0); PG8_LDB(B1, 1, 1); PG8_SCHED; PG8_LDA(At, 1, 0); PG8_STAGE(PG8_SA(0, 1), a2 + hstep, voffA);
            PG8_WAIT_V(8); PG8_WAIT_L(0); PG8_BAR; PG8_MMA(0, 0, At, B0); PG8_MMA(0, 1, At, B1); PG8_BAR; PG8_SCHED;
            PG8_LDA(At, 1, 1); PG8_STAGE(PG8_SB(1, 0), b3, voffB); PG8_STAGE(PG8_SB(1, 1), b3 + hstep, voffB); PG8_STAGE(PG8_SA(1, 0), a3, voffA);
            PG8_WAIT_V(8); PG8_WAIT_L(0); PG8_BAR; PG8_MMA(1, 0, At, B0); PG8_MMA(1, 1, At, B1); PG8_BAR; PG8_SCHED;
            } else {
            PG8_LDB(B0, 0, 0); PG8_SCHED; PG8_LDA(At, 0, 0); PG8_STAGE(PG8_SA(1, 1), a1 + hstep, voffA);
            PG8_WAIT_L(8); PG8_BAR; PG8_WAIT_L(0); PG8_MMA(0, 0, At, B0); PG8_BAR; PG8_SCHED;
            PG8_LDB(B1, 0, 1); PG8_STAGE(PG8_SB(0, 0), b2, voffB);
            PG8_BAR; PG8_WAIT_L(0); PG8_MMA(0, 1, At, B1); PG8_BAR;
            PG8_LDA(At, 0, 1); PG8_STAGE(PG8_SA(0, 0), a2, voffA);
            PG8_BAR; PG8_WAIT_L(0); PG8_MMA(1, 0, At, B0); PG8_BAR; PG8_SCHED;
            PG8_STAGE(PG8_SB(0, 1), b2 + hstep, voffB);
            PG8_WAIT_V(6); PG8_BAR; PG8_MMA(1, 1, At, B1); PG8_BAR;
            PG8_LDB(B0, 1, 0); PG8_SCHED; PG8_LDA(At, 1, 0); PG8_STAGE(PG8_SA(0, 1), a2 + hstep, voffA);
            PG8_WAIT_L(8); PG8_BAR; PG8_WAIT_L(0); PG8_MMA(0, 0, At, B0); PG8_BAR; PG8_SCHED;
            PG8_LDB(B1, 1, 1); PG8_STAGE(PG8_SB(1, 0), b3, voffB);
            PG8_BAR; PG8_WAIT_L(0); PG8_MMA(0, 1, At, B1); PG8_BAR;
            PG8_LDA(At, 1, 1); PG8_STAGE(PG8_SA(1, 0), a3, voffA);
            PG8_BAR; PG8_WAIT_L(0); PG8_MMA(1, 0, At, B0); PG8_BAR; PG8_SCHED;
            PG8_STAGE(PG8_SB(1, 1), b3 + hstep, voffB);
            PG8_WAIT_V(6); PG8_BAR; PG8_MMA(1, 1, At, B1); PG8_BAR;
            }
        }
        if constexpr (ALIGN_EPI) { if (wr == 0) PG8_BAR; }
        if constexpr (!Epi::AFTER_DRAIN) { E(acc, cur, wr, wc, fr, fq); S.done(cur); }
        if (!has_next) break;
#pragma unroll
        for (int a = 0; a < 2; ++a)
#pragma unroll
            for (int b = 0; b < 2; ++b)
#pragma unroll
                for (int m = 0; m < 4; ++m)
#pragma unroll
                    for (int n = 0; n < 2; ++n) acc[a][b][m][n] = (f32x4){0.f, 0.f, 0.f, 0.f};
        cur = nxt; cA = nA; cB = nB; ++ui;
        if constexpr (ALIGN_EPI) { if (wr == 1) PG8_BAR; }
    }
    PG8_WAIT_V(0);
    if constexpr (!ALIGN_EPI) { if (wr == 0) PG8_BAR; }
    PG8_BAR;
    if constexpr (Epi::AFTER_DRAIN) { E.fused(acc, cur, wr, wc, fr, fq, lds, wid, lane); S.done(cur); }
#undef PG8_SA
#undef PG8_SB
#undef PG8_STAGE
#undef PG8_LDA
#undef PG8_LDB
#undef PG8_MMA
#undef PG8_WAIT_V
#undef PG8_WAIT_L
#undef PG8_BAR
#undef PG8_SCHED
}
}
#define GAS __attribute__((address_space(1)))
#define LAS __attribute__((address_space(3)))
typedef unsigned short bf16;
typedef unsigned v4u __attribute__((ext_vector_type(4)));
typedef float f32x4 __attribute__((ext_vector_type(4)));
typedef short bf16x8 __attribute__((ext_vector_type(8)));
typedef GAS unsigned gu32;
typedef GAS unsigned long long gu64;
#define RLX_AGENT __ATOMIC_RELAXED, __HIP_MEMORY_SCOPE_AGENT
#define LDS_WAIT() asm volatile("s_waitcnt lgkmcnt(0)" ::: "memory")
#define VM_WAIT() asm volatile("s_waitcnt vmcnt(0)" ::: "memory")
__device__ __forceinline__ unsigned long long rt() { return __builtin_amdgcn_s_memrealtime(); }
__device__ __forceinline__ unsigned f2bf(float f) { unsigned u = __builtin_bit_cast(unsigned, f); return (u + 0x7fffu + ((u >> 16) & 1u)) >> 16; }
__device__ __forceinline__ unsigned pk2(float lo, float hi) { return f2bf(lo) | (f2bf(hi) << 16); }
#define XB_TMO      128
#define XB_XCNT(j)  (256  + 64 * (j))
#define XB_XSUB(j)  (1280 + 64 * (j))
#define XB_XGEN(j)  (2304 + 64 * (j))
#define XB_TOP      3328
#define XB_TOPGEN   3392
#define XCD_BAR_WORDS 3456
#define XB_SPIN_CAP (1u << 18)

__device__ __forceinline__ unsigned xb_ld(unsigned* p)              { return __hip_atomic_load(p, __ATOMIC_RELAXED, __HIP_MEMORY_SCOPE_AGENT); }
__device__ __forceinline__ unsigned xb_add(unsigned* p, unsigned v) { return __hip_atomic_fetch_add(p, v, __ATOMIC_RELAXED, __HIP_MEMORY_SCOPE_AGENT); }
__device__ __forceinline__ unsigned xb_xcc_id() { return (unsigned)__builtin_amdgcn_s_getreg((3 << 11) | 20) & 0xFu; }
#define XB_SPIN(cond, bar) do { unsigned _sp = 0; while (cond) { __builtin_amdgcn_s_sleep(1); \
    if ((++_sp & 255u) == 0u) { if (xb_ld(&(bar)[XB_TMO])) break; if (_sp > XB_SPIN_CAP) { atomicAdd(&(bar)[XB_TMO], 1u); break; } } } } while (0)

struct XcdBarrier {
    unsigned* bar; unsigned x;
    volatile LAS unsigned* st;
};

__device__ __forceinline__ XcdBarrier xcd_barrier_post(unsigned* bar, volatile LAS unsigned* st) {
    XcdBarrier b; b.bar = bar; b.x = xb_xcc_id(); b.st = st;
    if (threadIdx.x == 0) (void)xb_add(&bar[XB_XCNT(b.x)], 1u);
    return b;
}
__device__ __forceinline__ void xcd_barrier_complete(unsigned* bar, unsigned x, unsigned& nloc, unsigned& nx) {
    const unsigned G = gridDim.x * gridDim.y * gridDim.z;
    unsigned sum, cnt, mine, sp = 0u;
    for (;;) {
        sum = 0u; cnt = 0u; mine = 0u;
#pragma unroll
        for (unsigned j = 0; j < 16; ++j) { const unsigned c = xb_ld(&bar[XB_XCNT(j)]); sum += c; cnt += (c > 0u) ? 1u : 0u; mine = (j == x) ? c : mine; }
        if (sum == G) break;
        __builtin_amdgcn_s_sleep(1);
        if ((++sp & 255u) == 0u) { if (xb_ld(&bar[XB_TMO])) break; if (sp > XB_SPIN_CAP) { atomicAdd(&bar[XB_TMO], 1u); break; } }
    }
    nloc = mine > 0u ? mine : 1u; nx = cnt > 0u ? cnt : 1u;
}

__device__ __forceinline__ void xcd_barrier(const XcdBarrier& b) {
    asm volatile("s_waitcnt vmcnt(0)" ::: "memory");
    __syncthreads();
    if (threadIdx.x == 0) {
        unsigned* bar = b.bar;
        __builtin_amdgcn_s_waitcnt(0);
        unsigned nloc = b.st[0], nx = b.st[1];
        if (nloc == 0u) { xcd_barrier_complete(bar, b.x, nloc, nx); b.st[0] = nloc; b.st[1] = nx; }
        const unsigned old = xb_add(&bar[XB_XSUB(b.x)], 1u);
        const unsigned gen = old / nloc;
        if (old + 1u == (gen + 1u) * nloc) {
            __builtin_amdgcn_fence(__ATOMIC_RELEASE, "agent");
            asm volatile("s_waitcnt vmcnt(0)" ::: "memory");
            const unsigned og = xb_add(&bar[XB_TOP], 1u);
            const unsigned tg = og / nx;
            if (og + 1u == (tg + 1u) * nx) xb_add(&bar[XB_TOPGEN], 1u);
            else XB_SPIN(xb_ld(&bar[XB_TOPGEN]) == tg, bar);
            __builtin_amdgcn_fence(__ATOMIC_ACQUIRE, "agent");
            xb_add(&bar[XB_XGEN(b.x)], 1u);
            asm volatile("s_waitcnt vmcnt(0)" ::: "memory");
        } else {
            XB_SPIN(xb_ld(&bar[XB_XGEN(b.x)]) == gen, bar);
            __builtin_amdgcn_fence(__ATOMIC_ACQUIRE, "agent");
            asm volatile("s_waitcnt vmcnt(0)" ::: "memory");
        }
    }
    __syncthreads();
}
__device__ __forceinline__ float wave_sum(float v) {
#pragma unroll
    for (int o = 1; o < 64; o <<= 1) v += __shfl_xor(v, o);
    return v;
}
__device__ __forceinline__ unsigned cvtpk_rne(float lo, float hi) { typedef float f2 __attribute__((ext_vector_type(2))); typedef __bf16 b2 __attribute__((ext_vector_type(2)));
    f2 v = {lo, hi}; b2 b = __builtin_convertvector(v, b2); return __builtin_bit_cast(unsigned, b); }
__device__ __forceinline__ void p0_transpose_item64(const float* W, int K, int N, bf16* WT, LAS unsigned* scr, int item, int lane) {
    const int nblk = N / 64, kb = item / nblk, nb = item % nblk, k0 = 64 * kb, n0 = 64 * nb;
    const int g = lane >> 4, q = lane & 15;
    const float* src = W + (size_t)(k0 + 2 * g) * N + n0 + 4 * q;
    f32x4 v[16];
#pragma unroll
    for (int i = 0; i < 16; ++i) v[i] = *(const GAS f32x4*)(src + (size_t)(8 * (i >> 1) + (i & 1)) * N);
#pragma unroll
    for (int j = 0; j < 8; ++j)
#pragma unroll
        for (int e = 0; e < 4; ++e) scr[(4 * q + e) * 33 + 4 * j + g] = cvtpk_rne(v[2 * j][e], v[2 * j + 1][e]);
    LDS_WAIT(); asm volatile("" ::: "memory");
    const int c = lane & 7, nr = lane >> 3;
#pragma unroll
    for (int jj = 0; jj < 8; ++jj) { const int n = nr + 8 * jj; const LAS unsigned* s = scr + n * 33 + 4 * c;
        v4u o; o.x = s[0]; o.y = s[1]; o.z = s[2]; o.w = s[3];
        *(GAS v4u*)(WT + (size_t)(n0 + n) * K + k0 + 8 * c) = o; }
    LDS_WAIT(); asm volatile("" ::: "memory");
}


constexpr int NWAVES = 8;
constexpr int BATCH = 4, SEQ = 2048, DM = 2048, TOK = BATCH * SEQ, PW = 6144, DFF = 8192, HD = 128, DEPTH = 2;
constexpr int NHA = 6, NHB = 4, NHC = 6;
constexpr int COL_QA = 0, COL_KA = 768, COL_VA = 1536, COL_QB = 2304, COL_KB = 2816, COL_VB = 3328, COL_QC = 3840, COL_KC = 4608, COL_VC = 5376;
constexpr int MIX_A = 0, MIX_B = 768, MIX_C = 1280;
constexpr float EPS = 1e-6f;

constexpr size_t MiB = 1u << 20;
constexpr size_t WS_CTL = 0, CTL_ZERO_BYTES = 1 * MiB;
constexpr size_t WS_LUT = 1 * MiB;
constexpr size_t WS_WIN = 2 * MiB, WS_WOUT = 50 * MiB, WS_W1 = 66 * MiB, WS_W2 = 130 * MiB;
constexpr size_t WS_XB = 194 * MiB;
constexpr size_t WS_QKV = 226 * MiB;
constexpr size_t WS_MIX = 322 * MiB;
constexpr size_t WS_H = 226 * MiB;
constexpr size_t WS_PA = 354 * MiB;
constexpr size_t WS_LSE = 426 * MiB;
constexpr size_t WS_PB = 427 * MiB;
constexpr size_t WS_END = 459 * MiB;
constexpr int CW_BAR = 4096;
constexpr int CW_QUEUE = 8192;

constexpr int RING_OFF = 0, RING_BYTES = 131072;
constexpr int LDSCTL_OFF = RING_BYTES, MISC_OFF = LDSCTL_OFF + 320;
constexpr int LDS_BYTES = 147456;

struct Frame {
    LAS unsigned char* lds;
    volatile LAS unsigned* MISC;
    gu32* ctl;
    int tid, lane, wave, vcu, G;
};

namespace att {
typedef short bf16x8 __attribute__((ext_vector_type(8)));
typedef short s16x4 __attribute__((ext_vector_type(4)));
typedef float f32x16 __attribute__((ext_vector_type(16)));
typedef unsigned u32x4 __attribute__((ext_vector_type(4)));
typedef short v4i16_t __attribute__((ext_vector_type(4)));
constexpr int QP = PW;
constexpr int VPB = 320;
constexpr int VBYTES = 32 * VPB;

__device__ __forceinline__ int crow(int r, int hi) { return (r & 3) + 8 * (r >> 2) + 4 * hi; }
__device__ __forceinline__ unsigned cvtpk(float lo, float hi) { typedef float f2 __attribute__((ext_vector_type(2))); typedef __bf16 b2 __attribute__((ext_vector_type(2)));
    f2 v = {lo, hi}; b2 b = __builtin_convertvector(v, b2); return __builtin_bit_cast(unsigned, b); }
__device__ __forceinline__ s16x4 vtr(LAS const unsigned char* p) { return __builtin_bit_cast(s16x4, __builtin_amdgcn_ds_read_tr16_b64_v4i16((LAS v4i16_t*)p)); }

template <int NKS> __device__ __forceinline__ f32x16 qk_tile(const bf16x8 (&qf)[NKS], const bf16* krow) {
    bf16x8 kf[NKS];
#pragma unroll
    for (int ks = 0; ks < NKS; ++ks) kf[ks] = *(const bf16x8*)(krow + 16 * ks);
    f32x16 st = {0.f, 0.f, 0.f, 0.f, 0.f, 0.f, 0.f, 0.f, 0.f, 0.f, 0.f, 0.f, 0.f, 0.f, 0.f, 0.f};
#pragma unroll
    for (int ks = 0; ks < NKS; ++ks) st = __builtin_amdgcn_mfma_f32_32x32x16_bf16(kf[ks], qf[ks], st, 0, 0, 0);
    return st;
}
constexpr int VBLK = 1088;
__device__ __forceinline__ void dma_v(LAS unsigned char* vl, const bf16* Vb, int tk0, int tks, int lane) {
    const bf16* p = Vb + (size_t)(tk0 + 8 * tks * (lane >> 4)) * QP + (lane & 15) * 8; const size_t step = (size_t)tks * QP;
#pragma unroll
    for (int i = 0; i < 8; ++i) { __builtin_amdgcn_global_load_lds((const unsigned*)p, (LAS unsigned*)(vl + i * VBLK), 16, 0, 0); p += step; }
}
__device__ __forceinline__ void dma_wait() { asm volatile("s_waitcnt vmcnt(0)" ::: "memory"); }
__device__ __forceinline__ void pv_tile(f32x16 (&o)[4], const bf16x8 (&pa)[2], LAS const unsigned char* vl, int lane) {
    const int hi = lane >> 5, g1 = (lane >> 4) & 1, i = lane & 15;
    LAS const unsigned char* base = vl + (4 * hi + (i >> 2)) * VBLK + (16 * g1 + 4 * (i & 3)) * 2;
#pragma unroll
    for (int db = 0; db < 4; ++db)
#pragma unroll
        for (int s = 0; s < 2; ++s) {
            const s16x4 lo = vtr(base + s * 512 + db * 64);
            const s16x4 hh = vtr(base + s * 512 + 256 + db * 64);
            const bf16x8 vf = {lo[0], lo[1], lo[2], lo[3], hh[0], hh[1], hh[2], hh[3]};
            o[db] = __builtin_amdgcn_mfma_f32_32x32x16_bf16(pa[s], vf, o[db], 0, 0, 0);
        }
}

constexpr float LOG2E = 1.4426950408889634f;
constexpr float THR2 = 6.0f;
__device__ __forceinline__ float ex2(float x) { return __builtin_amdgcn_exp2f(x); }
__device__ __forceinline__ float lg2(float x) { return __builtin_amdgcn_logf(x); }
__device__ __forceinline__ constexpr int ccol(int r) { return (r & 3) + 8 * (r >> 2); }

template <int NKS> __device__ __forceinline__ void load_k(bf16x8 (&kf)[NKS], const bf16* krow) {
#pragma unroll
    for (int ks = 0; ks < NKS; ++ks) kf[ks] = *(const bf16x8*)(krow + 16 * ks);
}
template <int NKS> __device__ __forceinline__ f32x16 qk_mma(const bf16x8 (&kf)[NKS], const bf16x8 (&qf)[NKS]) {
    f32x16 st = {0.f, 0.f, 0.f, 0.f, 0.f, 0.f, 0.f, 0.f, 0.f, 0.f, 0.f, 0.f, 0.f, 0.f, 0.f, 0.f};
#pragma unroll
    for (int ks = 0; ks < NKS; ++ks) st = __builtin_amdgcn_mfma_f32_32x32x16_bf16(kf[ks], qf[ks], st, 0, 0, 0);
    return st;
}
__device__ __forceinline__ void pack_p(bf16x8 (&pa)[2], const float (&t)[16]) {
    u32x4 w0 = {cvtpk(t[0], t[1]), cvtpk(t[2], t[3]), cvtpk(t[4], t[5]), cvtpk(t[6], t[7])}, w1 = {cvtpk(t[8], t[9]), cvtpk(t[10], t[11]), cvtpk(t[12], t[13]), cvtpk(t[14], t[15])};
    pa[0] = __builtin_bit_cast(bf16x8, w0); pa[1] = __builtin_bit_cast(bf16x8, w1);
}
__device__ __forceinline__ void sm_tile(float (&xm)[16], bool first, float& m2, float& l, f32x16 (&o)[4], bf16x8 (&pa)[2], int hi) {
    float a = fmaxf(fmaxf(xm[0], xm[1]), fmaxf(xm[2], xm[3])), b = fmaxf(fmaxf(xm[4], xm[5]), fmaxf(xm[6], xm[7]));
    a = fmaxf(a, fmaxf(fmaxf(xm[8], xm[9]), fmaxf(xm[10], xm[11]))); b = fmaxf(b, fmaxf(fmaxf(xm[12], xm[13]), fmaxf(xm[14], xm[15])));
    float mt = fmaxf(a, b); mt = fmaxf(mt, __shfl_xor(mt, 32));
    if (first) {
        m2 += mt;
#pragma unroll
        for (int r = 0; r < 16; ++r) xm[r] -= mt;
    } else if (__any(mt > THR2)) {
        const float d = fmaxf(mt, 0.f), alpha = ex2(-d); m2 += d; l *= alpha;
#pragma unroll
        for (int r = 0; r < 16; ++r) xm[r] -= d;
#pragma unroll
        for (int r = 0; r < 16; ++r) { const float f = __shfl(alpha, crow(r, hi));
#pragma unroll
            for (int db = 0; db < 4; ++db) o[db][r] *= f; }
    }
    float ls = 0.f;
#pragma unroll
    for (int r = 0; r < 16; ++r) { xm[r] = ex2(xm[r]); ls += xm[r]; }
    l += ls;
    pack_p(pa, xm);
}
__device__ __forceinline__ void store_o_bf16(const f32x16 (&o)[4], float fq  , bool use_f, bf16* Ob, int tok0, int tstride, int pitch, LAS unsigned char* vl, int lane) {
    const int qi = lane & 31, hi = lane >> 5;
#pragma unroll
    for (int r = 0; r < 16; ++r) { const int qq = crow(r, hi); const float f = use_f ? __shfl(fq, qq) : 1.0f;
#pragma unroll
        for (int db = 0; db < 4; ++db) *(LAS unsigned short*)(vl + qq * VPB + (32 * db + qi) * 2) = (unsigned short)(cvtpk(o[db][r] * f, 0.f) & 0xffffu); }
    asm volatile("s_waitcnt lgkmcnt(0)" ::: "memory");
#pragma unroll
    for (int i = 0; i < 8; ++i) { const int row = 4 * i + (lane >> 4); const u32x4 v = *(LAS const u32x4*)(vl + row * VPB + (lane & 15) * 16);
        *(u32x4*)(Ob + (size_t)(tok0 + tstride * row) * pitch + (lane & 15) * 8) = v; }
    asm volatile("s_waitcnt lgkmcnt(0)" ::: "memory");
}

__device__ __forceinline__ void diff_item(const bf16* Qb, const bf16* Kb, const bf16* Vb, int qt, const float* lut2, const int* thrtab, bf16* Ob, LAS unsigned char* vl, int lane_in) {
    int lane = lane_in; asm volatile("" : "+v"(lane));
    const int qi = lane & 31, hi = lane >> 5; const float c1 = 0.125f * LOG2E;
    bf16x8 qf[4]; load_k<4>(qf, Qb + (size_t)(32 * qt + qi) * QP + 8 * hi);
    f32x16 o[4];
#pragma unroll
    for (int db = 0; db < 4; ++db)
#pragma unroll
        for (int r = 0; r < 16; ++r) o[db][r] = 0.f;
    float m2 = 0.f, l = 0.f;
    bf16x8 kf[4];
    load_k<4>(kf, Kb + (size_t)qi * QP + 8 * hi);
#pragma nounroll
    for (int kt = 0; kt <= qt; ++kt) {
        const int D = qt - kt, ktn = kt < qt ? kt + 1 : qt;
        const int thr = thrtab[D];
        float xm[16]; bf16x8 pa[2];
        if (thr < 0) {
            const int dl = 32 * D + lane - 31; const float bl = lut2[dl < 0 ? 0 : dl];
            const f32x16 st = qk_mma<4>(kf, qf);
            dma_v(vl, Vb, 32 * kt, 1, lane);
            load_k<4>(kf, Kb + (size_t)(32 * ktn + qi) * QP + 8 * hi);
            const int sl = qi + 31 - 4 * hi;
#pragma unroll
            for (int r = 0; r < 16; ++r) xm[r] = st[r] * c1 + (__shfl(bl, sl - ccol(r)) - m2);
            if (D == 0) {
#pragma unroll
                for (int r = 0; r < 16; ++r) xm[r] = (crow(r, hi) <= qi) ? xm[r] : -INFINITY;
            }
        } else {
            const float b0m = lut2[32 * D - 31] - m2, b1m = lut2[32 * D + 31] - m2; const int y2 = 32 * D + qi - thr - 4 * hi;
            const f32x16 st = qk_mma<4>(kf, qf);
            dma_v(vl, Vb, 32 * kt, 1, lane);
            load_k<4>(kf, Kb + (size_t)(32 * ktn + qi) * QP + 8 * hi);
#pragma unroll
            for (int r = 0; r < 16; ++r) xm[r] = st[r] * c1 + ((ccol(r) <= y2) ? b1m : b0m);
        }
        sm_tile(xm, kt == 0, m2, l, o, pa, hi);
        dma_wait();
        pv_tile(o, pa, vl, lane);
    }
    const float lt = l + __shfl_xor(l, 32);
    store_o_bf16(o, 1.0f / lt, true, Ob, 32 * qt, 1, 512, vl, lane);
}

__device__ __forceinline__ void dil_item(const bf16* Qb, const bf16* Kb, const bf16* Vb, int dil, int rr, int n32, const float* lut2, bf16* Ob, float* lseb, LAS unsigned char* vl, int lane_in) {
    int lane = lane_in; asm volatile("" : "+v"(lane));
    const int qi = lane & 31, hi = lane >> 5; const float c1 = 0.08838834764831845f * LOG2E;
    const int tq0 = 32 * n32 * dil + rr;
    bf16x8 qf[8]; load_k<8>(qf, Qb + (size_t)(tq0 + qi * dil) * QP + 8 * hi);
    f32x16 o[4];
#pragma unroll
    for (int db = 0; db < 4; ++db)
#pragma unroll
        for (int r = 0; r < 16; ++r) o[db][r] = 0.f;
    float m2 = 0.f, l = 0.f;
    const int kt_lo = n32 >= 4 ? 0 : 4 - n32;
#pragma nounroll
    for (int kt = kt_lo; kt <= 4; ++kt) {
        const int tkc = 32 * (n32 - 4 + kt) * dil + rr;
        bf16x8 kf[8]; load_k<8>(kf, Kb + (size_t)(tkc + qi * dil) * QP + 8 * hi);
        dma_v(vl, Vb, tkc, dil, lane);
        int dl = (128 - 32 * kt + lane - 31) * dil; dl = dl < 0 ? 0 : (dl > 2047 ? 2047 : dl);
        const float bl = lut2[dl];
        const f32x16 st = qk_mma<8>(kf, qf);
        float xm[16]; bf16x8 pa[2];
        const int sl = qi + 31 - 4 * hi;
#pragma unroll
        for (int r = 0; r < 16; ++r) xm[r] = st[r] * c1 + (__shfl(bl, sl - ccol(r)) - m2);
        if (kt == 0) {
#pragma unroll
            for (int r = 0; r < 16; ++r) xm[r] = (crow(r, hi) >= qi) ? xm[r] : -INFINITY;
        }
        if (kt == 4) {
#pragma unroll
            for (int r = 0; r < 16; ++r) xm[r] = (crow(r, hi) <= qi) ? xm[r] : -INFINITY;
        }
        sm_tile(xm, kt == kt_lo, m2, l, o, pa, hi);
        dma_wait();
        pv_tile(o, pa, vl, lane);
    }
    const float lt = l + __shfl_xor(l, 32);
    if (lane < 32) lseb[(size_t)(tq0 + qi * dil) * 6] = m2 + lg2(lt);
    store_o_bf16(o, 1.0f / lt, true, Ob, tq0, dil, 768, vl, lane);
}

__device__ __forceinline__ void stick_item(const bf16* Qb, const bf16* Kb, const bf16* Vb, int qt, bf16* Ob, LAS unsigned char* vl, int lane_in) {
    int lane = lane_in; asm volatile("" : "+v"(lane));
    const int qi = lane & 31, hi = lane >> 5; const float c1 = 0.08838834764831845f * LOG2E;
    bf16x8 qf[8]; load_k<8>(qf, Qb + (size_t)(32 * qt + qi) * QP + 8 * hi);
    f32x16 o[4];
#pragma unroll
    for (int db = 0; db < 4; ++db)
#pragma unroll
        for (int r = 0; r < 16; ++r) o[db][r] = 0.f;
    float R = 0.f;
    bf16x8 kf[8];
    load_k<8>(kf, Kb + (size_t)(32 * qt + qi) * QP + 8 * hi);
#pragma nounroll
    for (int kt = qt; kt >= 0; --kt) {
        const int ktn = kt > 0 ? kt - 1 : 0;
        const f32x16 st = qk_mma<8>(kf, qf);
        dma_v(vl, Vb, 32 * kt, 1, lane);
        load_k<8>(kf, Kb + (size_t)(32 * ktn + qi) * QP + 8 * hi);
        float u[16], zl[16];
#pragma unroll
        for (int r = 0; r < 16; ++r) { const float z = st[r] * c1; const float sp = fmaxf(z, 0.f) + lg2(1.0f + ex2(-fabsf(z)));
            u[r] = -sp; zl[r] = z - sp; }
        if (kt == qt) {
#pragma unroll
            for (int r = 0; r < 16; ++r) { const bool v = crow(r, hi) < qi; u[r] = v ? u[r] : 0.f; zl[r] = v ? zl[r] : -INFINITY; }
        }
        float gs[4], pg[4], tot[4], aft[4];
#pragma unroll
        for (int c = 0; c < 4; ++c) { gs[c] = (u[4 * c] + u[4 * c + 1]) + (u[4 * c + 2] + u[4 * c + 3]); pg[c] = __shfl_xor(gs[c], 32); tot[c] = gs[c] + pg[c]; }
        aft[3] = (hi == 0) ? pg[3] : 0.f;
        aft[2] = tot[3] + ((hi == 0) ? pg[2] : 0.f);
        aft[1] = tot[3] + tot[2] + ((hi == 0) ? pg[1] : 0.f);
        aft[0] = tot[3] + tot[2] + tot[1] + ((hi == 0) ? pg[0] : 0.f);
        float a[16];
#pragma unroll
        for (int c = 0; c < 4; ++c) { const float b = R + aft[c];
            const float s2 = u[4 * c + 3], s1 = s2 + u[4 * c + 2], s0 = s1 + u[4 * c + 1];
            a[4 * c + 3] = ex2(zl[4 * c + 3] + b); a[4 * c + 2] = ex2(zl[4 * c + 2] + (b + s2));
            a[4 * c + 1] = ex2(zl[4 * c + 1] + (b + s1)); a[4 * c + 0] = ex2(zl[4 * c + 0] + (b + s0)); }
        R += (tot[0] + tot[1]) + (tot[2] + tot[3]);
        bf16x8 pa[2]; pack_p(pa, a);
        dma_wait();
        pv_tile(o, pa, vl, lane);
        if (__all(R < -150.0f)) break;
    }
    store_o_bf16(o, 1.0f, false, Ob, 32 * qt, 1, DM, vl, lane);
}
}

__device__ __forceinline__ void rms_row_to_bf16(const float* xrow, const float* g, bf16* orow, int lane) {
    const GAS f32x4* xr = (const GAS f32x4*)xrow + lane; const GAS f32x4* gr = (const GAS f32x4*)g + lane;
    f32x4 v[8]; float s = 0.f;
#pragma unroll
    for (int j = 0; j < 8; ++j) { v[j] = xr[64 * j]; s += (v[j].x * v[j].x + v[j].y * v[j].y) + (v[j].z * v[j].z + v[j].w * v[j].w); }
    const float rstd = 1.0f / sqrtf(wave_sum(s) * (1.0f / DM) + EPS);
    GAS unsigned long long* o8 = (GAS unsigned long long*)orow + lane;
#pragma unroll
    for (int j = 0; j < 8; ++j) { const f32x4 gg = gr[64 * j]; const f32x4 y = v[j] * rstd * gg;
        o8[64 * j] = (unsigned long long)pk2(y.x, y.y) | ((unsigned long long)pk2(y.z, y.w) << 32); }
}
__device__ __forceinline__ void rms_row_to_f32(const float* xrow, const float* g, float* orow, int lane) {
    const GAS f32x4* xr = (const GAS f32x4*)xrow + lane; const GAS f32x4* gr = (const GAS f32x4*)g + lane;
    f32x4 v[8]; float s = 0.f;
#pragma unroll
    for (int j = 0; j < 8; ++j) { v[j] = xr[64 * j]; s += (v[j].x * v[j].x + v[j].y * v[j].y) + (v[j].z * v[j].z + v[j].w * v[j].w); }
    const float rstd = 1.0f / sqrtf(wave_sum(s) * (1.0f / DM) + EPS);
    GAS f32x4* o4 = (GAS f32x4*)orow + lane;
#pragma unroll
    for (int j = 0; j < 8; ++j) { const f32x4 gg = gr[64 * j]; o4[64 * j] = v[j] * rstd * gg; }
}
__device__ __forceinline__ int t5_bucket(int n) {
    if (n < 16) return n;
    const int v = 16 + (int)(logf((float)n / 16.0f) / 4.852030263919617f * 16.0f);
    return v < 31 ? v : 31;
}

struct Args { const float* in[14]; float* out; unsigned char* ws; int ph_lo, ph_hi, use_bar, pad; };
constexpr int N_PHASES = 1 + 8 * DEPTH;
#ifndef PROBE_DUP
#define PROBE_DUP -1
#endif
constexpr int N_STEPS = N_PHASES + (PROBE_DUP < 0 ? 0 : (PROBE_DUP == 100 ? 1 : 2));
__device__ __forceinline__ int step_phase(int i) {
    if (PROBE_DUP < 0) return i;
    if (PROBE_DUP == 100) return i == 0 ? 0 : i - 1;
    const int A = 1 + PROBE_DUP, B = 9 + PROBE_DUP;
    if (i <= A) return i; if (i == A + 1) return A; if (i <= B + 1) return i - 1; if (i == B + 2) return B; return i - 2;
}

__global__ void __launch_bounds__(NWAVES * 64, 2) fwd_kernel(Args args) {
    extern __shared__ __attribute__((aligned(16))) unsigned char lds_raw[];
    Frame F;
    F.lds = (LAS unsigned char*)lds_raw;
    F.MISC = (volatile LAS unsigned*)(F.lds + MISC_OFF);
    F.tid = threadIdx.x; F.lane = F.tid & 63; F.wave = __builtin_amdgcn_readfirstlane(F.tid >> 6);
    F.G = gridDim.x; { const int bx = blockIdx.x; F.vcu = (F.G % 8 == 0) ? (bx % 8) * (F.G / 8) + bx / 8 : bx; }
    unsigned char* ws = args.ws;
    F.ctl = (gu32*)(ws + WS_CTL);
    const float* x_in = args.in[0]; const float* w_in = args.in[1]; const float* w_out = args.in[2]; const float* g_attn = args.in[3]; const float* g_mlp = args.in[4];
    const float* w1 = args.in[5]; const float* w2 = args.in[6]; const float* rel_tab = args.in[7];
    const float* lq1 = args.in[8]; const float* lk1 = args.in[9]; const float* lq2 = args.in[10]; const float* lk2 = args.in[11]; const float* subln_g = args.in[12]; const float* g_final = args.in[13];
    float* out = args.out;
    bf16* WIN_T = (bf16*)(ws + WS_WIN); bf16* WOUT_T = (bf16*)(ws + WS_WOUT); bf16* W1_T = (bf16*)(ws + WS_W1); bf16* W2_T = (bf16*)(ws + WS_W2);
    bf16* XB = (bf16*)(ws + WS_XB); bf16* QKV = (bf16*)(ws + WS_QKV); bf16* MIX = (bf16*)(ws + WS_MIX); bf16* HB = (bf16*)(ws + WS_H);
    bf16* PAH = (bf16*)(ws + WS_PA); float* LSE = (float*)(ws + WS_LSE); bf16* PBH = (bf16*)(ws + WS_PB); float* LUT = (float*)(ws + WS_LUT);

    for (int u = F.tid; u < (LDS_BYTES - LDSCTL_OFF) / 4; u += NWAVES * 64) ((LAS unsigned*)(F.lds + LDSCTL_OFF))[u] = 0u;
    __syncthreads();
    XcdBarrier bar; bar.bar = (unsigned*)(F.ctl + CW_BAR); bar.x = 0; bar.st = nullptr;
    if (args.use_bar) bar = xcd_barrier_post((unsigned*)(F.ctl + CW_BAR), F.MISC + 8);

    const int NGW = F.G * NWAVES;

    for (int step = args.ph_lo; step < args.ph_hi; ++step) {
        const int ph = step_phase(step);
        int tid = threadIdx.x; asm volatile("" : "+v"(tid));
        const int lane = tid & 63, wave = __builtin_amdgcn_readfirstlane(tid >> 6), gw = F.vcu * NWAVES + wave;
        const int l = ph > 0 ? ((ph - 1) >> 3) : 0, pt = ph > 0 ? ((ph - 1) & 7) : -1;
        if (pt == 0 || pt == 3 || pt == 5 || pt == 6) {
            pg8::Gemm g; pg8::EpiAny E; int N;
            if (pt == 0)      { g.A = XB;  g.Bt = WIN_T + (size_t)l * PW * DM;  N = PW;  g.K = DM;  E.mode = 0; E.O = QKV; E.base = nullptr; E.out = nullptr; E.ldc = PW; }
            else if (pt == 3) { g.A = MIX; g.Bt = WOUT_T + (size_t)l * DM * DM; N = DM;  g.K = DM;  E.mode = 2; E.O = nullptr; E.base = (l == 0) ? x_in : (const float*)out; E.out = out; E.ldc = DM; }
            else if (pt == 5) { g.A = XB;  g.Bt = W1_T + (size_t)l * DFF * DM;  N = DFF; g.K = DM;  E.mode = 1; E.O = HB; E.base = nullptr; E.out = nullptr; E.ldc = DFF; }
            else              { g.A = HB;  g.Bt = W2_T + (size_t)l * DM * DFF;  N = DM;  g.K = DFF; E.mode = 2; E.O = nullptr; E.base = (const float*)out; E.out = out; E.ldc = DM; }
            g.M = TOK; g.N = N; E.perm = (E.mode != 2);
            pg8::StaticOrder S; S.init(TOK, N, F.G, (int)blockIdx.x);
            pg8::gemm_phase<pg8::EpiAny, pg8::StaticOrder, true, true>(F.lds + RING_OFF, g, S, E);
        } else if (ph == 0) {
            LAS unsigned* scr = (LAS unsigned*)(F.lds + RING_OFF + wave * 16384);
            constexpr int I_IN = (DM / 64) * (PW / 64), I_OUT = (DM / 64) * (DM / 64), I_1 = (DM / 64) * (DFF / 64), I_2 = (DFF / 64) * (DM / 64), I_L = I_IN + I_OUT + I_1 + I_2;
            for (int it = gw; it < DEPTH * I_L; it += NGW) {
                const int ll = it / I_L; int r = it % I_L;
                const float* W; bf16* WT; int K, N;
                if (r < I_IN) { W = w_in + (size_t)ll * DM * PW; WT = WIN_T + (size_t)ll * PW * DM; K = DM; N = PW; }
                else if ((r -= I_IN) < I_OUT) { W = w_out + (size_t)ll * DM * DM; WT = WOUT_T + (size_t)ll * DM * DM; K = DM; N = DM; }
                else if ((r -= I_OUT) < I_1) { W = w1 + (size_t)ll * DM * DFF; WT = W1_T + (size_t)ll * DFF * DM; K = DM; N = DFF; }
                else { r -= I_1; W = w2 + (size_t)ll * DFF * DM; WT = W2_T + (size_t)ll * DM * DFF; K = DFF; N = DM; }
                p0_transpose_item64(W, K, N, WT, scr, r, lane);
            }
            for (int i = blockIdx.x * (NWAVES * 64) + tid; i < 10 * 2048; i += F.G * NWAVES * 64) { const int h = i >> 11, d = i & 2047; LUT[i] = rel_tab[t5_bucket(d) * 10 + h] * att::LOG2E; }
            if (blockIdx.x == 0 && tid < 64) {
                const int D = tid, dlo = 32 * D - 31 < 0 ? 0 : 32 * D - 31, dhi = 32 * D + 31, bl = t5_bucket(dlo), bh = t5_bucket(dhi); int thr = -1;
                if (D > 0 && bl == bh) thr = 1 << 30;
                else if (D > 0 && bh == bl + 1) { thr = dhi; for (int d = dhi; d >= dlo; --d) if (t5_bucket(d) == bh) thr = d; }
                ((int*)(LUT + 10 * 2048))[D] = thr;
            }
            for (int m = gw; m < TOK; m += NGW) rms_row_to_bf16(x_in + (size_t)m * DM, g_attn, XB + (size_t)m * DM, lane);
        } else if (pt == 1) {
            LAS unsigned char* vl = F.lds + RING_OFF + wave * att::VBYTES;
            const int* thrtab = (const int*)(LUT + 10 * 2048);
            for (int s = gw; s < 2048; s += NGW) {
                const int combo = s >> 6, j = s & 63, qt = (j & 1) ? 63 - (j >> 1) : (j >> 1), b = combo >> 3, vh = combo & 7, h = vh >> 1, p = vh & 1;
                const bf16* base = QKV + (size_t)b * SEQ * PW;
                att::diff_item(base + COL_QB + h * HD + p * 64, base + COL_KB + h * HD + p * 64, base + COL_VB + h * HD, qt, LUT + (6 + h) * 2048, thrtab,
                               PBH + ((size_t)p * TOK + (size_t)b * SEQ) * 512 + h * HD, vl, lane);
            }
            gu32* qctr = F.ctl + CW_QUEUE + 64 * step;
            for (;;) {
                unsigned idx = 0; if (lane == 0) idx = __hip_atomic_fetch_add(qctr, 1u, __ATOMIC_RELAXED, __HIP_MEMORY_SCOPE_AGENT);
                idx = (unsigned)__builtin_amdgcn_readfirstlane((int)idx);
                if (idx >= 768u + 1152u) break;
                if (idx < 768u) {
                    const int bh = (int)idx >> 5, jj = (int)idx & 31, b = bh / 6, h = bh % 6; const bf16* base = QKV + (size_t)b * SEQ * PW;
#pragma nounroll
                    for (int rep = 0; rep < 2; ++rep)
                        att::stick_item(base + COL_QC + h * HD, base + COL_KC + h * HD, base + COL_VC + h * HD, 63 - (2 * jj + rep), MIX + (size_t)b * SEQ * DM + MIX_C + h * HD, vl, lane);
                } else {
                    const int i2 = (int)idx - 768, p = i2 / 384, rem = i2 % 384, bh = rem >> 4, j4 = rem & 15, b = bh / 6, h = bh % 6;
                    const int dil = p == 0 ? 1 : (p == 1 ? 4 : 16), tpr = 64 / dil;
                    const bf16* base = QKV + (size_t)b * SEQ * PW;
#pragma nounroll
                    for (int rep = 0; rep < 4; ++rep) { const int j = 4 * j4 + rep;
                        att::dil_item(base + COL_QA + h * HD, base + COL_KA + h * HD, base + COL_VA + h * HD, dil, j / tpr, j % tpr, LUT + h * 2048,
                                      PAH + ((size_t)p * TOK + (size_t)b * SEQ) * 768 + h * HD, LSE + ((size_t)p * TOK + (size_t)b * SEQ) * 6 + h, vl, lane); }
                }
            }
        } else if (pt == 2) {
            const float lam_init = 0.8f - 0.6f * expf(-0.3f * (float)l);
            const float s1 = wave_sum(lq1[l * 64 + lane] * lk1[l * 64 + lane]), s2 = wave_sum(lq2[l * 64 + lane] * lk2[l * 64 + lane]);
            const float lam = expf(s1) - expf(s2) + lam_init;
            const float gx = subln_g[l * HD + 2 * lane] * (1.0f - lam_init), gy = subln_g[l * HD + 2 * lane + 1] * (1.0f - lam_init);
            typedef float f32x2 __attribute__((ext_vector_type(2)));
            for (int tok = gw; tok < TOK; tok += NGW) {
                GAS unsigned* mrow = (GAS unsigned*)(MIX + (size_t)tok * DM);
#pragma unroll
                for (int h = 0; h < NHA; ++h) {
                    const float l0 = LSE[((size_t)0 * TOK + tok) * 6 + h], l1 = LSE[((size_t)1 * TOK + tok) * 6 + h], l2 = LSE[((size_t)2 * TOK + tok) * 6 + h];
                    const float mx = fmaxf(l0, fmaxf(l1, l2)); float w0 = att::ex2(l0 - mx), w1_ = att::ex2(l1 - mx), w2_ = att::ex2(l2 - mx); const float inv = 1.0f / (w0 + w1_ + w2_);
                    w0 *= inv; w1_ *= inv; w2_ *= inv;
                    const unsigned a = *(const GAS unsigned*)(PAH + ((size_t)0 * TOK + tok) * 768 + h * HD + 2 * lane), b = *(const GAS unsigned*)(PAH + ((size_t)1 * TOK + tok) * 768 + h * HD + 2 * lane),
                                   c = *(const GAS unsigned*)(PAH + ((size_t)2 * TOK + tok) * 768 + h * HD + 2 * lane);
                    const float ax = __uint_as_float(a << 16), ay = __uint_as_float(a & 0xffff0000u), bx = __uint_as_float(b << 16), by = __uint_as_float(b & 0xffff0000u), cx = __uint_as_float(c << 16), cy = __uint_as_float(c & 0xffff0000u);
                    mrow[(MIX_A + h * HD) / 2 + lane] = cvtpk_rne(w0 * ax + w1_ * bx + w2_ * cx, w0 * ay + w1_ * by + w2_ * cy);
                }
#pragma unroll
                for (int h = 0; h < NHB; ++h) {
                    const unsigned a = *(const GAS unsigned*)(PBH + ((size_t)0 * TOK + tok) * 512 + h * HD + 2 * lane), b = *(const GAS unsigned*)(PBH + ((size_t)1 * TOK + tok) * 512 + h * HD + 2 * lane);
                    const float ox = __uint_as_float(a << 16) - lam * __uint_as_float(b << 16), oy = __uint_as_float(a & 0xffff0000u) - lam * __uint_as_float(b & 0xffff0000u);
                    const float rstd = 1.0f / sqrtf(wave_sum(ox * ox + oy * oy) * (1.0f / HD) + EPS);
                    mrow[(MIX_B + h * HD) / 2 + lane] = cvtpk_rne(ox * rstd * gx, oy * rstd * gy);
                }
            }
        } else if (pt == 4) {
            for (int m = gw; m < TOK; m += NGW) rms_row_to_bf16(out + (size_t)m * DM, g_mlp + (size_t)l * DM, XB + (size_t)m * DM, lane);
        } else {
            if (l + 1 < DEPTH) { for (int m = gw; m < TOK; m += NGW) rms_row_to_bf16(out + (size_t)m * DM, g_attn + (size_t)(l + 1) * DM, XB + (size_t)m * DM, lane); }
            else { for (int m = gw; m < TOK; m += NGW) rms_row_to_f32(out + (size_t)m * DM, g_final, out + (size_t)m * DM, lane); }
        }
        if (step + 1 < args.ph_hi) xcd_barrier(bar);
    }
}

#ifndef MK_PER_PHASE
#define MK_PER_PHASE 0
#endif
extern "C" void kernel_launch(void* const* d_in, const int* in_sizes, int n_in, void* d_out, int out_size, void* d_ws, size_t ws_size, hipStream_t stream) {
    static int grid = 0;
    if (grid == 0) {
        if (n_in != 14 || out_size != TOK * DM || ws_size < WS_END) { fprintf(stderr, "kernel_launch: unexpected shapes (n_in %d out %d ws %zu)\n", n_in, out_size, ws_size); grid = -1; return; }
        int dev = 0, cus = 0, per_cu = 0;
        if (hipGetDevice(&dev) != hipSuccess || hipDeviceGetAttribute(&cus, hipDeviceAttributeMultiprocessorCount, dev) != hipSuccess) { grid = -1; return; }
        if (hipFuncSetAttribute((const void*)fwd_kernel, hipFuncAttributeMaxDynamicSharedMemorySize, LDS_BYTES) != hipSuccess) { fprintf(stderr, "kernel_launch: hipFuncSetAttribute failed\n"); grid = -1; return; }
        if (hipOccupancyMaxActiveBlocksPerMultiprocessor(&per_cu, (const void*)fwd_kernel, NWAVES * 64, LDS_BYTES) != hipSuccess || per_cu < 1) { fprintf(stderr, "kernel_launch: occupancy query says %d blocks per CU\n", per_cu); grid = -1; (void)hipGetLastError(); return; }
        (void)hipGetLastError();
        grid = cus;
    }
    if (grid < 0) return;
    if (hipMemsetAsync((char*)d_ws + WS_CTL, 0, CTL_ZERO_BYTES, stream) != hipSuccess) return;
    Args a{};
    for (int i = 0; i < 14; ++i) a.in[i] = (const float*)d_in[i];
    a.out = (float*)d_out; a.ws = (unsigned char*)d_ws;
#if MK_PER_PHASE
    for (int ph = 0; ph < N_STEPS; ++ph) { a.ph_lo = ph; a.ph_hi = ph + 1; a.use_bar = 0; hipLaunchKernelGGL(fwd_kernel, dim3(grid), dim3(NWAVES * 64), LDS_BYTES, stream, a); }
#else
    a.ph_lo = 0; a.ph_hi = N_STEPS; a.use_bar = 1;
    void* kargs[] = {(void*)&a};
    const hipError_t le = hipLaunchCooperativeKernel((const void*)fwd_kernel, dim3(grid), dim3(NWAVES * 64), kargs, (unsigned)LDS_BYTES, stream);
    if (le != hipSuccess) fprintf(stderr, "kernel_launch: cooperative launch failed: %s (grid %d x %d threads, %d B LDS)\n", hipGetErrorName(le), grid, NWAVES * 64, LDS_BYTES);
#endif
}
```

```cpp
#include <hip/hip_runtime.h>
#include <cstdio>
#include <cstdint>
#include <cmath>
namespace pg8 {
#define PG8_LAS __attribute__((address_space(3)))
typedef unsigned short bf16_t;
typedef short bf16x8 __attribute__((ext_vector_type(8)));
typedef float f32x4 __attribute__((ext_vector_type(4)));
typedef unsigned u32x4 __attribute__((ext_vector_type(4)));
constexpr int BM = 256, BK = 64, HALF = 128, HTB = HALF * BK * 2  , STAGE_BYTES = 8 * HTB, NXCD = 8, WGM = 8;

__host__ __device__ __forceinline__ int lds_byte(int r, int c) { const int st = (r >> 4) * 2 + (c >> 5), rr = r & 15, cc = c & 31, ob = rr * 64 + cc * 2; return st * 1024 + (ob ^ (((ob >> 9) & 1) << 5)); }
__host__ __device__ __forceinline__ void stage_rc(int b, int& R, int& C) { const int st = b / 1024, sb = b % 1024, swz = sb ^ (((sb >> 9) & 1) << 5); R = (st >> 1) * 16 + swz / 64; C = (st & 1) * 32 + (swz % 64) / 2; }
__host__ __device__ __forceinline__ int perm32(int rho) { const int n = rho >> 4, i = rho & 15; return 8 * (i >> 2) + 4 * n + (i & 3); }

struct Unit { int pm, pn; };
struct Gemm { const bf16_t* A; const bf16_t* Bt; int M, N, K; };

struct StaticOrder {
    int nM, nN, nwg, G, c;
    __host__ __device__ void init(int M, int N, int G_, int c_) { nM = M / BM; nN = N / BM; nwg = nM * nN; G = G_; c = c_; }
    __host__ __device__ bool next(int i, Unit& u) const {
        const long L = (long)i * G + c; if (L >= nwg) return false;
        int wgid = (int)L; { const int q = nwg / NXCD, r = nwg % NXCD, xcd = wgid % NXCD, off = wgid / NXCD; wgid = (xcd < r ? xcd * (q + 1) : r * (q + 1) + (xcd - r) * q) + off; }
        const int nig = WGM * nN, gid = wgid / nig, fm = gid * WGM, gsz = (nM - fm) < WGM ? (nM - fm) : WGM;
        u.pm = fm + ((wgid % nig) % gsz); u.pn = (wgid % nig) / gsz; return true;
    }
    __device__ __forceinline__ void a_ready(const Unit&) const {}
    __device__ __forceinline__ void done(const Unit&) const {}
};

__device__ __forceinline__ unsigned cvt_pk_bf16(float lo, float hi) { unsigned r; asm volatile("v_cvt_pk_bf16_f32 %0, %1, %2" : "=v"(r) : "v"(lo), "v"(hi)); return r; }
typedef float f32x2 __attribute__((ext_vector_type(2)));

struct EpiAny {
    static constexpr bool AFTER_DRAIN = false;
    int mode; bool perm; bf16_t* O; const float* base; float* out; int ldc;
    const float* ss_in; float* ss_out; bf16_t* xb; const float* g;
    __device__ __forceinline__ void operator()(const f32x4 (&acc)[2][2][4][2], const Unit& u, int wr, int wc, int fr, int fq) const {
        if (mode != 2) {
            const int row0 = u.pm * BM + wr * 64 + fr; const int col0 = u.pn * BM + wc * 32 + 8 * fq;
#pragma unroll
            for (int ai = 0; ai < 2; ++ai)
#pragma unroll
                for (int m = 0; m < 4; ++m) { const int row = row0 + ai * HALF + m * 16;
                    const f32x4 s0 = *(const f32x4*)(ss_in + (size_t)row * 32 + 8 * fq), s1 = *(const f32x4*)(ss_in + (size_t)row * 32 + 8 * fq + 4);
                    float ss = ((s0[0] + s0[1]) + (s0[2] + s0[3])) + ((s1[0] + s1[1]) + (s1[2] + s1[3]));
                    ss += __shfl_xor(ss, 16); ss += __shfl_xor(ss, 32);
                    const float rstd = 1.0f / sqrtf(ss * (1.0f / 2048.0f) + 1e-6f);
                    bf16_t* rowp = O + (size_t)row * ldc + col0;
#pragma unroll
                    for (int bj = 0; bj < 2; ++bj) { f32x4 v0 = acc[ai][bj][m][0] * rstd, v1 = acc[ai][bj][m][1] * rstd;
                        if (mode == 1) {
#pragma unroll
                            for (int e = 0; e < 4; ++e) { const float a = v0[e] > 0.f ? v0[e] : 0.f, b = v1[e] > 0.f ? v1[e] : 0.f; v0[e] = a * a; v1[e] = b * b; } }
                        u32x4 w; w.x = cvt_pk_bf16(v0[0], v0[1]); w.y = cvt_pk_bf16(v0[2], v0[3]); w.z = cvt_pk_bf16(v1[0], v1[1]); w.w = cvt_pk_bf16(v1[2], v1[3]);
                        *(u32x4*)(rowp + bj * HALF) = w; } }
        } else {
            typedef unsigned u32x2 __attribute__((ext_vector_type(2)));
            const int col0 = u.pn * BM + wc * 32 + 4 * fq;
            f32x4 gv[2][2];
#pragma unroll
            for (int bj = 0; bj < 2; ++bj)
#pragma unroll
                for (int n = 0; n < 2; ++n) gv[bj][n] = xb ? *(const f32x4*)(g + col0 + bj * HALF + n * 16) : (f32x4){0.f, 0.f, 0.f, 0.f};
#pragma unroll
            for (int ai = 0; ai < 2; ++ai)
#pragma unroll
                for (int m = 0; m < 4; ++m) { const int row = u.pm * BM + ai * HALF + wr * 64 + m * 16 + fr; const size_t off = (size_t)row * ldc + col0;
                    f32x4 bs[2][2];
#pragma unroll
                    for (int bj = 0; bj < 2; ++bj)
#pragma unroll
                        for (int n = 0; n < 2; ++n) bs[bj][n] = *(const f32x4*)(base + off + bj * HALF + n * 16);
                    float ss = 0.f;
#pragma unroll
                    for (int bj = 0; bj < 2; ++bj)
#pragma unroll
                        for (int n = 0; n < 2; ++n) { const f32x4 v = bs[bj][n] + acc[ai][bj][m][n]; *(f32x4*)(out + off + bj * HALF + n * 16) = v;
                            ss += (v[0] * v[0] + v[1] * v[1]) + (v[2] * v[2] + v[3] * v[3]);
                            if (xb) { const f32x4 y = v * gv[bj][n]; u32x2 w; w.x = cvt_pk_bf16(y[0], y[1]); w.y = cvt_pk_bf16(y[2], y[3]); *(u32x2*)(xb + off + bj * HALF + n * 16) = w; } }
                    ss += __shfl_xor(ss, 16); ss += __shfl_xor(ss, 32);
                    if (fq == 0) ss_out[(size_t)row * 32 + 4 * u.pn + wc] = ss;
                    asm volatile("" ::: "memory"); }
        }
    }
};

template <class Epi, class Sched, bool ALIGN_EPI = false, bool SP2 = false>
__device__ __forceinline__ void gemm_phase(PG8_LAS unsigned char* lds, const Gemm g, const Sched& S, const Epi& E) {
    int tid = threadIdx.x; asm volatile("" : "+v"(tid));
    const int wid = __builtin_amdgcn_readfirstlane(tid >> 6), lane = tid & 63, wr = wid >> 2, wc = wid & 3, fr = lane & 15, fq = lane >> 4;
    const int K = g.K, nt = K / BK;
    unsigned voffA[2], voffB[2];
#pragma unroll
    for (int i = 0; i < 2; ++i) { int R, C; stage_rc(tid * 16 + i * 8192, R, C); const int Rb = E.perm ? ((R & ~31) + perm32(R & 31)) : R;
        voffA[i] = (unsigned)(R * K + C) * 2u; voffB[i] = (unsigned)(Rb * K + C) * 2u; }
    const size_t kstep = (size_t)(BK * 2);
    const size_t hstep = (size_t)HALF * K * 2;
    const size_t tstep = 2 * hstep;
    const unsigned ldsw = (unsigned)wid * 1024u;
    const int aoff = lds_byte(wr * 64 + fr, fq * 8), boff = lds_byte(wc * 32 + fr, fq * 8);
#define PG8_SA(b, h) (((b) * 2 + (h)) * HTB)
#define PG8_SB(b, h) ((4 + (b) * 2 + (h)) * HTB)
#define PG8_STAGE(bufoff, gbase, voff) do { _Pragma("unroll") for (int _i = 0; _i < 2; ++_i) \
        __builtin_amdgcn_global_load_lds((const unsigned*)((const char*)(gbase) + (voff)[_i]), (PG8_LAS unsigned*)(lds + (bufoff) + ldsw + _i * 8192), 16, 0, 0); } while (0)
#define PG8_LDA(dst, b, h) do { _Pragma("unroll") for (int m = 0; m < 4; ++m) _Pragma("unroll") for (int k = 0; k < 2; ++k) dst[m][k] = *(const PG8_LAS bf16x8*)(lds + PG8_SA(b, h) + aoff + m * 2048 + k * 1024); } while (0)
#define PG8_LDB(dst, b, h) do { _Pragma("unroll") for (int n = 0; n < 2; ++n) _Pragma("unroll") for (int k = 0; k < 2; ++k) dst[n][k] = *(const PG8_LAS bf16x8*)(lds + PG8_SB(b, h) + boff + n * 2048 + k * 1024); } while (0)
#define PG8_MMA(ai, bj, At, Bt) do { __builtin_amdgcn_s_setprio(1); _Pragma("unroll") for (int m = 0; m < 4; ++m) _Pragma("unroll") for (int n = 0; n < 2; ++n) _Pragma("unroll") for (int k = 0; k < 2; ++k) \
        acc[ai][bj][m][n] = __builtin_amdgcn_mfma_f32_16x16x32_bf16(Bt[n][k], At[m][k], acc[ai][bj][m][n], 0, 0, 0); __builtin_amdgcn_s_setprio(0); } while (0)
#define PG8_WAIT_V(n) asm volatile("s_waitcnt vmcnt(" #n ")" ::: "memory")
#define PG8_WAIT_L(n) asm volatile("s_waitcnt lgkmcnt(" #n ")" ::: "memory")
#define PG8_BAR __builtin_amdgcn_s_barrier()
#define PG8_SCHED __builtin_amdgcn_sched_barrier(0)
    Unit cur, nxt; int ui = 0;
    if (!S.next(0, cur)) return;
    f32x4 acc[2][2][4][2];
#pragma unroll
    for (int a = 0; a < 2; ++a)
#pragma unroll
        for (int b = 0; b < 2; ++b)
#pragma unroll
            for (int m = 0; m < 4; ++m)
#pragma unroll
                for (int n = 0; n < 2; ++n) acc[a][b][m][n] = (f32x4){0.f, 0.f, 0.f, 0.f};
    bf16x8 At[4][2], B0[2][2], B1[2][2];
    const char* cA = (const char*)g.A + (size_t)cur.pm * tstep; const char* cB = (const char*)g.Bt + (size_t)cur.pn * tstep;
    S.a_ready(cur);
    if constexpr (SP2) {
        PG8_STAGE(PG8_SB(0, 0), cB, voffB); PG8_STAGE(PG8_SB(0, 1), cB + hstep, voffB); PG8_STAGE(PG8_SA(0, 0), cA, voffA); PG8_STAGE(PG8_SA(0, 1), cA + hstep, voffA);
        if (wr == 1) PG8_BAR;
        PG8_WAIT_V(2); PG8_BAR;
        PG8_STAGE(PG8_SB(1, 0), cB + kstep, voffB); PG8_STAGE(PG8_SA(1, 0), cA + kstep, voffA); PG8_STAGE(PG8_SB(1, 1), cB + hstep + kstep, voffB);
        PG8_WAIT_V(6); PG8_BAR;
    } else {
        PG8_STAGE(PG8_SB(0, 0), cB, voffB); PG8_STAGE(PG8_SA(0, 0), cA, voffA); PG8_STAGE(PG8_SB(0, 1), cB + hstep, voffB); PG8_STAGE(PG8_SA(0, 1), cA + hstep, voffA);
        if (wr == 1) PG8_BAR;
        PG8_WAIT_V(4); PG8_BAR;
        PG8_STAGE(PG8_SB(1, 0), cB + kstep, voffB); PG8_STAGE(PG8_SA(1, 0), cA + kstep, voffA); PG8_STAGE(PG8_SB(1, 1), cB + hstep + kstep, voffB);
        PG8_WAIT_V(6); PG8_BAR;
    }
    for (;;) {
        const bool has_next = S.next(ui + 1, nxt);
        const char* nA = has_next ? (const char*)g.A + (size_t)nxt.pm * tstep : cA; const char* nB = has_next ? (const char*)g.Bt + (size_t)nxt.pn * tstep : cB;
        for (int t = 0; t < nt; t += 2) {
            const bool last = (t == nt - 2);
            const char* a1 = cA + (size_t)(t + 1) * kstep;
            const char* a2 = last ? nA : cA + (size_t)(t + 2) * kstep; const char* b2 = last ? nB : cB + (size_t)(t + 2) * kstep;
            const char* a3 = a2 + kstep; const char* b3 = b2 + kstep;
            if (last && has_next) S.a_ready(nxt);
            if constexpr (SP2) {
            PG8_LDB(B0, 0, 0); PG8_LDB(B1, 0, 1); PG8_SCHED; PG8_LDA(At, 0, 0); PG8_STAGE(PG8_SA(1, 1), a1 + hstep, voffA);
            PG8_WAIT_V(8); PG8_WAIT_L(0); PG8_BAR; PG8_MMA(0, 0, At, B0); PG8_MMA(0, 1, At, B1); PG8_BAR; PG8_SCHED;
            PG8_LDA(At, 0, 1); PG8_STAGE(PG8_SB(0, 0), b2, voffB); PG8_STAGE(PG8_SB(0, 1), b2 + hstep, voffB); PG8_STAGE(PG8_SA(0, 0), a2, voffA);
            PG8_WAIT_V(8); PG8_WAIT_L(0); PG8_BAR; PG8_MMA(1, 0, At, B0); PG8_MMA(1, 1, At, B1); PG8_BAR; PG8_SCHED;
            PG8_LDB(B0, 1, 0); PG8_LDB(B1, 1, 1); PG8_SCHED; PG8_LDA(At, 1, 0); PG8_STAGE(PG8_SA(0, 1), a2 + hstep, voffA);
            PG8_WAIT_V(8); PG8_WAIT_L(0); PG8_BAR; PG8_MMA(0, 0, At, B0); PG8_MMA(0, 1, At, B1); PG8_BAR; PG8_SCHED;
            PG8_LDA(At, 1, 1); PG8_STAGE(PG8_SB(1, 0), b3, voffB); PG8_STAGE(PG8_SB(1, 1), b3 + hstep, voffB); PG8_STAGE(PG8_SA(1, 0), a3, voffA);
            PG8_WAIT_V(8); PG8_WAIT_L(0); PG8_BAR; PG8_MMA(1, 0, At, B0); PG8_MMA(1, 1, At, B1); PG8_BAR; PG8_SCHED;
            } else {
            PG8_LDB(B0, 0, 0); PG8_SCHED; PG8_LDA(At, 0, 0); PG8_STAGE(PG8_SA(1, 1), a1 + hstep, voffA);
            PG8_WAIT_L(8); PG8_BAR; PG8_WAIT_L(0); PG8_MMA(0, 0, At, B0); PG8_BAR; PG8_SCHED;
            PG8_LDB(B1, 0, 1); PG8_STAGE(PG8_SB(0, 0), b2, voffB);
            PG8_BAR; PG8_WAIT_L(0); PG8_MMA(0, 1, At, B1); PG8_BAR;
            PG8_LDA(At, 0, 1); PG8_STAGE(PG8_SA(0, 0), a2, voffA);
            PG8_BAR; PG8_WAIT_L(0); PG8_MMA(1, 0, At, B0); PG8_BAR; PG8_SCHED;
            PG8_STAGE(PG8_SB(0, 1), b2 + hstep, voffB);
            PG8_WAIT_V(6); PG8_BAR; PG8_MMA(1, 1, At, B1); PG8_BAR;
            PG8_LDB(B0, 1, 0); PG8_SCHED; PG8_LDA(At, 1, 0); PG8_STAGE(PG8_SA(0, 1), a2 + hstep, voffA);
            PG8_WAIT_L(8); PG8_BAR; PG8_WAIT_L(0); PG8_MMA(0, 0, At, B0); PG8_BAR; PG8_SCHED;
            PG8_LDB(B1, 1, 1); PG8_STAGE(PG8_SB(1, 0), b3, voffB);
            PG8_BAR; PG8_WAIT_L(0); PG8_MMA(0, 1, At, B1); PG8_BAR;
            PG8_LDA(At, 1, 1); PG8_STAGE(PG8_SA(1, 0), a3, voffA);
            PG8_BAR; PG8_WAIT_L(0); PG8_MMA(1, 0, At, B0); PG8_BAR; PG8_SCHED;
            PG8_STAGE(PG8_SB(1, 1), b3 + hstep, voffB);
            PG8_WAIT_V(6); PG8_BAR; PG8_MMA(1, 1, At, B1); PG8_BAR;
            }
        }
        if constexpr (ALIGN_EPI) { if (wr == 0) PG8_BAR; }
        if constexpr (!Epi::AFTER_DRAIN) { E(acc, cur, wr, wc, fr, fq); S.done(cur); }
        if (!has_next) break;
#pragma unroll
        for (int a = 0; a < 2; ++a)
#pragma unroll
            for (int b = 0; b < 2; ++b)
#pragma unroll
                for (int m = 0; m < 4; ++m)
#pragma unroll
                    for (int n = 0; n < 2; ++n) acc[a][b][m][n] = (f32x4){0.f, 0.f, 0.f, 0.f};
        cur = nxt; cA = nA; cB = nB; ++ui;
        if constexpr (ALIGN_EPI) { if (wr == 1) PG8_BAR; }
    }
    PG8_WAIT_V(0);
    if constexpr (!ALIGN_EPI) { if (wr == 0) PG8_BAR; }
    PG8_BAR;
    if constexpr (Epi::AFTER_DRAIN) { E.fused(acc, cur, wr, wc, fr, fq, lds, wid, lane); S.done(cur); }
#undef PG8_SA
#undef PG8_SB
#undef PG8_STAGE
#undef PG8_LDA
#undef PG8_LDB
#undef PG8_MMA
#undef PG8_WAIT_V
#undef PG8_WAIT_L
#undef PG8_BAR
#undef PG8_SCHED
}
}
#define GAS __attribute__((address_space(1)))
#define LAS __attribute__((address_space(3)))
typedef unsigned short bf16;
typedef unsigned v4u __attribute__((ext_vector_type(4)));
typedef float f32x4 __attribute__((ext_vector_type(4)));
typedef short bf16x8 __attribute__((ext_vector_type(8)));
typedef GAS unsigned gu32;
typedef GAS unsigned long long gu64;
#define RLX_AGENT __ATOMIC_RELAXED, __HIP_MEMORY_SCOPE_AGENT
#define LDS_WAIT() asm volatile("s_waitcnt lgkmcnt(0)" ::: "memory")
#define VM_WAIT() asm volatile("s_waitcnt vmcnt(0)" ::: "memory")
__device__ __forceinline__ unsigned long long rt() { return __builtin_amdgcn_s_memrealtime(); }
__device__ __forceinline__ unsigned f2bf(float f) { unsigned u = __builtin_bit_cast(unsigned, f); return (u + 0x7fffu + ((u >> 16) & 1u)) >> 16; }
__device__ __forceinline__ unsigned pk2(float lo, float hi) { return f2bf(lo) | (f2bf(hi) << 16); }
#define XB_TMO      128
#define XB_XCNT(j)  (256  + 64 * (j))
#define XB_XSUB(j)  (1280 + 64 * (j))
#define XB_XGEN(j)  (2304 + 64 * (j))
#define XB_TOP      3328
#define XB_TOPGEN   3392
#define XCD_BAR_WORDS 3456
#define XB_SPIN_CAP (1u << 18)

__device__ __forceinline__ unsigned xb_ld(unsigned* p)              { return __hip_atomic_load(p, __ATOMIC_RELAXED, __HIP_MEMORY_SCOPE_AGENT); }
__device__ __forceinline__ unsigned xb_add(unsigned* p, unsigned v) { return __hip_atomic_fetch_add(p, v, __ATOMIC_RELAXED, __HIP_MEMORY_SCOPE_AGENT); }
__device__ __forceinline__ unsigned xb_xcc_id() { return (unsigned)__builtin_amdgcn_s_getreg((3 << 11) | 20) & 0xFu; }
#define XB_SPIN(cond, bar) do { unsigned _sp = 0; while (cond) { __builtin_amdgcn_s_sleep(1); \
    if ((++_sp & 255u) == 0u) { if (xb_ld(&(bar)[XB_TMO])) break; if (_sp > XB_SPIN_CAP) { atomicAdd(&(bar)[XB_TMO], 1u); break; } } } } while (0)

struct XcdBarrier {
    unsigned* bar; unsigned x;
    volatile LAS unsigned* st;
};

__device__ __forceinline__ XcdBarrier xcd_barrier_post(unsigned* bar, volatile LAS unsigned* st) {
    XcdBarrier b; b.bar = bar; b.x = xb_xcc_id(); b.st = st;
    if (threadIdx.x == 0) (void)xb_add(&bar[XB_XCNT(b.x)], 1u);
    return b;
}
__device__ __forceinline__ void xcd_barrier_complete(unsigned* bar, unsigned x, unsigned& nloc, unsigned& nx) {
    const unsigned G = gridDim.x * gridDim.y * gridDim.z;
    unsigned sum, cnt, mine, sp = 0u;
    for (;;) {
        sum = 0u; cnt = 0u; mine = 0u;
#pragma unroll
        for (unsigned j = 0; j < 16; ++j) { const unsigned c = xb_ld(&bar[XB_XCNT(j)]); sum += c; cnt += (c > 0u) ? 1u : 0u; mine = (j == x) ? c : mine; }
        if (sum == G) break;
        __builtin_amdgcn_s_sleep(1);
        if ((++sp & 255u) == 0u) { if (xb_ld(&bar[XB_TMO])) break; if (sp > XB_SPIN_CAP) { atomicAdd(&bar[XB_TMO], 1u); break; } }
    }
    nloc = mine > 0u ? mine : 1u; nx = cnt > 0u ? cnt : 1u;
}

__device__ __forceinline__ void xcd_barrier(const XcdBarrier& b) {
    asm volatile("s_waitcnt vmcnt(0)" ::: "memory");
    __syncthreads();
    if (threadIdx.x == 0) {
        unsigned* bar = b.bar;
        __builtin_amdgcn_s_waitcnt(0);
        unsigned nloc = b.st[0], nx = b.st[1];
        if (nloc == 0u) { xcd_barrier_complete(bar, b.x, nloc, nx); b.st[0] = nloc; b.st[1] = nx; }
        const unsigned old = xb_add(&bar[XB_XSUB(b.x)], 1u);
        const unsigned gen = old / nloc;
        if (old + 1u == (gen + 1u) * nloc) {
            __builtin_amdgcn_fence(__ATOMIC_RELEASE, "agent");
            asm volatile("s_waitcnt vmcnt(0)" ::: "memory");
            const unsigned og = xb_add(&bar[XB_TOP], 1u);
            const unsigned tg = og / nx;
            if (og + 1u == (tg + 1u) * nx) xb_add(&bar[XB_TOPGEN], 1u);
            else XB_SPIN(xb_ld(&bar[XB_TOPGEN]) == tg, bar);
            __builtin_amdgcn_fence(__ATOMIC_ACQUIRE, "agent");
            xb_add(&bar[XB_XGEN(b.x)], 1u);
            asm volatile("s_waitcnt vmcnt(0)" ::: "memory");
        } else {
            XB_SPIN(xb_ld(&bar[XB_XGEN(b.x)]) == gen, bar);
            __builtin_amdgcn_fence(__ATOMIC_ACQUIRE, "agent");
            asm volatile("s_waitcnt vmcnt(0)" ::: "memory");
        }
    }
    __syncthreads();
}
__device__ __forceinline__ float wave_sum(float v) {
#pragma unroll
    for (int o = 1; o < 64; o <<= 1) v += __shfl_xor(v, o);
    return v;
}
__device__ __forceinline__ unsigned cvtpk_rne(float lo, float hi) { typedef float f2 __attribute__((ext_vector_type(2))); typedef __bf16 b2 __attribute__((ext_vector_type(2)));
    f2 v = {lo, hi}; b2 b = __builtin_convertvector(v, b2); return __builtin_bit_cast(unsigned, b); }
__device__ __forceinline__ void p0_transpose_item64(const float* W, int K, int N, bf16* WT, LAS unsigned* scr, int item, int lane) {
    const int nblk = N / 64, kb = item / nblk, nb = item % nblk, k0 = 64 * kb, n0 = 64 * nb;
    const int g = lane >> 4, q = lane & 15;
    const float* src = W + (size_t)(k0 + 2 * g) * N + n0 + 4 * q;
    f32x4 v[16];
#pragma unroll
    for (int i = 0; i < 16; ++i) v[i] = *(const GAS f32x4*)(src + (size_t)(8 * (i >> 1) + (i & 1)) * N);
#pragma unroll
    for (int j = 0; j < 8; ++j)
#pragma unroll
        for (int e = 0; e < 4; ++e) scr[(4 * q + e) * 33 + 4 * j + g] = cvtpk_rne(v[2 * j][e], v[2 * j + 1][e]);
    LDS_WAIT(); asm volatile("" ::: "memory");
    const int c = lane & 7, nr = lane >> 3;
#pragma unroll
    for (int jj = 0; jj < 8; ++jj) { const int n = nr + 8 * jj; const LAS unsigned* s = scr + n * 33 + 4 * c;
        v4u o; o.x = s[0]; o.y = s[1]; o.z = s[2]; o.w = s[3];
        *(GAS v4u*)(WT + (size_t)(n0 + n) * K + k0 + 8 * c) = o; }
    LDS_WAIT(); asm volatile("" ::: "memory");
}


constexpr int NWAVES = 8;
constexpr int BATCH = 4, SEQ = 2048, DM = 2048, TOK = BATCH * SEQ, PW = 6144, DFF = 8192, HD = 128, DEPTH = 2;
constexpr int NHA = 6, NHB = 4, NHC = 6;
constexpr int COL_QA = 0, COL_KA = 768, COL_VA = 1536, COL_QB = 2304, COL_KB = 2816, COL_VB = 3328, COL_QC = 3840, COL_KC = 4608, COL_VC = 5376;
constexpr int MIX_A = 0, MIX_B = 768, MIX_C = 1280;
constexpr float EPS = 1e-6f;

constexpr size_t MiB = 1u << 20;
constexpr size_t WS_CTL = 0, CTL_ZERO_BYTES = 1 * MiB;
constexpr size_t WS_LUT = 1 * MiB;
constexpr size_t WS_SS = 459 * MiB;
constexpr size_t WS_WIN = 2 * MiB, WS_WOUT = 50 * MiB, WS_W1 = 66 * MiB, WS_W2 = 130 * MiB;
constexpr size_t WS_XB = 194 * MiB;
constexpr size_t WS_QKV = 226 * MiB;
constexpr size_t WS_MIX = 322 * MiB;
constexpr size_t WS_H = 226 * MiB;
constexpr size_t WS_PA = 354 * MiB;
constexpr size_t WS_LSE = 426 * MiB;
constexpr size_t WS_PB = 427 * MiB;
constexpr size_t WS_END = 460 * MiB;
constexpr int CW_BAR = 4096;
constexpr int CW_QUEUE = 8192;

constexpr int RING_OFF = 0, RING_BYTES = 131072;
constexpr int LDSCTL_OFF = RING_BYTES, MISC_OFF = LDSCTL_OFF + 320;
constexpr int LDS_BYTES = 147456;

struct Frame {
    LAS unsigned char* lds;
    volatile LAS unsigned* MISC;
    gu32* ctl;
    int tid, lane, wave, vcu, G;
};

namespace att {
typedef short bf16x8 __attribute__((ext_vector_type(8)));
typedef short s16x4 __attribute__((ext_vector_type(4)));
typedef float f32x16 __attribute__((ext_vector_type(16)));
typedef unsigned u32x4 __attribute__((ext_vector_type(4)));
typedef short v4i16_t __attribute__((ext_vector_type(4)));
constexpr int QP = PW;
constexpr int VPB = 320;
constexpr int VBYTES = 32 * VPB;

__device__ __forceinline__ int crow(int r, int hi) { return (r & 3) + 8 * (r >> 2) + 4 * hi; }
__device__ __forceinline__ unsigned cvtpk(float lo, float hi) { typedef float f2 __attribute__((ext_vector_type(2))); typedef __bf16 b2 __attribute__((ext_vector_type(2)));
    f2 v = {lo, hi}; b2 b = __builtin_convertvector(v, b2); return __builtin_bit_cast(unsigned, b); }
__device__ __forceinline__ s16x4 vtr(LAS const unsigned char* p) { return __builtin_bit_cast(s16x4, __builtin_amdgcn_ds_read_tr16_b64_v4i16((LAS v4i16_t*)p)); }

template <int NKS> __device__ __forceinline__ f32x16 qk_tile(const bf16x8 (&qf)[NKS], const bf16* krow) {
    bf16x8 kf[NKS];
#pragma unroll
    for (int ks = 0; ks < NKS; ++ks) kf[ks] = *(const bf16x8*)(krow + 16 * ks);
    f32x16 st = {0.f, 0.f, 0.f, 0.f, 0.f, 0.f, 0.f, 0.f, 0.f, 0.f, 0.f, 0.f, 0.f, 0.f, 0.f, 0.f};
#pragma unroll
    for (int ks = 0; ks < NKS; ++ks) st = __builtin_amdgcn_mfma_f32_32x32x16_bf16(kf[ks], qf[ks], st, 0, 0, 0);
    return st;
}
constexpr int VBLK = 1088;
__device__ __forceinline__ void dma_v(LAS unsigned char* vl, const bf16* Vb, int tk0, int tks, int lane) {
    const bf16* p = Vb + (size_t)(tk0 + 8 * tks * (lane >> 4)) * QP + (lane & 15) * 8; const size_t step = (size_t)tks * QP;
#pragma unroll
    for (int i = 0; i < 8; ++i) { __builtin_amdgcn_global_load_lds((const unsigned*)p, (LAS unsigned*)(vl + i * VBLK), 16, 0, 0); p += step; }
}
__device__ __forceinline__ void dma_wait() { asm volatile("s_waitcnt vmcnt(0)" ::: "memory"); }
__device__ __forceinline__ void pv_tile(f32x16 (&o)[4], const bf16x8 (&pa)[2], LAS const unsigned char* vl, int lane) {
    const int hi = lane >> 5, g1 = (lane >> 4) & 1, i = lane & 15;
    LAS const unsigned char* base = vl + (4 * hi + (i >> 2)) * VBLK + (16 * g1 + 4 * (i & 3)) * 2;
#pragma unroll
    for (int db = 0; db < 4; ++db)
#pragma unroll
        for (int s = 0; s < 2; ++s) {
            const s16x4 lo = vtr(base + s * 512 + db * 64);
            const s16x4 hh = vtr(base + s * 512 + 256 + db * 64);
            const bf16x8 vf = {lo[0], lo[1], lo[2], lo[3], hh[0], hh[1], hh[2], hh[3]};
            o[db] = __builtin_amdgcn_mfma_f32_32x32x16_bf16(pa[s], vf, o[db], 0, 0, 0);
        }
}

constexpr float LOG2E = 1.4426950408889634f;
constexpr float THR2 = 6.0f;
__device__ __forceinline__ float ex2(float x) { return __builtin_amdgcn_exp2f(x); }
__device__ __forceinline__ float lg2(float x) { return __builtin_amdgcn_logf(x); }
__device__ __forceinline__ constexpr int ccol(int r) { return (r & 3) + 8 * (r >> 2); }

template <int NKS> __device__ __forceinline__ void load_k(bf16x8 (&kf)[NKS], const bf16* krow) {
#pragma unroll
    for (int ks = 0; ks < NKS; ++ks) kf[ks] = *(const bf16x8*)(krow + 16 * ks);
}
template <int NKS> __device__ __forceinline__ f32x16 qk_mma(const bf16x8 (&kf)[NKS], const bf16x8 (&qf)[NKS]) {
    f32x16 st = {0.f, 0.f, 0.f, 0.f, 0.f, 0.f, 0.f, 0.f, 0.f, 0.f, 0.f, 0.f, 0.f, 0.f, 0.f, 0.f};
#pragma unroll
    for (int ks = 0; ks < NKS; ++ks) st = __builtin_amdgcn_mfma_f32_32x32x16_bf16(kf[ks], qf[ks], st, 0, 0, 0);
    return st;
}
__device__ __forceinline__ void pack_p(bf16x8 (&pa)[2], const float (&t)[16]) {
    u32x4 w0 = {cvtpk(t[0], t[1]), cvtpk(t[2], t[3]), cvtpk(t[4], t[5]), cvtpk(t[6], t[7])}, w1 = {cvtpk(t[8], t[9]), cvtpk(t[10], t[11]), cvtpk(t[12], t[13]), cvtpk(t[14], t[15])};
    pa[0] = __builtin_bit_cast(bf16x8, w0); pa[1] = __builtin_bit_cast(bf16x8, w1);
}
__device__ __forceinline__ void sm_tile(float (&xm)[16], bool first, float& m2, float& l, f32x16 (&o)[4], bf16x8 (&pa)[2], int hi) {
    float a = fmaxf(fmaxf(xm[0], xm[1]), fmaxf(xm[2], xm[3])), b = fmaxf(fmaxf(xm[4], xm[5]), fmaxf(xm[6], xm[7]));
    a = fmaxf(a, fmaxf(fmaxf(xm[8], xm[9]), fmaxf(xm[10], xm[11]))); b = fmaxf(b, fmaxf(fmaxf(xm[12], xm[13]), fmaxf(xm[14], xm[15])));
    float mt = fmaxf(a, b); mt = fmaxf(mt, __shfl_xor(mt, 32));
    if (first) {
        m2 += mt;
#pragma unroll
        for (int r = 0; r < 16; ++r) xm[r] -= mt;
    } else if (__any(mt > THR2)) {
        const float d = fmaxf(mt, 0.f), alpha = ex2(-d); m2 += d; l *= alpha;
#pragma unroll
        for (int r = 0; r < 16; ++r) xm[r] -= d;
#pragma unroll
        for (int r = 0; r < 16; ++r) { const float f = __shfl(alpha, crow(r, hi));
#pragma unroll
            for (int db = 0; db < 4; ++db) o[db][r] *= f; }
    }
    float ls = 0.f;
#pragma unroll
    for (int r = 0; r < 16; ++r) { xm[r] = ex2(xm[r]); ls += xm[r]; }
    l += ls;
    pack_p(pa, xm);
}
__device__ __forceinline__ void store_o_bf16(const f32x16 (&o)[4], float fq  , bool use_f, bf16* Ob, int tok0, int tstride, int pitch, LAS unsigned char* vl, int lane) {
    const int qi = lane & 31, hi = lane >> 5;
#pragma unroll
    for (int r = 0; r < 16; ++r) { const int qq = crow(r, hi); const float f = use_f ? __shfl(fq, qq) : 1.0f;
#pragma unroll
        for (int db = 0; db < 4; ++db) *(LAS unsigned short*)(vl + qq * VPB + (32 * db + qi) * 2) = (unsigned short)(cvtpk(o[db][r] * f, 0.f) & 0xffffu); }
    asm volatile("s_waitcnt lgkmcnt(0)" ::: "memory");
#pragma unroll
    for (int i = 0; i < 8; ++i) { const int row = 4 * i + (lane >> 4); const u32x4 v = *(LAS const u32x4*)(vl + row * VPB + (lane & 15) * 16);
        *(u32x4*)(Ob + (size_t)(tok0 + tstride * row) * pitch + (lane & 15) * 8) = v; }
    asm volatile("s_waitcnt lgkmcnt(0)" ::: "memory");
}

__device__ __forceinline__ void diff_item(const bf16* Qb, const bf16* Kb, const bf16* Vb, int qt, const float* lut2, const int* thrtab, bf16* Ob, LAS unsigned char* vl, int lane_in) {
    int lane = lane_in; asm volatile("" : "+v"(lane));
    const int qi = lane & 31, hi = lane >> 5; const float c1 = 0.125f * LOG2E;
    bf16x8 qf[4]; load_k<4>(qf, Qb + (size_t)(32 * qt + qi) * QP + 8 * hi);
    f32x16 o[4];
#pragma unroll
    for (int db = 0; db < 4; ++db)
#pragma unroll
        for (int r = 0; r < 16; ++r) o[db][r] = 0.f;
    float m2 = 0.f, l = 0.f;
    bf16x8 kf[4];
    load_k<4>(kf, Kb + (size_t)qi * QP + 8 * hi);
#pragma nounroll
    for (int kt = 0; kt <= qt; ++kt) {
        const int D = qt - kt, ktn = kt < qt ? kt + 1 : qt;
        const int thr = thrtab[D];
        float xm[16]; bf16x8 pa[2];
        if (thr < 0) {
            const int dl = 32 * D + lane - 31; const float bl = lut2[dl < 0 ? 0 : dl];
            const f32x16 st = qk_mma<4>(kf, qf);
            dma_v(vl, Vb, 32 * kt, 1, lane);
            load_k<4>(kf, Kb + (size_t)(32 * ktn + qi) * QP + 8 * hi);
            const int sl = qi + 31 - 4 * hi;
#pragma unroll
            for (int r = 0; r < 16; ++r) xm[r] = st[r] * c1 + (__shfl(bl, sl - ccol(r)) - m2);
            if (D == 0) {
#pragma unroll
                for (int r = 0; r < 16; ++r) xm[r] = (crow(r, hi) <= qi) ? xm[r] : -INFINITY;
            }
        } else {
            const float b0m = lut2[32 * D - 31] - m2, b1m = lut2[32 * D + 31] - m2; const int y2 = 32 * D + qi - thr - 4 * hi;
            const f32x16 st = qk_mma<4>(kf, qf);
            dma_v(vl, Vb, 32 * kt, 1, lane);
            load_k<4>(kf, Kb + (size_t)(32 * ktn + qi) * QP + 8 * hi);
#pragma unroll
            for (int r = 0; r < 16; ++r) xm[r] = st[r] * c1 + ((ccol(r) <= y2) ? b1m : b0m);
        }
        sm_tile(xm, kt == 0, m2, l, o, pa, hi);
        dma_wait();
        pv_tile(o, pa, vl, lane);
    }
    const float lt = l + __shfl_xor(l, 32);
    store_o_bf16(o, 1.0f / lt, true, Ob, 32 * qt, 1, 512, vl, lane);
}

__device__ __forceinline__ void dil_item(const bf16* Qb, const bf16* Kb, const bf16* Vb, int dil, int rr, int n32, const float* lut2, bf16* Ob, float* lseb, LAS unsigned char* vl, int lane_in) {
    int lane = lane_in; asm volatile("" : "+v"(lane));
    const int qi = lane & 31, hi = lane >> 5; const float c1 = 0.08838834764831845f * LOG2E;
    const int tq0 = 32 * n32 * dil + rr;
    bf16x8 qf[8]; load_k<8>(qf, Qb + (size_t)(tq0 + qi * dil) * QP + 8 * hi);
    f32x16 o[4];
#pragma unroll
    for (int db = 0; db < 4; ++db)
#pragma unroll
        for (int r = 0; r < 16; ++r) o[db][r] = 0.f;
    float m2 = 0.f, l = 0.f;
    const int kt_lo = n32 >= 4 ? 0 : 4 - n32;
#pragma nounroll
    for (int kt = kt_lo; kt <= 4; ++kt) {
        const int tkc = 32 * (n32 - 4 + kt) * dil + rr;
        bf16x8 kf[8]; load_k<8>(kf, Kb + (size_t)(tkc + qi * dil) * QP + 8 * hi);
        dma_v(vl, Vb, tkc, dil, lane);
        int dl = (128 - 32 * kt + lane - 31) * dil; dl = dl < 0 ? 0 : (dl > 2047 ? 2047 : dl);
        const float bl = lut2[dl];
        const f32x16 st = qk_mma<8>(kf, qf);
        float xm[16]; bf16x8 pa[2];
        const int sl = qi + 31 - 4 * hi;
#pragma unroll
        for (int r = 0; r < 16; ++r) xm[r] = st[r] * c1 + (__shfl(bl, sl - ccol(r)) - m2);
        if (kt == 0) {
#pragma unroll
            for (int r = 0; r < 16; ++r) xm[r] = (crow(r, hi) >= qi) ? xm[r] : -INFINITY;
        }
        if (kt == 4) {
#pragma unroll
            for (int r = 0; r < 16; ++r) xm[r] = (crow(r, hi) <= qi) ? xm[r] : -INFINITY;
        }
        sm_tile(xm, kt == kt_lo, m2, l, o, pa, hi);
        dma_wait();
        pv_tile(o, pa, vl, lane);
    }
    const float lt = l + __shfl_xor(l, 32);
    if (lane < 32) lseb[(size_t)(tq0 + qi * dil) * 6] = m2 + lg2(lt);
    store_o_bf16(o, 1.0f / lt, true, Ob, tq0, dil, 768, vl, lane);
}

__device__ __forceinline__ void stick_item(const bf16* Qb, const bf16* Kb, const bf16* Vb, int qt, bf16* Ob, LAS unsigned char* vl, int lane_in) {
    int lane = lane_in; asm volatile("" : "+v"(lane));
    const int qi = lane & 31, hi = lane >> 5; const float c1 = 0.08838834764831845f * LOG2E;
    bf16x8 qf[8]; load_k<8>(qf, Qb + (size_t)(32 * qt + qi) * QP + 8 * hi);
    f32x16 o[4];
#pragma unroll
    for (int db = 0; db < 4; ++db)
#pragma unroll
        for (int r = 0; r < 16; ++r) o[db][r] = 0.f;
    float R = 0.f;
    bf16x8 kf[8];
    load_k<8>(kf, Kb + (size_t)(32 * qt + qi) * QP + 8 * hi);
#pragma nounroll
    for (int kt = qt; kt >= 0; --kt) {
        const int ktn = kt > 0 ? kt - 1 : 0;
        const f32x16 st = qk_mma<8>(kf, qf);
        dma_v(vl, Vb, 32 * kt, 1, lane);
        load_k<8>(kf, Kb + (size_t)(32 * ktn + qi) * QP + 8 * hi);
        float u[16], zl[16];
#pragma unroll
        for (int r = 0; r < 16; ++r) { const float z = st[r] * c1; const float sp = fmaxf(z, 0.f) + lg2(1.0f + ex2(-fabsf(z)));
            u[r] = -sp; zl[r] = z - sp; }
        if (kt == qt) {
#pragma unroll
            for (int r = 0; r < 16; ++r) { const bool v = crow(r, hi) < qi; u[r] = v ? u[r] : 0.f; zl[r] = v ? zl[r] : -INFINITY; }
        }
        float gs[4], pg[4], tot[4], aft[4];
#pragma unroll
        for (int c = 0; c < 4; ++c) { gs[c] = (u[4 * c] + u[4 * c + 1]) + (u[4 * c + 2] + u[4 * c + 3]); pg[c] = __shfl_xor(gs[c], 32); tot[c] = gs[c] + pg[c]; }
        aft[3] = (hi == 0) ? pg[3] : 0.f;
        aft[2] = tot[3] + ((hi == 0) ? pg[2] : 0.f);
        aft[1] = tot[3] + tot[2] + ((hi == 0) ? pg[1] : 0.f);
        aft[0] = tot[3] + tot[2] + tot[1] + ((hi == 0) ? pg[0] : 0.f);
        float a[16];
#pragma unroll
        for (int c = 0; c < 4; ++c) { const float b = R + aft[c];
            const float s2 = u[4 * c + 3], s1 = s2 + u[4 * c + 2], s0 = s1 + u[4 * c + 1];
            a[4 * c + 3] = ex2(zl[4 * c + 3] + b); a[4 * c + 2] = ex2(zl[4 * c + 2] + (b + s2));
            a[4 * c + 1] = ex2(zl[4 * c + 1] + (b + s1)); a[4 * c + 0] = ex2(zl[4 * c + 0] + (b + s0)); }
        R += (tot[0] + tot[1]) + (tot[2] + tot[3]);
        bf16x8 pa[2]; pack_p(pa, a);
        dma_wait();
        pv_tile(o, pa, vl, lane);
        if (__all(R < -150.0f)) break;
    }
    store_o_bf16(o, 1.0f, false, Ob, 32 * qt, 1, DM, vl, lane);
}
}

__device__ __forceinline__ void row_prep(const float* xrow, const float* g, bf16* orow, float* ss, int lane) {
    const GAS f32x4* xr = (const GAS f32x4*)xrow + lane; const GAS f32x4* gr = (const GAS f32x4*)g + lane;
    f32x4 v[8]; float s = 0.f;
#pragma unroll
    for (int j = 0; j < 8; ++j) { v[j] = xr[64 * j]; s += (v[j].x * v[j].x + v[j].y * v[j].y) + (v[j].z * v[j].z + v[j].w * v[j].w); }
    s = wave_sum(s);
    GAS unsigned long long* o8 = (GAS unsigned long long*)orow + lane;
#pragma unroll
    for (int j = 0; j < 8; ++j) { const f32x4 y = v[j] * gr[64 * j]; o8[64 * j] = (unsigned long long)cvtpk_rne(y.x, y.y) | ((unsigned long long)cvtpk_rne(y.z, y.w) << 32); }
    if (lane < 32) ss[lane] = lane == 0 ? s : 0.f;
}
__device__ __forceinline__ int t5_bucket(int n) {
    if (n < 16) return n;
    const int v = 16 + (int)(logf((float)n / 16.0f) / 4.852030263919617f * 16.0f);
    return v < 31 ? v : 31;
}

struct Args { const float* in[14]; float* out; unsigned char* ws; int ph_lo, ph_hi, use_bar, pad; };
constexpr int PPL = 6;
constexpr int N_PHASES = 1 + PPL * DEPTH + 1;
#ifndef PROBE_MASK
#define PROBE_MASK 0
#endif
#ifndef PROBE_DUP
#define PROBE_DUP -1
#endif
constexpr int N_STEPS = N_PHASES + (PROBE_DUP < 0 ? 0 : (PROBE_DUP == 100 ? 1 : 2));
__device__ __forceinline__ int step_phase(int i) {
    if (PROBE_DUP < 0) return i;
    if (PROBE_DUP == 100) return i == 0 ? 0 : i - 1;
    const int A = 1 + PROBE_DUP, B = 1 + PPL + PROBE_DUP;
    if (i <= A) return i; if (i == A + 1) return A; if (i <= B + 1) return i - 1; if (i == B + 2) return B; return i - 2;
}

__global__ void __launch_bounds__(NWAVES * 64, 2) fwd_kernel(Args args) {
    extern __shared__ __attribute__((aligned(16))) unsigned char lds_raw[];
    Frame F;
    F.lds = (LAS unsigned char*)lds_raw;
    F.MISC = (volatile LAS unsigned*)(F.lds + MISC_OFF);
    F.tid = threadIdx.x; F.lane = F.tid & 63; F.wave = __builtin_amdgcn_readfirstlane(F.tid >> 6);
    F.G = gridDim.x; { const int bx = blockIdx.x; F.vcu = (F.G % 8 == 0) ? (bx % 8) * (F.G / 8) + bx / 8 : bx; }
    unsigned char* ws = args.ws;
    F.ctl = (gu32*)(ws + WS_CTL);
    const float* x_in = args.in[0]; const float* w_in = args.in[1]; const float* w_out = args.in[2]; const float* g_attn = args.in[3]; const float* g_mlp = args.in[4];
    const float* w1 = args.in[5]; const float* w2 = args.in[6]; const float* rel_tab = args.in[7];
    const float* lq1 = args.in[8]; const float* lk1 = args.in[9]; const float* lq2 = args.in[10]; const float* lk2 = args.in[11]; const float* subln_g = args.in[12]; const float* g_final = args.in[13];
    float* out = args.out;
    bf16* WIN_T = (bf16*)(ws + WS_WIN); bf16* WOUT_T = (bf16*)(ws + WS_WOUT); bf16* W1_T = (bf16*)(ws + WS_W1); bf16* W2_T = (bf16*)(ws + WS_W2);
    bf16* XB = (bf16*)(ws + WS_XB); bf16* QKV = (bf16*)(ws + WS_QKV); bf16* MIX = (bf16*)(ws + WS_MIX); bf16* HB = (bf16*)(ws + WS_H);
    float* SS = (float*)(ws + WS_SS); bf16* PAH = (bf16*)(ws + WS_PA); float* LSE = (float*)(ws + WS_LSE); bf16* PBH = (bf16*)(ws + WS_PB); float* LUT = (float*)(ws + WS_LUT);

    for (int u = F.tid; u < (LDS_BYTES - LDSCTL_OFF) / 4; u += NWAVES * 64) ((LAS unsigned*)(F.lds + LDSCTL_OFF))[u] = 0u;
    __syncthreads();
    XcdBarrier bar; bar.bar = (unsigned*)(F.ctl + CW_BAR); bar.x = 0; bar.st = nullptr;
    if (args.use_bar) bar = xcd_barrier_post((unsigned*)(F.ctl + CW_BAR), F.MISC + 8);

    const int NGW = F.G * NWAVES;

    for (int step = args.ph_lo; step < args.ph_hi; ++step) {
        const int ph = step_phase(step);
        int tid = threadIdx.x; asm volatile("" : "+v"(tid));
        const int lane = tid & 63, wave = __builtin_amdgcn_readfirstlane(tid >> 6), gw = F.vcu * NWAVES + wave;
        const int l = ph > 0 ? (ph - 1) / PPL : 0, pt = (ph > 0 && ph <= PPL * DEPTH) ? (ph - 1) % PPL : (ph == 0 ? -1 : 100);
        if (pt == 0 || pt == 3 || pt == 4 || pt == 5) {
            pg8::Gemm g; pg8::EpiAny E; int N;
            E.O = nullptr; E.base = nullptr; E.out = nullptr; E.ss_in = SS; E.ss_out = SS; E.xb = nullptr; E.g = nullptr;
            if (pt == 0)      { g.A = XB;  g.Bt = WIN_T + (size_t)l * PW * DM;  N = PW;  g.K = DM;  E.mode = 0; E.O = QKV; E.ldc = PW; }
            else if (pt == 3) { g.A = MIX; g.Bt = WOUT_T + (size_t)l * DM * DM; N = DM;  g.K = DM;  E.mode = 2; E.base = (l == 0) ? x_in : (const float*)out; E.out = out; E.ldc = DM;
                                E.xb = XB; E.g = g_mlp + (size_t)l * DM; }
            else if (pt == 4) { g.A = XB;  g.Bt = W1_T + (size_t)l * DFF * DM;  N = DFF; g.K = DM;  E.mode = 1; E.O = HB; E.ldc = DFF; }
            else              { g.A = HB;  g.Bt = W2_T + (size_t)l * DM * DFF;  N = DM;  g.K = DFF; E.mode = 2; E.base = (const float*)out; E.out = out; E.ldc = DM;
                                if (l + 1 < DEPTH) { E.xb = XB; E.g = g_attn + (size_t)(l + 1) * DM; } }
            g.M = TOK; g.N = N; E.perm = (E.mode != 2);
            pg8::StaticOrder S; S.init(TOK, N, F.G, (int)blockIdx.x);
            pg8::gemm_phase<pg8::EpiAny, pg8::StaticOrder, true, true>(F.lds + RING_OFF, g, S, E);
        } else if (ph == 0) {
            LAS unsigned* scr = (LAS unsigned*)(F.lds + RING_OFF + wave * 16384);
            constexpr int I_IN = (DM / 64) * (PW / 64), I_OUT = (DM / 64) * (DM / 64), I_1 = (DM / 64) * (DFF / 64), I_2 = (DFF / 64) * (DM / 64), I_L = I_IN + I_OUT + I_1 + I_2;
            for (int it = gw; it < DEPTH * I_L; it += NGW) {
                const int ll = it / I_L; int r = it % I_L;
                const float* W; bf16* WT; int K, N;
                if (r < I_IN) { W = w_in + (size_t)ll * DM * PW; WT = WIN_T + (size_t)ll * PW * DM; K = DM; N = PW; }
                else if ((r -= I_IN) < I_OUT) { W = w_out + (size_t)ll * DM * DM; WT = WOUT_T + (size_t)ll * DM * DM; K = DM; N = DM; }
                else if ((r -= I_OUT) < I_1) { W = w1 + (size_t)ll * DM * DFF; WT = W1_T + (size_t)ll * DFF * DM; K = DM; N = DFF; }
                else { r -= I_1; W = w2 + (size_t)ll * DFF * DM; WT = W2_T + (size_t)ll * DM * DFF; K = DFF; N = DM; }
                p0_transpose_item64(W, K, N, WT, scr, r, lane);
            }
            for (int i = blockIdx.x * (NWAVES * 64) + tid; i < 10 * 2048; i += F.G * NWAVES * 64) { const int h = i >> 11, d = i & 2047; LUT[i] = rel_tab[t5_bucket(d) * 10 + h] * att::LOG2E; }
            if (blockIdx.x == 0 && tid < 64) {
                const int D = tid, dlo = 32 * D - 31 < 0 ? 0 : 32 * D - 31, dhi = 32 * D + 31, bl = t5_bucket(dlo), bh = t5_bucket(dhi); int thr = -1;
                if (D > 0 && bl == bh) thr = 1 << 30;
                else if (D > 0 && bh == bl + 1) { thr = dhi; for (int d = dhi; d >= dlo; --d) if (t5_bucket(d) == bh) thr = d; }
                ((int*)(LUT + 10 * 2048))[D] = thr;
            }
            for (int m = gw; m < TOK; m += NGW) row_prep(x_in + (size_t)m * DM, g_attn, XB + (size_t)m * DM, SS + (size_t)m * 32, lane);
        } else if (pt == 1) {
            LAS unsigned char* vl = F.lds + RING_OFF + wave * att::VBYTES;
            const int* thrtab = (const int*)(LUT + 10 * 2048);
            const int skip = (PROBE_DUP == 1 && (step == 2 || step == 3 + PPL)) ? PROBE_MASK : 0;
            for (int s = gw; s < ((skip & 1) ? 0 : 2048); s += NGW) {
                const int combo = s >> 6, j = s & 63, x = 4 * (j >> 3) + (j & 3), qt = (j & 4) ? x : 63 - x, b = combo >> 3, vh = combo & 7, h = vh >> 1, p = vh & 1;
                const bf16* base = QKV + (size_t)b * SEQ * PW;
                att::diff_item(base + COL_QB + h * HD + p * 64, base + COL_KB + h * HD + p * 64, base + COL_VB + h * HD, qt, LUT + (6 + h) * 2048, thrtab,
                               PBH + ((size_t)p * TOK + (size_t)b * SEQ) * 512 + h * HD, vl, lane);
            }
            const int nq = (F.G % 8 == 0) ? 8 : 1, xq = F.vcu / (F.G / nq);
            gu32* qctr = F.ctl + CW_QUEUE + 64 * (8 * step + xq);
            for (;;) {
                unsigned idx = 0; if (lane == 0) idx = __hip_atomic_fetch_add(qctr, 1u, __ATOMIC_RELAXED, __HIP_MEMORY_SCOPE_AGENT);
                idx = (unsigned)__builtin_amdgcn_readfirstlane((int)idx) * (unsigned)nq + (unsigned)xq;
                if (idx >= 768u + 1152u) break;
                if (idx < 768u) { if (skip & 2) continue;
                    const int bh = (int)idx >> 5, jj = (int)idx & 31, b = bh / 6, h = bh % 6; const bf16* base = QKV + (size_t)b * SEQ * PW;
#pragma nounroll
                    for (int rep = 0; rep < 2; ++rep)
                        att::stick_item(base + COL_QC + h * HD, base + COL_KC + h * HD, base + COL_VC + h * HD, 63 - (2 * jj + rep), MIX + (size_t)b * SEQ * DM + MIX_C + h * HD, vl, lane);
                } else { if (skip & 4) continue;
                    const int i2 = (int)idx - 768, p = i2 / 384, rem = i2 % 384, bh = rem >> 4, j4 = rem & 15, b = bh / 6, h = bh % 6;
                    const int dil = p == 0 ? 1 : (p == 1 ? 4 : 16), tpr = 64 / dil;
                    const bf16* base = QKV + (size_t)b * SEQ * PW;
#pragma nounroll
                    for (int rep = 0; rep < 4; ++rep) { const int j = 4 * j4 + rep;
                        att::dil_item(base + COL_QA + h * HD, base + COL_KA + h * HD, base + COL_VA + h * HD, dil, j / tpr, j % tpr, LUT + h * 2048,
                                      PAH + ((size_t)p * TOK + (size_t)b * SEQ) * 768 + h * HD, LSE + ((size_t)p * TOK + (size_t)b * SEQ) * 6 + h, vl, lane); }
                }
            }
        } else if (pt == 2) {
            const float lam_init = 0.8f - 0.6f * expf(-0.3f * (float)l);
            const float s1 = wave_sum(lq1[l * 64 + lane] * lk1[l * 64 + lane]), s2 = wave_sum(lq2[l * 64 + lane] * lk2[l * 64 + lane]);
            const float lam = expf(s1) - expf(s2) + lam_init;
            const float gx = subln_g[l * HD + 2 * lane] * (1.0f - lam_init), gy = subln_g[l * HD + 2 * lane + 1] * (1.0f - lam_init);
            typedef float f32x2 __attribute__((ext_vector_type(2)));
            for (int tok = gw; tok < TOK; tok += NGW) {
                GAS unsigned* mrow = (GAS unsigned*)(MIX + (size_t)tok * DM);
#pragma unroll
                for (int h = 0; h < NHA; ++h) {
                    const float l0 = LSE[((size_t)0 * TOK + tok) * 6 + h], l1 = LSE[((size_t)1 * TOK + tok) * 6 + h], l2 = LSE[((size_t)2 * TOK + tok) * 6 + h];
                    const float mx = fmaxf(l0, fmaxf(l1, l2)); float w0 = att::ex2(l0 - mx), w1_ = att::ex2(l1 - mx), w2_ = att::ex2(l2 - mx); const float inv = 1.0f / (w0 + w1_ + w2_);
                    w0 *= inv; w1_ *= inv; w2_ *= inv;
                    const unsigned a = *(const GAS unsigned*)(PAH + ((size_t)0 * TOK + tok) * 768 + h * HD + 2 * lane), b = *(const GAS unsigned*)(PAH + ((size_t)1 * TOK + tok) * 768 + h * HD + 2 * lane),
                                   c = *(const GAS unsigned*)(PAH + ((size_t)2 * TOK + tok) * 768 + h * HD + 2 * lane);
                    const float ax = __uint_as_float(a << 16), ay = __uint_as_float(a & 0xffff0000u), bx = __uint_as_float(b << 16), by = __uint_as_float(b & 0xffff0000u), cx = __uint_as_float(c << 16), cy = __uint_as_float(c & 0xffff0000u);
                    mrow[(MIX_A + h * HD) / 2 + lane] = cvtpk_rne(w0 * ax + w1_ * bx + w2_ * cx, w0 * ay + w1_ * by + w2_ * cy);
                }
#pragma unroll
                for (int h = 0; h < NHB; ++h) {
                    const unsigned a = *(const GAS unsigned*)(PBH + ((size_t)0 * TOK + tok) * 512 + h * HD + 2 * lane), b = *(const GAS unsigned*)(PBH + ((size_t)1 * TOK + tok) * 512 + h * HD + 2 * lane);
                    const float ox = __uint_as_float(a << 16) - lam * __uint_as_float(b << 16), oy = __uint_as_float(a & 0xffff0000u) - lam * __uint_as_float(b & 0xffff0000u);
                    const float rstd = 1.0f / sqrtf(wave_sum(ox * ox + oy * oy) * (1.0f / HD) + EPS);
                    mrow[(MIX_B + h * HD) / 2 + lane] = cvtpk_rne(ox * rstd * gx, oy * rstd * gy);
                }
            }
        } else {
            for (int m = gw; m < TOK; m += NGW) { const float s = wave_sum(lane < 32 ? SS[(size_t)m * 32 + lane] : 0.f); const float rstd = 1.0f / sqrtf(s * (1.0f / DM) + EPS);
                GAS f32x4* o4 = (GAS f32x4*)(out + (size_t)m * DM) + lane; const GAS f32x4* gr = (const GAS f32x4*)g_final + lane;
#pragma unroll
                for (int j = 0; j < 8; ++j) o4[64 * j] = o4[64 * j] * rstd * gr[64 * j]; }
        }
        if (step + 1 < args.ph_hi) xcd_barrier(bar);
    }
}

#ifndef MK_PER_PHASE
#define MK_PER_PHASE 0
#endif
extern "C" void kernel_launch(void* const* d_in, const int* in_sizes, int n_in, void* d_out, int out_size, void* d_ws, size_t ws_size, hipStream_t stream) {
    static int grid = 0;
    if (grid == 0) {
        if (n_in != 14 || out_size != TOK * DM || ws_size < WS_END) { fprintf(stderr, "kernel_launch: unexpected shapes (n_in %d out %d ws %zu)\n", n_in, out_size, ws_size); grid = -1; return; }
        int dev = 0, cus = 0, per_cu = 0;
        if (hipGetDevice(&dev) != hipSuccess || hipDeviceGetAttribute(&cus, hipDeviceAttributeMultiprocessorCount, dev) != hipSuccess) { grid = -1; return; }
        if (hipFuncSetAttribute((const void*)fwd_kernel, hipFuncAttributeMaxDynamicSharedMemorySize, LDS_BYTES) != hipSuccess) { fprintf(stderr, "kernel_launch: hipFuncSetAttribute failed\n"); grid = -1; return; }
        if (hipOccupancyMaxActiveBlocksPerMultiprocessor(&per_cu, (const void*)fwd_kernel, NWAVES * 64, LDS_BYTES) != hipSuccess || per_cu < 1) { fprintf(stderr, "kernel_launch: occupancy query says %d blocks per CU\n", per_cu); grid = -1; (void)hipGetLastError(); return; }
        (void)hipGetLastError();
        grid = cus;
    }
    if (grid < 0) return;
    if (hipMemsetAsync((char*)d_ws + WS_CTL, 0, CTL_ZERO_BYTES, stream) != hipSuccess) return;
    Args a{};
    for (int i = 0; i < 14; ++i) a.in[i] = (const float*)d_in[i];
    a.out = (float*)d_out; a.ws = (unsigned char*)d_ws;
#if MK_PER_PHASE
    for (int ph = 0; ph < N_STEPS; ++ph) { a.ph_lo = ph; a.ph_hi = ph + 1; a.use_bar = 0; hipLaunchKernelGGL(fwd_kernel, dim3(grid), dim3(NWAVES * 64), LDS_BYTES, stream, a); }
#else
    a.ph_lo = 0; a.ph_hi = N_STEPS; a.use_bar = 1;
    void* kargs[] = {(void*)&a};
    const hipError_t le = hipLaunchCooperativeKernel((const void*)fwd_kernel, dim3(grid), dim3(NWAVES * 64), kargs, (unsigned)LDS_BYTES, stream);
    if (le != hipSuccess) fprintf(stderr, "kernel_launch: cooperative launch failed: %s (grid %d x %d threads, %d B LDS)\n", hipGetErrorName(le), grid, NWAVES * 64, LDS_BYTES);
#endif
}
```

```cpp
#include <hip/hip_runtime.h>
#include <cstdio>
#include <cstdint>
#include <cmath>
namespace pg8 {
#define PG8_LAS __attribute__((address_space(3)))
typedef unsigned short bf16_t;
typedef short bf16x8 __attribute__((ext_vector_type(8)));
typedef float f32x4 __attribute__((ext_vector_type(4)));
typedef unsigned u32x4 __attribute__((ext_vector_type(4)));
constexpr int BM = 256, BK = 64, HALF = 128, HTB = HALF * BK * 2  , STAGE_BYTES = 8 * HTB, NXCD = 8, WGM = 8;

__host__ __device__ __forceinline__ int lds_byte(int r, int c) { const int st = (r >> 4) * 2 + (c >> 5), rr = r & 15, cc = c & 31, ob = rr * 64 + cc * 2; return st * 1024 + (ob ^ (((ob >> 9) & 1) << 5)); }
__host__ __device__ __forceinline__ void stage_rc(int b, int& R, int& C) { const int st = b / 1024, sb = b % 1024, swz = sb ^ (((sb >> 9) & 1) << 5); R = (st >> 1) * 16 + swz / 64; C = (st & 1) * 32 + (swz % 64) / 2; }
__host__ __device__ __forceinline__ int perm32(int rho) { const int n = rho >> 4, i = rho & 15; return 8 * (i >> 2) + 4 * n + (i & 3); }

struct Unit { int pm, pn; };
struct Gemm { const bf16_t* A; const bf16_t* Bt; int M, N, K; };

struct StaticOrder {
    int nM, nN, nwg, G, c;
    __host__ __device__ void init(int M, int N, int G_, int c_) { nM = M / BM; nN = N / BM; nwg = nM * nN; G = G_; c = c_; }
    __host__ __device__ bool next(int i, Unit& u) const {
        const long L = (long)i * G + c; if (L >= nwg) return false;
        int wgid = (int)L; { const int q = nwg / NXCD, r = nwg % NXCD, xcd = wgid % NXCD, off = wgid / NXCD; wgid = (xcd < r ? xcd * (q + 1) : r * (q + 1) + (xcd - r) * q) + off; }
        const int nig = WGM * nN, gid = wgid / nig, fm = gid * WGM, gsz = (nM - fm) < WGM ? (nM - fm) : WGM;
        u.pm = fm + ((wgid % nig) % gsz); u.pn = (wgid % nig) / gsz; return true;
    }
    __device__ __forceinline__ void a_ready(const Unit&) const {}
    __device__ __forceinline__ void done(const Unit&) const {}
};

__device__ __forceinline__ unsigned cvt_pk_bf16(float lo, float hi) { unsigned r; asm volatile("v_cvt_pk_bf16_f32 %0, %1, %2" : "=v"(r) : "v"(lo), "v"(hi)); return r; }
typedef float f32x2 __attribute__((ext_vector_type(2)));


__device__ __forceinline__ float sum_fq(float s) {
    { float t = __shfl_xor(s, 16); asm volatile("s_waitcnt lgkmcnt(0)" : "+v"(t)); s += t; }
    { float t = __shfl_xor(s, 32); asm volatile("s_waitcnt lgkmcnt(0)" : "+v"(t)); s += t; }
    return s;
}
struct EpiAny {
    static constexpr bool AFTER_DRAIN = false;
    int mode; bool perm; bf16_t* O; const float* base; float* out; int ldc;
    const float* ss_in; float* ss_out; bf16_t* xb; const float* g;
    __device__ __forceinline__ void operator()(const f32x4 (&acc)[2][2][4][2], const Unit& u, int wr, int wc, int fr, int fq) const {
        if (mode != 2) {
            const int row0 = u.pm * BM + wr * 64 + fr; const int col0 = u.pn * BM + wc * 32 + 8 * fq;
#pragma unroll
            for (int ai = 0; ai < 2; ++ai)
#pragma unroll
                for (int m = 0; m < 4; ++m) { const int row = row0 + ai * HALF + m * 16;
                    const f32x4 s0 = *(const f32x4*)(ss_in + (size_t)row * 32 + 8 * fq), s1 = *(const f32x4*)(ss_in + (size_t)row * 32 + 8 * fq + 4);
                    float ss = ((s0[0] + s0[1]) + (s0[2] + s0[3])) + ((s1[0] + s1[1]) + (s1[2] + s1[3]));
                    ss = sum_fq(ss);
                    const float rstd = 1.0f / sqrtf(ss * (1.0f / 2048.0f) + 1e-6f);
                    bf16_t* rowp = O + (size_t)row * ldc + col0;
#pragma unroll
                    for (int bj = 0; bj < 2; ++bj) { f32x4 v0 = acc[ai][bj][m][0] * rstd, v1 = acc[ai][bj][m][1] * rstd;
                        if (mode == 1) {
#pragma unroll
                            for (int e = 0; e < 4; ++e) { const float a = v0[e] > 0.f ? v0[e] : 0.f, b = v1[e] > 0.f ? v1[e] : 0.f; v0[e] = a * a; v1[e] = b * b; } }
                        u32x4 w; w.x = cvt_pk_bf16(v0[0], v0[1]); w.y = cvt_pk_bf16(v0[2], v0[3]); w.z = cvt_pk_bf16(v1[0], v1[1]); w.w = cvt_pk_bf16(v1[2], v1[3]);
                        *(u32x4*)(rowp + bj * HALF) = w; } }
        } else {
            typedef unsigned u32x2 __attribute__((ext_vector_type(2)));
            const int col0 = u.pn * BM + wc * 32 + 4 * fq;
            f32x4 gv[2][2];
#pragma unroll
            for (int bj = 0; bj < 2; ++bj)
#pragma unroll
                for (int n = 0; n < 2; ++n) gv[bj][n] = xb ? *(const f32x4*)(g + col0 + bj * HALF + n * 16) : (f32x4){0.f, 0.f, 0.f, 0.f};
#pragma unroll
            for (int ai = 0; ai < 2; ++ai)
#pragma unroll
                for (int m = 0; m < 4; ++m) { const int row = u.pm * BM + ai * HALF + wr * 64 + m * 16 + fr; const size_t off = (size_t)row * ldc + col0;
                    f32x4 bs[2][2];
#pragma unroll
                    for (int bj = 0; bj < 2; ++bj)
#pragma unroll
                        for (int n = 0; n < 2; ++n) bs[bj][n] = *(const f32x4*)(base + off + bj * HALF + n * 16);
                    float ss = 0.f;
#pragma unroll
                    for (int bj = 0; bj < 2; ++bj)
#pragma unroll
                        for (int n = 0; n < 2; ++n) { const f32x4 v = bs[bj][n] + acc[ai][bj][m][n]; *(f32x4*)(out + off + bj * HALF + n * 16) = v;
                            ss += (v[0] * v[0] + v[1] * v[1]) + (v[2] * v[2] + v[3] * v[3]);
                            if (xb) { const f32x4 y = v * gv[bj][n]; u32x2 w; w.x = cvt_pk_bf16(y[0], y[1]); w.y = cvt_pk_bf16(y[2], y[3]); *(u32x2*)(xb + off + bj * HALF + n * 16) = w; } }
                    ss = sum_fq(ss);
                    if (fq == 0) ss_out[(size_t)row * 32 + 4 * u.pn + wc] = ss;
                    asm volatile("" ::: "memory"); }
        }
    }
};

template <class Epi, class Sched, bool ALIGN_EPI = false, bool SP2 = false>
__device__ __forceinline__ void gemm_phase(PG8_LAS unsigned char* lds, const Gemm g, const Sched& S, const Epi& E, int tid_in) {
    int tid = tid_in; asm volatile("" : "+v"(tid));
    const int wid = __builtin_amdgcn_readfirstlane(tid >> 6), lane = tid & 63, wr = wid >> 2, wc = wid & 3, fr = lane & 15, fq = lane >> 4;
    const int K = g.K, nt = K / BK;
    unsigned voffA[2], voffB[2];
#pragma unroll
    for (int i = 0; i < 2; ++i) { int R, C; stage_rc(tid * 16 + i * 8192, R, C); const int Rb = E.perm ? ((R & ~31) + perm32(R & 31)) : R;
        voffA[i] = (unsigned)(R * K + C) * 2u; voffB[i] = (unsigned)(Rb * K + C) * 2u; }
    const size_t kstep = (size_t)(BK * 2);
    const size_t hstep = (size_t)HALF * K * 2;
    const size_t tstep = 2 * hstep;
    const unsigned ldsw = (unsigned)wid * 1024u;
    const int aoff = lds_byte(wr * 64 + fr, fq * 8), boff = lds_byte(wc * 32 + fr, fq * 8);
#define PG8_SA(b, h) (((b) * 2 + (h)) * HTB)
#define PG8_SB(b, h) ((4 + (b) * 2 + (h)) * HTB)
#define PG8_STAGE(bufoff, gbase, voff) do { _Pragma("unroll") for (int _i = 0; _i < 2; ++_i) \
        __builtin_amdgcn_global_load_lds((const unsigned*)((const char*)(gbase) + (voff)[_i]), (PG8_LAS unsigned*)(lds + (bufoff) + ldsw + _i * 8192), 16, 0, 0); } while (0)
#define PG8_LDA(dst, b, h) do { _Pragma("unroll") for (int m = 0; m < 4; ++m) _Pragma("unroll") for (int k = 0; k < 2; ++k) dst[m][k] = *(const PG8_LAS bf16x8*)(lds + PG8_SA(b, h) + aoff + m * 2048 + k * 1024); } while (0)
#define PG8_LDB(dst, b, h) do { _Pragma("unroll") for (int n = 0; n < 2; ++n) _Pragma("unroll") for (int k = 0; k < 2; ++k) dst[n][k] = *(const PG8_LAS bf16x8*)(lds + PG8_SB(b, h) + boff + n * 2048 + k * 1024); } while (0)
#define PG8_MMA(ai, bj, At, Bt) do { __builtin_amdgcn_s_setprio(1); _Pragma("unroll") for (int m = 0; m < 4; ++m) _Pragma("unroll") for (int n = 0; n < 2; ++n) _Pragma("unroll") for (int k = 0; k < 2; ++k) \
        acc[ai][bj][m][n] = __builtin_amdgcn_mfma_f32_16x16x32_bf16(Bt[n][k], At[m][k], acc[ai][bj][m][n], 0, 0, 0); __builtin_amdgcn_s_setprio(0); } while (0)
#define PG8_WAIT_V(n) asm volatile("s_waitcnt vmcnt(" #n ")" ::: "memory")
#define PG8_WAIT_L(n) asm volatile("s_waitcnt lgkmcnt(" #n ")" ::: "memory")
#define PG8_BAR __builtin_amdgcn_s_barrier()
#define PG8_SCHED __builtin_amdgcn_sched_barrier(0)
    Unit cur, nxt; int ui = 0;
    if (!S.next(0, cur)) return;
    f32x4 acc[2][2][4][2];
#pragma unroll
    for (int a = 0; a < 2; ++a)
#pragma unroll
        for (int b = 0; b < 2; ++b)
#pragma unroll
            for (int m = 0; m < 4; ++m)
#pragma unroll
                for (int n = 0; n < 2; ++n) acc[a][b][m][n] = (f32x4){0.f, 0.f, 0.f, 0.f};
    bf16x8 At[4][2], B0[2][2], B1[2][2];
    const char* cA = (const char*)g.A + (size_t)cur.pm * tstep; const char* cB = (const char*)g.Bt + (size_t)cur.pn * tstep;
    S.a_ready(cur);
    if constexpr (SP2) {
        PG8_STAGE(PG8_SB(0, 0), cB, voffB); PG8_STAGE(PG8_SB(0, 1), cB + hstep, voffB); PG8_STAGE(PG8_SA(0, 0), cA, voffA); PG8_STAGE(PG8_SA(0, 1), cA + hstep, voffA);
        if (wr == 1) PG8_BAR;
        PG8_WAIT_V(2); PG8_BAR;
        PG8_STAGE(PG8_SB(1, 0), cB + kstep, voffB); PG8_STAGE(PG8_SA(1, 0), cA + kstep, voffA); PG8_STAGE(PG8_SB(1, 1), cB + hstep + kstep, voffB);
        PG8_WAIT_V(6); PG8_BAR;
    } else {
        PG8_STAGE(PG8_SB(0, 0), cB, voffB); PG8_STAGE(PG8_SA(0, 0), cA, voffA); PG8_STAGE(PG8_SB(0, 1), cB + hstep, voffB); PG8_STAGE(PG8_SA(0, 1), cA + hstep, voffA);
        if (wr == 1) PG8_BAR;
        PG8_WAIT_V(4); PG8_BAR;
        PG8_STAGE(PG8_SB(1, 0), cB + kstep, voffB); PG8_STAGE(PG8_SA(1, 0), cA + kstep, voffA); PG8_STAGE(PG8_SB(1, 1), cB + hstep + kstep, voffB);
        PG8_WAIT_V(6); PG8_BAR;
    }
    for (;;) {
        const bool has_next = S.next(ui + 1, nxt);
        const char* nA = has_next ? (const char*)g.A + (size_t)nxt.pm * tstep : cA; const char* nB = has_next ? (const char*)g.Bt + (size_t)nxt.pn * tstep : cB;
        for (int t = 0; t < nt; t += 2) {
            const bool last = (t == nt - 2);
            const char* a1 = cA + (size_t)(t + 1) * kstep;
            const char* a2 = last ? nA : cA + (size_t)(t + 2) * kstep; const char* b2 = last ? nB : cB + (size_t)(t + 2) * kstep;
            const char* a3 = a2 + kstep; const char* b3 = b2 + kstep;
            if (last && has_next) S.a_ready(nxt);
            if constexpr (SP2) {
            PG8_LDB(B0, 0, 0); PG8_LDB(B1, 0, 1); PG8_SCHED; PG8_LDA(At, 0, 0); PG8_STAGE(PG8_SA(1, 1), a1 + hstep, voffA);
            PG8_WAIT_V(8); PG8_WAIT_L(0); PG8_BAR; PG8_MMA(0, 0, At, B0); PG8_MMA(0, 1, At, B1); PG8_BAR; PG8_SCHED;
            PG8_LDA(At, 0, 1); PG8_STAGE(PG8_SB(0, 0), b2, voffB); PG8_STAGE(PG8_SB(0, 1), b2 + hstep, voffB); PG8_STAGE(PG8_SA(0, 0), a2, voffA);
            PG8_WAIT_V(8); PG8_WAIT_L(0); PG8_BAR; PG8_MMA(1, 0, At, B0); PG8_MMA(1, 1, At, B1); PG8_BAR; PG8_SCHED;
            PG8_LDB(B0, 1, 0); PG8_LDB(B1, 1, 1); PG8_SCHED; PG8_LDA(At, 1, 0); PG8_STAGE(PG8_SA(0, 1), a2 + hstep, voffA);
            PG8_WAIT_V(8); PG8_WAIT_L(0); PG8_BAR; PG8_MMA(0, 0, At, B0); PG8_MMA(0, 1, At, B1); PG8_BAR; PG8_SCHED;
            PG8_LDA(At, 1, 1); PG8_STAGE(PG8_SB(1, 0), b3, voffB); PG8_STAGE(PG8_SB(1, 1), b3 + hstep, voffB); PG8_STAGE(PG8_SA(1, 0), a3, voffA);
            PG8_WAIT_V(8); PG8_WAIT_L(0); PG8_BAR; PG8_MMA(1, 0, At, B0); PG8_MMA(1, 1, At, B1); PG8_BAR; PG8_SCHED;
            } else {
            PG8_LDB(B0, 0, 0); PG8_SCHED; PG8_LDA(At, 0, 0); PG8_STAGE(PG8_SA(1, 1), a1 + hstep, voffA);
            PG8_WAIT_L(8); PG8_BAR; PG8_WAIT_L(0); PG8_MMA(0, 0, At, B0); PG8_BAR; PG8_SCHED;
            PG8_LDB(B1, 0, 1); PG8_STAGE(PG8_SB(0, 0), b2, voffB);
            PG8_BAR; PG8_WAIT_L(0); PG8_MMA(0, 1, At, B1); PG8_BAR;
            PG8_LDA(At, 0, 1); PG8_STAGE(PG8_SA(0, 0), a2, voffA);
            PG8_BAR; PG8_WAIT_L(0); PG8_MMA(1, 0, At, B0); PG8_BAR; PG8_SCHED;
            PG8_STAGE(PG8_SB(0, 1), b2 + hstep, voffB);
            PG8_WAIT_V(6); PG8_BAR; PG8_MMA(1, 1, At, B1); PG8_BAR;
            PG8_LDB(B0, 1, 0); PG8_SCHED; PG8_LDA(At, 1, 0); PG8_STAGE(PG8_SA(0, 1), a2 + hstep, voffA);
            PG8_WAIT_L(8); PG8_BAR; PG8_WAIT_L(0); PG8_MMA(0, 0, At, B0); PG8_BAR; PG8_SCHED;
            PG8_LDB(B1, 1, 1); PG8_STAGE(PG8_SB(1, 0), b3, voffB);
            PG8_BAR; PG8_WAIT_L(0); PG8_MMA(0, 1, At, B1); PG8_BAR;
            PG8_LDA(At, 1, 1); PG8_STAGE(PG8_SA(1, 0), a3, voffA);
            PG8_BAR; PG8_WAIT_L(0); PG8_MMA(1, 0, At, B0); PG8_BAR; PG8_SCHED;
            PG8_STAGE(PG8_SB(1, 1), b3 + hstep, voffB);
            PG8_WAIT_V(6); PG8_BAR; PG8_MMA(1, 1, At, B1); PG8_BAR;
            }
        }
        if constexpr (ALIGN_EPI) { if (wr == 0) PG8_BAR; }
        if constexpr (!Epi::AFTER_DRAIN) { E(acc, cur, wr, wc, fr, fq); S.done(cur); }
        if (!has_next) break;
#pragma unroll
        for (int a = 0; a < 2; ++a)
#pragma unroll
            for (int b = 0; b < 2; ++b)
#pragma unroll
                for (int m = 0; m < 4; ++m)
#pragma unroll
                    for (int n = 0; n < 2; ++n) acc[a][b][m][n] = (f32x4){0.f, 0.f, 0.f, 0.f};
        cur = nxt; cA = nA; cB = nB; ++ui;
        if constexpr (ALIGN_EPI) { if (wr == 1) PG8_BAR; }
    }
    PG8_WAIT_V(0);
    if constexpr (!ALIGN_EPI) { if (wr == 0) PG8_BAR; }
    PG8_BAR;
    if constexpr (Epi::AFTER_DRAIN) { E.fused(acc, cur, wr, wc, fr, fq, lds, wid, lane); S.done(cur); }
#undef PG8_SA
#undef PG8_SB
#undef PG8_STAGE
#undef PG8_LDA
#undef PG8_LDB
#undef PG8_MMA
#undef PG8_WAIT_V
#undef PG8_WAIT_L
#undef PG8_BAR
#undef PG8_SCHED
}
}
#define GAS __attribute__((address_space(1)))
#define LAS __attribute__((address_space(3)))
typedef unsigned short bf16;
typedef unsigned v4u __attribute__((ext_vector_type(4)));
typedef float f32x4 __attribute__((ext_vector_type(4)));
typedef short bf16x8 __attribute__((ext_vector_type(8)));
typedef GAS unsigned gu32;
typedef GAS unsigned long long gu64;
#define RLX_AGENT __ATOMIC_RELAXED, __HIP_MEMORY_SCOPE_AGENT
#define LDS_WAIT() asm volatile("s_waitcnt lgkmcnt(0)" ::: "memory")
#define VM_WAIT() asm volatile("s_waitcnt vmcnt(0)" ::: "memory")
__device__ __forceinline__ unsigned long long rt() { return __builtin_amdgcn_s_memrealtime(); }
__device__ __forceinline__ unsigned f2bf(float f) { unsigned u = __builtin_bit_cast(unsigned, f); return (u + 0x7fffu + ((u >> 16) & 1u)) >> 16; }
__device__ __forceinline__ unsigned pk2(float lo, float hi) { return f2bf(lo) | (f2bf(hi) << 16); }
#define XB_TMO      128
#define XB_XCNT(j)  (256  + 64 * (j))
#define XB_XSUB(j)  (1280 + 64 * (j))
#define XB_XGEN(j)  (2304 + 64 * (j))
#define XB_TOP      3328
#define XB_TOPGEN   3392
#define XCD_BAR_WORDS 3456
#define XB_SPIN_CAP (1u << 18)

__device__ __forceinline__ unsigned xb_ld(unsigned* p)              { return __hip_atomic_load(p, __ATOMIC_RELAXED, __HIP_MEMORY_SCOPE_AGENT); }
__device__ __forceinline__ unsigned xb_add(unsigned* p, unsigned v) { return __hip_atomic_fetch_add(p, v, __ATOMIC_RELAXED, __HIP_MEMORY_SCOPE_AGENT); }
__device__ __forceinline__ unsigned xb_xcc_id() { return (unsigned)__builtin_amdgcn_s_getreg((3 << 11) | 20) & 0xFu; }
#define XB_SPIN(cond, bar) do { unsigned _sp = 0; while (cond) { __builtin_amdgcn_s_sleep(1); \
    if ((++_sp & 255u) == 0u) { if (xb_ld(&(bar)[XB_TMO])) break; if (_sp > XB_SPIN_CAP) { atomicAdd(&(bar)[XB_TMO], 1u); break; } } } } while (0)

struct XcdBarrier {
    unsigned* bar; unsigned x;
    volatile LAS unsigned* st;
    bool leader;
};

__device__ __forceinline__ XcdBarrier xcd_barrier_post(unsigned* bar, volatile LAS unsigned* st) {
    XcdBarrier b; b.bar = bar; b.x = xb_xcc_id(); b.st = st; b.leader = false;
    if (threadIdx.x == 0) (void)xb_add(&bar[XB_XCNT(b.x)], 1u);
    return b;
}
__device__ __forceinline__ void xcd_barrier_complete(unsigned* bar, unsigned x, unsigned& nloc, unsigned& nx) {
    const unsigned G = gridDim.x * gridDim.y * gridDim.z;
    unsigned sum, cnt, mine, sp = 0u;
    for (;;) {
        sum = 0u; cnt = 0u; mine = 0u;
#pragma unroll
        for (unsigned j = 0; j < 16; ++j) { const unsigned c = xb_ld(&bar[XB_XCNT(j)]); sum += c; cnt += (c > 0u) ? 1u : 0u; mine = (j == x) ? c : mine; }
        if (sum == G) break;
        __builtin_amdgcn_s_sleep(1);
        if ((++sp & 255u) == 0u) { if (xb_ld(&bar[XB_TMO])) break; if (sp > XB_SPIN_CAP) { atomicAdd(&bar[XB_TMO], 1u); break; } }
    }
    nloc = mine > 0u ? mine : 1u; nx = cnt > 0u ? cnt : 1u;
}

__device__ __forceinline__ void xcd_barrier(const XcdBarrier& b) {
    asm volatile("s_waitcnt vmcnt(0)" ::: "memory");
    __syncthreads();
    if (b.leader) {
        unsigned* bar = b.bar;
        __builtin_amdgcn_s_waitcnt(0);
        unsigned nloc = b.st[0], nx = b.st[1];
        if (nloc == 0u) { xcd_barrier_complete(bar, b.x, nloc, nx); b.st[0] = nloc; b.st[1] = nx; }
        const unsigned old = xb_add(&bar[XB_XSUB(b.x)], 1u);
        const unsigned gen = old / nloc;
        if (old + 1u == (gen + 1u) * nloc) {
            __builtin_amdgcn_fence(__ATOMIC_RELEASE, "agent");
            asm volatile("s_waitcnt vmcnt(0)" ::: "memory");
            const unsigned og = xb_add(&bar[XB_TOP], 1u);
            const unsigned tg = og / nx;
            if (og + 1u == (tg + 1u) * nx) xb_add(&bar[XB_TOPGEN], 1u);
            else XB_SPIN(xb_ld(&bar[XB_TOPGEN]) == tg, bar);
            __builtin_amdgcn_fence(__ATOMIC_ACQUIRE, "agent");
            xb_add(&bar[XB_XGEN(b.x)], 1u);
            asm volatile("s_waitcnt vmcnt(0)" ::: "memory");
        } else {
            XB_SPIN(xb_ld(&bar[XB_XGEN(b.x)]) == gen, bar);
            __builtin_amdgcn_fence(__ATOMIC_ACQUIRE, "agent");
            asm volatile("s_waitcnt vmcnt(0)" ::: "memory");
        }
    }
    __syncthreads();
}
__device__ __forceinline__ float wave_sum(float v) {
#pragma unroll
    for (int o = 1; o < 64; o <<= 1) v += __shfl_xor(v, o);
    return v;
}
__device__ __forceinline__ unsigned cvtpk_rne(float lo, float hi) { typedef float f2 __attribute__((ext_vector_type(2))); typedef __bf16 b2 __attribute__((ext_vector_type(2)));
    f2 v = {lo, hi}; b2 b = __builtin_convertvector(v, b2); return __builtin_bit_cast(unsigned, b); }
__device__ __forceinline__ void p0_transpose_item64(const float* W, int K, int N, bf16* WT, LAS unsigned* scr, int item, int lane) {
    const int nblk = N / 64, kb = item / nblk, nb = item % nblk, k0 = 64 * kb, n0 = 64 * nb;
    const int g = lane >> 4, q = lane & 15;
    const float* src = W + (size_t)(k0 + 2 * g) * N + n0 + 4 * q;
    f32x4 v[16];
#pragma unroll
    for (int i = 0; i < 16; ++i) v[i] = *(const GAS f32x4*)(src + (size_t)(8 * (i >> 1) + (i & 1)) * N);
#pragma unroll
    for (int j = 0; j < 8; ++j)
#pragma unroll
        for (int e = 0; e < 4; ++e) scr[(4 * q + e) * 33 + 4 * j + g] = cvtpk_rne(v[2 * j][e], v[2 * j + 1][e]);
    LDS_WAIT(); asm volatile("" ::: "memory");
    const int c = lane & 7, nr = lane >> 3;
#pragma unroll
    for (int jj = 0; jj < 8; ++jj) { const int n = nr + 8 * jj; const LAS unsigned* s = scr + n * 33 + 4 * c;
        v4u o; o.x = s[0]; o.y = s[1]; o.z = s[2]; o.w = s[3];
        *(GAS v4u*)(WT + (size_t)(n0 + n) * K + k0 + 8 * c) = o; }
    LDS_WAIT(); asm volatile("" ::: "memory");
}


constexpr int NWAVES = 8;
constexpr int BATCH = 4, SEQ = 2048, DM = 2048, TOK = BATCH * SEQ, PW = 6144, DFF = 8192, HD = 128, DEPTH = 2;
constexpr int NHA = 6, NHB = 4, NHC = 6;
constexpr int COL_QA = 0, COL_KA = 768, COL_VA = 1536, COL_QB = 2304, COL_KB = 2816, COL_VB = 3328, COL_QC = 3840, COL_KC = 4608, COL_VC = 5376;
constexpr int MIX_A = 0, MIX_B = 768, MIX_C = 1280;
constexpr float EPS = 1e-6f;

constexpr size_t MiB = 1u << 20;
constexpr size_t WS_CTL = 0, CTL_ZERO_BYTES = 1 * MiB;
constexpr size_t WS_LUT = 1 * MiB;
constexpr size_t WS_SS = 459 * MiB;
constexpr size_t WS_WIN = 2 * MiB, WS_WOUT = 50 * MiB, WS_W1 = 66 * MiB, WS_W2 = 130 * MiB;
constexpr size_t WS_XB = 194 * MiB;
constexpr size_t WS_QKV = 226 * MiB;
constexpr size_t WS_MIX = 322 * MiB;
constexpr size_t WS_H = 226 * MiB;
constexpr size_t WS_PA = 354 * MiB;
constexpr size_t WS_LSE = 426 * MiB;
constexpr size_t WS_PB = 427 * MiB;
constexpr size_t WS_END = 460 * MiB;
constexpr int CW_BAR = 4096;
constexpr int CW_QUEUE = 8192;

constexpr int RING_OFF = 0, RING_BYTES = 131072;
constexpr int LDSCTL_OFF = RING_BYTES, MISC_OFF = LDSCTL_OFF + 320;
constexpr int LDS_BYTES = 147456;

struct Frame {
    LAS unsigned char* lds;
    volatile LAS unsigned* MISC;
    gu32* ctl;
    int tid, lane, wave, vcu, G;
};

namespace att {
typedef short bf16x8 __attribute__((ext_vector_type(8)));
typedef short s16x4 __attribute__((ext_vector_type(4)));
typedef float f32x16 __attribute__((ext_vector_type(16)));
typedef unsigned u32x4 __attribute__((ext_vector_type(4)));
typedef short v4i16_t __attribute__((ext_vector_type(4)));
constexpr int QP = PW;
constexpr int VPB = 320;
constexpr int VBYTES = 32 * VPB;

__device__ __forceinline__ int crow(int r, int hi) { return (r & 3) + 8 * (r >> 2) + 4 * hi; }
__device__ __forceinline__ unsigned cvtpk(float lo, float hi) { typedef float f2 __attribute__((ext_vector_type(2))); typedef __bf16 b2 __attribute__((ext_vector_type(2)));
    f2 v = {lo, hi}; b2 b = __builtin_convertvector(v, b2); return __builtin_bit_cast(unsigned, b); }
__device__ __forceinline__ s16x4 vtr(LAS const unsigned char* p) { return __builtin_bit_cast(s16x4, __builtin_amdgcn_ds_read_tr16_b64_v4i16((LAS v4i16_t*)p)); }

template <int NKS> __device__ __forceinline__ f32x16 qk_tile(const bf16x8 (&qf)[NKS], const bf16* krow) {
    bf16x8 kf[NKS];
#pragma unroll
    for (int ks = 0; ks < NKS; ++ks) kf[ks] = *(const bf16x8*)(krow + 16 * ks);
    f32x16 st = {0.f, 0.f, 0.f, 0.f, 0.f, 0.f, 0.f, 0.f, 0.f, 0.f, 0.f, 0.f, 0.f, 0.f, 0.f, 0.f};
#pragma unroll
    for (int ks = 0; ks < NKS; ++ks) st = __builtin_amdgcn_mfma_f32_32x32x16_bf16(kf[ks], qf[ks], st, 0, 0, 0);
    return st;
}
constexpr int VBLK = 1088;
#ifndef NT_DIFF
#define NT_DIFF 1
#endif
#ifndef NT_DIL
#define NT_DIL 1
#endif
constexpr int NT_OFF = 8 * VBLK;
__device__ __forceinline__ void dma_v(LAS unsigned char* vl, const bf16* Vb, int tk0, int tks, int lane) {
    const bf16* p = Vb + (size_t)(tk0 + 8 * tks * (lane >> 4)) * QP + (lane & 15) * 8; const size_t step = (size_t)tks * QP;
#pragma unroll
    for (int i = 0; i < 8; ++i) { __builtin_amdgcn_global_load_lds((const unsigned*)p, (LAS unsigned*)(vl + i * VBLK), 16, 0, 0); p += step; }
}
#ifndef DMA_WAIT_EXTRA
#define DMA_WAIT_EXTRA ""
#endif
__device__ __forceinline__ void dma_wait() { asm volatile("s_waitcnt vmcnt(0)" DMA_WAIT_EXTRA ::: "memory"); }
__device__ __forceinline__ void pv_tile(f32x16 (&o)[4], const bf16x8 (&pa)[2], LAS const unsigned char* vl, int lane) {
    const int hi = lane >> 5, g1 = (lane >> 4) & 1, i = lane & 15;
    LAS const unsigned char* base = vl + (4 * hi + (i >> 2)) * VBLK + (16 * g1 + 4 * (i & 3)) * 2;
#pragma unroll
    for (int db = 0; db < 4; ++db)
#pragma unroll
        for (int s = 0; s < 2; ++s) {
            const s16x4 lo = vtr(base + s * 512 + db * 64);
            const s16x4 hh = vtr(base + s * 512 + 256 + db * 64);
            const bf16x8 vf = {lo[0], lo[1], lo[2], lo[3], hh[0], hh[1], hh[2], hh[3]};
            o[db] = __builtin_amdgcn_mfma_f32_32x32x16_bf16(pa[s], vf, o[db], 0, 0, 0);
        }
}

constexpr float LOG2E = 1.4426950408889634f;
constexpr float THR2 = 6.0f;
__device__ __forceinline__ float ex2(float x) { return __builtin_amdgcn_exp2f(x); }
__device__ __forceinline__ float lg2(float x) { return __builtin_amdgcn_logf(x); }
__device__ __forceinline__ constexpr int ccol(int r) { return (r & 3) + 8 * (r >> 2); }

#ifndef LOADK_DRAIN
#define LOADK_DRAIN 0
#endif
__device__ __forceinline__ float xhalf(float v, int hi) { const auto rr = __builtin_amdgcn_permlane32_swap(__float_as_uint(v), __float_as_uint(v), false, false); return __uint_as_float(hi ? rr[0] : rr[1]); }
template <int NKS> __device__ __forceinline__ void load_k(bf16x8 (&kf)[NKS], const bf16* krow) {
#pragma unroll
    for (int ks = 0; ks < NKS; ++ks) kf[ks] = *(const bf16x8*)(krow + 16 * ks);
    if (LOADK_DRAIN) asm volatile("s_waitcnt vmcnt(0)" ::: "memory");
}
template <int NKS> __device__ __forceinline__ f32x16 qk_mma(const bf16x8 (&kf)[NKS], const bf16x8 (&qf)[NKS]) {
    f32x16 st = {0.f, 0.f, 0.f, 0.f, 0.f, 0.f, 0.f, 0.f, 0.f, 0.f, 0.f, 0.f, 0.f, 0.f, 0.f, 0.f};
#pragma unroll
    for (int ks = 0; ks < NKS; ++ks) st = __builtin_amdgcn_mfma_f32_32x32x16_bf16(kf[ks], qf[ks], st, 0, 0, 0);
    return st;
}
__device__ __forceinline__ void pack_p(bf16x8 (&pa)[2], const float (&t)[16]) {
    u32x4 w0 = {cvtpk(t[0], t[1]), cvtpk(t[2], t[3]), cvtpk(t[4], t[5]), cvtpk(t[6], t[7])}, w1 = {cvtpk(t[8], t[9]), cvtpk(t[10], t[11]), cvtpk(t[12], t[13]), cvtpk(t[14], t[15])};
    pa[0] = __builtin_bit_cast(bf16x8, w0); pa[1] = __builtin_bit_cast(bf16x8, w1);
}
__device__ __forceinline__ void sm_tile(float (&xm)[16], bool first, float& m2, float& l, f32x16 (&o)[4], bf16x8 (&pa)[2], int hi) {
    float a = fmaxf(fmaxf(xm[0], xm[1]), fmaxf(xm[2], xm[3])), b = fmaxf(fmaxf(xm[4], xm[5]), fmaxf(xm[6], xm[7]));
    a = fmaxf(a, fmaxf(fmaxf(xm[8], xm[9]), fmaxf(xm[10], xm[11]))); b = fmaxf(b, fmaxf(fmaxf(xm[12], xm[13]), fmaxf(xm[14], xm[15])));
    float mt = fmaxf(a, b); mt = fmaxf(mt, xhalf(mt, hi));
    if (first) {
        m2 += mt;
#pragma unroll
        for (int r = 0; r < 16; ++r) xm[r] -= mt;
    } else if (__any(mt > THR2)) {
        const float d = fmaxf(mt, 0.f), alpha = ex2(-d); m2 += d; l *= alpha;
#pragma unroll
        for (int r = 0; r < 16; ++r) xm[r] -= d;
        float f[16];
#pragma unroll
        for (int r = 0; r < 16; ++r) f[r] = __shfl(alpha, crow(r, hi));
        asm volatile("s_waitcnt lgkmcnt(0)" : "+v"(f[0]), "+v"(f[1]), "+v"(f[2]), "+v"(f[3]), "+v"(f[4]), "+v"(f[5]), "+v"(f[6]), "+v"(f[7]), "+v"(f[8]), "+v"(f[9]), "+v"(f[10]), "+v"(f[11]), "+v"(f[12]), "+v"(f[13]), "+v"(f[14]), "+v"(f[15]));
#pragma unroll
        for (int r = 0; r < 16; ++r)
#pragma unroll
            for (int db = 0; db < 4; ++db) o[db][r] *= f[r];
    }
    float ls = 0.f;
#pragma unroll
    for (int r = 0; r < 16; ++r) { xm[r] = ex2(xm[r]); ls += xm[r]; }
    l += ls;
    pack_p(pa, xm);
}
__device__ __forceinline__ void store_o_bf16(const f32x16 (&o)[4], float fq  , bool use_f, bf16* Ob, int tok0, int tstride, int pitch, LAS unsigned char* vl, int lane) {
    const int qi = lane & 31, hi = lane >> 5;
#pragma unroll
    for (int r = 0; r < 16; ++r) { const int qq = crow(r, hi); const float f = use_f ? __shfl(fq, qq) : 1.0f;
#pragma unroll
        for (int db = 0; db < 4; ++db) *(LAS unsigned short*)(vl + qq * VPB + (32 * db + qi) * 2) = (unsigned short)(cvtpk(o[db][r] * f, 0.f) & 0xffffu); }
    asm volatile("s_waitcnt lgkmcnt(0)" ::: "memory");
#pragma unroll
    for (int i = 0; i < 8; ++i) { const int row = 4 * i + (lane >> 4); const u32x4 v = *(LAS const u32x4*)(vl + row * VPB + (lane & 15) * 16);
        *(u32x4*)(Ob + (size_t)(tok0 + tstride * row) * pitch + (lane & 15) * 8) = v; }
    asm volatile("s_waitcnt lgkmcnt(0)" ::: "memory");
}

__device__ __forceinline__ void diff_item(const bf16* Qb, const bf16* Kb, const bf16* Vb, int qt, const float* lut2, const int* thrtab, bf16* Ob, LAS unsigned char* vl, int lane_in) {
    int lane = lane_in; asm volatile("" : "+v"(lane));
    const int qi = lane & 31, hi = lane >> 5; const float c1 = 0.125f * LOG2E;
    bf16x8 qf[4]; load_k<4>(qf, Qb + (size_t)(32 * qt + qi) * QP + 8 * hi);
    f32x16 o[4];
#pragma unroll
    for (int db = 0; db < 4; ++db)
#pragma unroll
        for (int r = 0; r < 16; ++r) o[db][r] = 0.f;
    float m2 = 0.f, l = 0.f;
    bf16x8 kf[4];
    load_k<4>(kf, Kb + (size_t)qi * QP + 8 * hi);
    int thrL = thrtab[lane]; float b0L = lut2[32 * lane - 31 < 0 ? 0 : 32 * lane - 31], b1L = lut2[32 * lane + 31];
    LAS float* NT = (LAS float*)(vl + NT_OFF);
#pragma unroll
    for (int i = 0; i < 4; ++i) { const int idx = 64 * i + lane; NT[idx] = lut2[idx < 32 ? 0 : idx - 32]; }
    asm volatile("s_waitcnt vmcnt(0) lgkmcnt(0)" : "+v"(thrL), "+v"(b0L), "+v"(b1L) :: "memory");
#pragma nounroll
    for (int kt = 0; kt <= qt; ++kt) {
        const int D = qt - kt, ktn = kt < qt ? kt + 1 : qt;
        const int thr = __builtin_amdgcn_readlane(thrL, D);
        float xm[16]; bf16x8 pa[2];
        if (thr < 0) {
            const LAS float* nt = NT + (32 * D + qi - 4 * hi + 32 - 27);
            float bias[16];
#pragma unroll
            for (int r = 0; r < 16; ++r) bias[r] = nt[27 - ccol(r)];
            asm volatile("s_waitcnt lgkmcnt(0)" : "+v"(bias[0]), "+v"(bias[1]), "+v"(bias[2]), "+v"(bias[3]), "+v"(bias[4]), "+v"(bias[5]), "+v"(bias[6]), "+v"(bias[7]), "+v"(bias[8]), "+v"(bias[9]), "+v"(bias[10]), "+v"(bias[11]), "+v"(bias[12]), "+v"(bias[13]), "+v"(bias[14]), "+v"(bias[15]) :: "memory");
            const f32x16 st = qk_mma<4>(kf, qf);
            dma_v(vl, Vb, 32 * kt, 1, lane);
            load_k<4>(kf, Kb + (size_t)(32 * ktn + qi) * QP + 8 * hi);
#pragma unroll
            for (int r = 0; r < 16; ++r) xm[r] = st[r] * c1 + (bias[r] - m2);
            if (D == 0) {
#pragma unroll
                for (int r = 0; r < 16; ++r) xm[r] = (crow(r, hi) <= qi) ? xm[r] : -INFINITY;
            }
        } else {
            const float b0m = __builtin_bit_cast(float, __builtin_amdgcn_readlane(__builtin_bit_cast(int, b0L), D)) - m2, b1m = __builtin_bit_cast(float, __builtin_amdgcn_readlane(__builtin_bit_cast(int, b1L), D)) - m2; const int y2 = 32 * D + qi - thr - 4 * hi;
            const f32x16 st = qk_mma<4>(kf, qf);
            dma_v(vl, Vb, 32 * kt, 1, lane);
            load_k<4>(kf, Kb + (size_t)(32 * ktn + qi) * QP + 8 * hi);
#pragma unroll
            for (int r = 0; r < 16; ++r) xm[r] = st[r] * c1 + ((ccol(r) <= y2) ? b1m : b0m);
        }
        sm_tile(xm, kt == 0, m2, l, o, pa, hi);
        dma_wait();
        pv_tile(o, pa, vl, lane);
    }
    const float lt = l + xhalf(l, hi);
    store_o_bf16(o, 1.0f / lt, true, Ob, 32 * qt, 1, 512, vl, lane);
}

__device__ __forceinline__ void dil_item(const bf16* Qb, const bf16* Kb, const bf16* Vb, int dil, int rr, int n32, const float* lut2, bf16* Ob, float* lseb, LAS unsigned char* vl, int lane_in) {
    int lane = lane_in; asm volatile("" : "+v"(lane));
    const int qi = lane & 31, hi = lane >> 5; const float c1 = 0.08838834764831845f * LOG2E;
    const int tq0 = 32 * n32 * dil + rr;
    bf16x8 qf[8]; load_k<8>(qf, Qb + (size_t)(tq0 + qi * dil) * QP + 8 * hi);
    f32x16 o[4];
#pragma unroll
    for (int db = 0; db < 4; ++db)
#pragma unroll
        for (int r = 0; r < 16; ++r) o[db][r] = 0.f;
    float m2 = 0.f, l = 0.f;
    const int kt_lo = n32 >= 4 ? 0 : 4 - n32;
    LAS float* NT = (LAS float*)(vl + NT_OFF);
#pragma unroll
    for (int i = 0; i < 4; ++i) { const int idx = 64 * i + lane; int dl = (idx - 32) * dil; dl = dl < 0 ? 0 : (dl > 2047 ? 2047 : dl); NT[idx] = lut2[dl]; }
    asm volatile("s_waitcnt vmcnt(0) lgkmcnt(0)" ::: "memory");
#pragma nounroll
    for (int kt = kt_lo; kt <= 4; ++kt) {
        const int tkc = 32 * (n32 - 4 + kt) * dil + rr;
        const LAS float* nt = NT + (128 - 32 * kt + qi - 4 * hi + 32 - 27);
        float bias[16];
#pragma unroll
        for (int r = 0; r < 16; ++r) bias[r] = nt[27 - ccol(r)];
        asm volatile("s_waitcnt lgkmcnt(0)" : "+v"(bias[0]), "+v"(bias[1]), "+v"(bias[2]), "+v"(bias[3]), "+v"(bias[4]), "+v"(bias[5]), "+v"(bias[6]), "+v"(bias[7]), "+v"(bias[8]), "+v"(bias[9]), "+v"(bias[10]), "+v"(bias[11]), "+v"(bias[12]), "+v"(bias[13]), "+v"(bias[14]), "+v"(bias[15]) :: "memory");
        bf16x8 kf[8]; load_k<8>(kf, Kb + (size_t)(tkc + qi * dil) * QP + 8 * hi);
        dma_v(vl, Vb, tkc, dil, lane);
        const f32x16 st = qk_mma<8>(kf, qf);
        float xm[16]; bf16x8 pa[2];
#pragma unroll
        for (int r = 0; r < 16; ++r) xm[r] = st[r] * c1 + (bias[r] - m2);
        if (kt == 0) {
#pragma unroll
            for (int r = 0; r < 16; ++r) xm[r] = (crow(r, hi) >= qi) ? xm[r] : -INFINITY;
        }
        if (kt == 4) {
#pragma unroll
            for (int r = 0; r < 16; ++r) xm[r] = (crow(r, hi) <= qi) ? xm[r] : -INFINITY;
        }
        sm_tile(xm, kt == kt_lo, m2, l, o, pa, hi);
        dma_wait();
        pv_tile(o, pa, vl, lane);
    }
    const float lt = l + xhalf(l, hi);
    if (lane < 32) lseb[(size_t)(tq0 + qi * dil) * 6] = m2 + lg2(lt);
    store_o_bf16(o, 1.0f / lt, true, Ob, tq0, dil, 768, vl, lane);
}

__device__ __forceinline__ void stick_item(const bf16* Qb, const bf16* Kb, const bf16* Vb, int qt, bf16* Ob, LAS unsigned char* vl, int lane_in) {
    int lane = lane_in; asm volatile("" : "+v"(lane));
    const int qi = lane & 31, hi = lane >> 5; const float c1 = 0.08838834764831845f * LOG2E;
    bf16x8 qf[8]; load_k<8>(qf, Qb + (size_t)(32 * qt + qi) * QP + 8 * hi);
    f32x16 o[4];
#pragma unroll
    for (int db = 0; db < 4; ++db)
#pragma unroll
        for (int r = 0; r < 16; ++r) o[db][r] = 0.f;
    float R = 0.f;
    bf16x8 kf[8];
    load_k<8>(kf, Kb + (size_t)(32 * qt + qi) * QP + 8 * hi);
#pragma nounroll
    for (int kt = qt; kt >= 0; --kt) {
        const int ktn = kt > 0 ? kt - 1 : 0;
        const f32x16 st = qk_mma<8>(kf, qf);
        dma_v(vl, Vb, 32 * kt, 1, lane);
        load_k<8>(kf, Kb + (size_t)(32 * ktn + qi) * QP + 8 * hi);
        float u[16], zl[16];
#pragma unroll
        for (int r = 0; r < 16; ++r) { const float z = st[r] * c1; const float sp = fmaxf(z, 0.f) + lg2(1.0f + ex2(-fabsf(z)));
            u[r] = -sp; zl[r] = z - sp; }
        if (kt == qt) {
#pragma unroll
            for (int r = 0; r < 16; ++r) { const bool v = crow(r, hi) < qi; u[r] = v ? u[r] : 0.f; zl[r] = v ? zl[r] : -INFINITY; }
        }
        float gs[4], pg[4], tot[4], aft[4];
#pragma unroll
        for (int c = 0; c < 4; ++c) { gs[c] = (u[4 * c] + u[4 * c + 1]) + (u[4 * c + 2] + u[4 * c + 3]); pg[c] = xhalf(gs[c], hi); tot[c] = gs[c] + pg[c]; }
        aft[3] = (hi == 0) ? pg[3] : 0.f;
        aft[2] = tot[3] + ((hi == 0) ? pg[2] : 0.f);
        aft[1] = tot[3] + tot[2] + ((hi == 0) ? pg[1] : 0.f);
        aft[0] = tot[3] + tot[2] + tot[1] + ((hi == 0) ? pg[0] : 0.f);
        float a[16];
#pragma unroll
        for (int c = 0; c < 4; ++c) { const float b = R + aft[c];
            const float s2 = u[4 * c + 3], s1 = s2 + u[4 * c + 2], s0 = s1 + u[4 * c + 1];
            a[4 * c + 3] = ex2(zl[4 * c + 3] + b); a[4 * c + 2] = ex2(zl[4 * c + 2] + (b + s2));
            a[4 * c + 1] = ex2(zl[4 * c + 1] + (b + s1)); a[4 * c + 0] = ex2(zl[4 * c + 0] + (b + s0)); }
        R += (tot[0] + tot[1]) + (tot[2] + tot[3]);
        bf16x8 pa[2]; pack_p(pa, a);
        dma_wait();
        pv_tile(o, pa, vl, lane);
        if (__all(R < -150.0f)) break;
    }
    store_o_bf16(o, 1.0f, false, Ob, 32 * qt, 1, DM, vl, lane);
}
}

__device__ __forceinline__ void row_prep(const float* xrow, const float* g, bf16* orow, float* ss, int lane) {
    const GAS f32x4* xr = (const GAS f32x4*)xrow + lane; const GAS f32x4* gr = (const GAS f32x4*)g + lane;
    f32x4 v[8]; float s = 0.f;
#pragma unroll
    for (int j = 0; j < 8; ++j) { v[j] = xr[64 * j]; s += (v[j].x * v[j].x + v[j].y * v[j].y) + (v[j].z * v[j].z + v[j].w * v[j].w); }
    s = wave_sum(s);
    GAS unsigned long long* o8 = (GAS unsigned long long*)orow + lane;
#pragma unroll
    for (int j = 0; j < 8; ++j) { const f32x4 y = v[j] * gr[64 * j]; o8[64 * j] = (unsigned long long)cvtpk_rne(y.x, y.y) | ((unsigned long long)cvtpk_rne(y.z, y.w) << 32); }
    if (lane < 32) ss[lane] = lane == 0 ? s : 0.f;
}
__device__ __forceinline__ int t5_bucket(int n) {
    if (n < 16) return n;
    const int v = 16 + (int)(logf((float)n / 16.0f) / 4.852030263919617f * 16.0f);
    return v < 31 ? v : 31;
}

struct Args { const float* in[14]; float* out; unsigned char* ws; int ph_lo, ph_hi, use_bar, pad; };
constexpr int PPL = 6;
constexpr int N_PHASES = 1 + PPL * DEPTH + 1;
#ifndef PROBE_MASK
#define PROBE_MASK 0
#endif
#ifndef PROBE_VAR
#define PROBE_VAR 0
#endif
#ifndef PROBE_DUP
#define PROBE_DUP -1
#endif
constexpr int N_STEPS = N_PHASES + (PROBE_DUP < 0 ? 0 : (PROBE_DUP == 100 ? 1 : 2));
__device__ __forceinline__ int step_phase(int i) {
    if (PROBE_DUP < 0) return i;
    if (PROBE_DUP == 100) return i == 0 ? 0 : i - 1;
    const int A = 1 + PROBE_DUP, B = 1 + PPL + PROBE_DUP;
    if (i <= A) return i; if (i == A + 1) return A; if (i <= B + 1) return i - 1; if (i == B + 2) return B; return i - 2;
}

__global__ void __launch_bounds__(NWAVES * 64, 2) fwd_kernel(Args args) {
    extern __shared__ __attribute__((aligned(16))) unsigned char lds_raw[];
    Frame F;
    F.lds = (LAS unsigned char*)lds_raw;
    F.MISC = (volatile LAS unsigned*)(F.lds + MISC_OFF);
    F.tid = threadIdx.x; F.lane = F.tid & 63; F.wave = __builtin_amdgcn_readfirstlane(F.tid >> 6);
    F.G = gridDim.x; { const int bx = blockIdx.x; F.vcu = (F.G % 8 == 0) ? (bx % 8) * (F.G / 8) + bx / 8 : bx; }
    F.ctl = (gu32*)(args.ws + WS_CTL);
    for (int u = F.tid; u < (LDS_BYTES - LDSCTL_OFF) / 4; u += NWAVES * 64) ((LAS unsigned*)(F.lds + LDSCTL_OFF))[u] = 0u;
    __syncthreads();
    XcdBarrier bar; bar.bar = (unsigned*)(F.ctl + CW_BAR); bar.x = 0; bar.st = nullptr; bar.leader = false;
    if (args.use_bar) bar = xcd_barrier_post((unsigned*)(F.ctl + CW_BAR), F.MISC + 8);

    const int NGW = F.G * NWAVES;

    for (int step = args.ph_lo; step < args.ph_hi; ++step) {
        const int ph = step_phase(step);
        typedef const __attribute__((address_space(4))) Args* KArgs; KArgs ap = (KArgs)__builtin_amdgcn_kernarg_segment_ptr(); asm volatile("" : "+s"(ap));
        unsigned char* ws = ap->ws;
        const float* x_in = ap->in[0]; const float* w_in = ap->in[1]; const float* w_out = ap->in[2]; const float* g_attn = ap->in[3]; const float* g_mlp = ap->in[4];
        const float* w1 = ap->in[5]; const float* w2 = ap->in[6]; const float* rel_tab = ap->in[7];
        const float* lq1 = ap->in[8]; const float* lk1 = ap->in[9]; const float* lq2 = ap->in[10]; const float* lk2 = ap->in[11]; const float* subln_g = ap->in[12]; const float* g_final = ap->in[13];
        float* out = ap->out;
        bf16* WIN_T = (bf16*)(ws + WS_WIN); bf16* WOUT_T = (bf16*)(ws + WS_WOUT); bf16* W1_T = (bf16*)(ws + WS_W1); bf16* W2_T = (bf16*)(ws + WS_W2);
        bf16* XB = (bf16*)(ws + WS_XB); bf16* QKV = (bf16*)(ws + WS_QKV); bf16* MIX = (bf16*)(ws + WS_MIX); bf16* HB = (bf16*)(ws + WS_H);
        float* SS = (float*)(ws + WS_SS); bf16* PAH = (bf16*)(ws + WS_PA); float* LSE = (float*)(ws + WS_LSE); bf16* PBH = (bf16*)(ws + WS_PB); float* LUT = (float*)(ws + WS_LUT);
        int lane = (int)__builtin_amdgcn_mbcnt_hi(~0u, __builtin_amdgcn_mbcnt_lo(~0u, 0u)); asm volatile("" : "+v"(lane));
        const int wave = F.wave, tid = wave * 64 + lane, gw = F.vcu * NWAVES + wave;
        const int l = ph > 0 ? (ph - 1) / PPL : 0, pt = (ph > 0 && ph <= PPL * DEPTH) ? (ph - 1) % PPL : (ph == 0 ? -1 : 100);
        if (pt == 0 || pt == 3 || pt == 4 || pt == 5) {
            pg8::Gemm g; pg8::EpiAny E; int N;
            E.O = nullptr; E.base = nullptr; E.out = nullptr; E.ss_in = SS; E.ss_out = SS; E.xb = nullptr; E.g = nullptr;
            if (pt == 0)      { g.A = XB;  g.Bt = WIN_T + (size_t)l * PW * DM;  N = PW;  g.K = DM;  E.mode = 0; E.O = QKV; E.ldc = PW; }
            else if (pt == 3) { g.A = MIX; g.Bt = WOUT_T + (size_t)l * DM * DM; N = DM;  g.K = DM;  E.mode = 2; E.base = (l == 0) ? x_in : (const float*)out; E.out = out; E.ldc = DM;
                                E.xb = XB; E.g = g_mlp + (size_t)l * DM; }
            else if (pt == 4) { g.A = XB;  g.Bt = W1_T + (size_t)l * DFF * DM;  N = DFF; g.K = DM;  E.mode = 1; E.O = HB; E.ldc = DFF; }
            else              { g.A = HB;  g.Bt = W2_T + (size_t)l * DM * DFF;  N = DM;  g.K = DFF; E.mode = 2; E.base = (const float*)out; E.out = out; E.ldc = DM;
                                if (l + 1 < DEPTH) { E.xb = XB; E.g = g_attn + (size_t)(l + 1) * DM; } }
            g.M = TOK; g.N = N; E.perm = (E.mode != 2);
            pg8::StaticOrder S; S.init(TOK, N, F.G, (int)blockIdx.x);
            pg8::gemm_phase<pg8::EpiAny, pg8::StaticOrder, true, true>(F.lds + RING_OFF, g, S, E, tid);
        } else if (ph == 0) {
            LAS unsigned* scr = (LAS unsigned*)(F.lds + RING_OFF + wave * 16384);
            constexpr int I_IN = (DM / 64) * (PW / 64), I_OUT = (DM / 64) * (DM / 64), I_1 = (DM / 64) * (DFF / 64), I_2 = (DFF / 64) * (DM / 64), I_L = I_IN + I_OUT + I_1 + I_2;
            for (int it = gw; it < DEPTH * I_L; it += NGW) {
                const int ll = it / I_L; int r = it % I_L;
                const float* W; bf16* WT; int K, N;
                if (r < I_IN) { W = w_in + (size_t)ll * DM * PW; WT = WIN_T + (size_t)ll * PW * DM; K = DM; N = PW; }
                else if ((r -= I_IN) < I_OUT) { W = w_out + (size_t)ll * DM * DM; WT = WOUT_T + (size_t)ll * DM * DM; K = DM; N = DM; }
                else if ((r -= I_OUT) < I_1) { W = w1 + (size_t)ll * DM * DFF; WT = W1_T + (size_t)ll * DFF * DM; K = DM; N = DFF; }
                else { r -= I_1; W = w2 + (size_t)ll * DFF * DM; WT = W2_T + (size_t)ll * DM * DFF; K = DFF; N = DM; }
                p0_transpose_item64(W, K, N, WT, scr, r, lane);
            }
            for (int i = blockIdx.x * (NWAVES * 64) + tid; i < 10 * 2048; i += F.G * NWAVES * 64) { const int h = i >> 11, d = i & 2047; LUT[i] = rel_tab[t5_bucket(d) * 10 + h] * att::LOG2E; }
            if (blockIdx.x == 0 && tid < 64) {
                const int D = tid, dlo = 32 * D - 31 < 0 ? 0 : 32 * D - 31, dhi = 32 * D + 31, bl = t5_bucket(dlo), bh = t5_bucket(dhi); int thr = -1;
                if (D > 0 && bl == bh) thr = 1 << 30;
                else if (D > 0 && bh == bl + 1) { thr = dhi; for (int d = dhi; d >= dlo; --d) if (t5_bucket(d) == bh) thr = d; }
                ((int*)(LUT + 10 * 2048))[D] = thr;
            }
            for (int m = gw; m < TOK; m += NGW) row_prep(x_in + (size_t)m * DM, g_attn, XB + (size_t)m * DM, SS + (size_t)m * 32, lane);
        } else if (pt == 1) {
            LAS unsigned char* vl = F.lds + RING_OFF + wave * att::VBYTES;
            const int* thrtab = (const int*)(LUT + 10 * 2048);
            const int skip = (PROBE_DUP == 1 && (step == 2 || step == 3 + PPL)) ? PROBE_MASK : 0;
            for (int s = gw; s < ((skip & 1) ? 0 : 2048); s += NGW) {
                const int combo = s >> 6, j = s & 63, x = 4 * (j >> 3) + (j & 3), qt = (j & 4) ? x : 63 - x, b = combo >> 3, vh = combo & 7, h = vh >> 1, p = vh & 1;
                const bf16* base = QKV + (size_t)b * SEQ * PW;
                att::diff_item(base + COL_QB + h * HD + p * 64, base + COL_KB + h * HD + p * 64, base + COL_VB + h * HD, qt, LUT + (6 + h) * 2048, thrtab,
                               PBH + ((size_t)p * TOK + (size_t)b * SEQ) * 512 + h * HD, vl, lane);
            }
            const int nq = (F.G % 8 == 0) ? 8 : 1, xq = F.vcu / (F.G / nq);
            gu32* qctr = F.ctl + CW_QUEUE + 64 * (8 * step + xq);
            for (;;) {
                unsigned idx = 0; if (lane == 0) idx = __hip_atomic_fetch_add(qctr, 1u, __ATOMIC_RELAXED, __HIP_MEMORY_SCOPE_AGENT);
                idx = (unsigned)__builtin_amdgcn_readfirstlane((int)idx) * (unsigned)nq + (unsigned)xq;
                if (idx >= 768u + 1152u) break;
                if (idx < 768u) { if (skip & 2) continue;
                    const int bh = (int)idx >> 5, jj = (int)idx & 31, b = bh / 6, h = bh % 6; const bf16* base = QKV + (size_t)b * SEQ * PW;
#pragma nounroll
                    for (int rep = 0; rep < 2; ++rep)
                        att::stick_item(base + COL_QC + h * HD, base + COL_KC + h * HD, base + COL_VC + h * HD, 63 - (2 * jj + rep), MIX + (size_t)b * SEQ * DM + MIX_C + h * HD, vl, lane);
                } else { if (skip & 4) continue;
                    const int i2 = (int)idx - 768, p = i2 / 384, rem = i2 % 384, bh = rem >> 4, j4 = rem & 15, b = bh / 6, h = bh % 6;
                    const int dil = p == 0 ? 1 : (p == 1 ? 4 : 16), tpr = 64 / dil;
                    const bf16* base = QKV + (size_t)b * SEQ * PW;
#pragma nounroll
                    for (int rep = 0; rep < 4; ++rep) { const int j = 4 * j4 + rep;
                        att::dil_item(base + COL_QA + h * HD, base + COL_KA + h * HD, base + COL_VA + h * HD, dil, j / tpr, j % tpr, LUT + h * 2048,
                                      PAH + ((size_t)p * TOK + (size_t)b * SEQ) * 768 + h * HD, LSE + ((size_t)p * TOK + (size_t)b * SEQ) * 6 + h, vl, lane); }
                }
            }
        } else if (pt == 2) {
            const float lam_init = 0.8f - 0.6f * expf(-0.3f * (float)l);
            const float s1 = wave_sum(lq1[l * 64 + lane] * lk1[l * 64 + lane]), s2 = wave_sum(lq2[l * 64 + lane] * lk2[l * 64 + lane]);
            const float lam = expf(s1) - expf(s2) + lam_init;
            const float gx = subln_g[l * HD + 2 * lane] * (1.0f - lam_init), gy = subln_g[l * HD + 2 * lane + 1] * (1.0f - lam_init);
            typedef float f32x2 __attribute__((ext_vector_type(2)));
            for (int tok = gw; tok < TOK; tok += NGW) {
                GAS unsigned* mrow = (GAS unsigned*)(MIX + (size_t)tok * DM);
#pragma unroll
                for (int h = 0; h < NHA; ++h) {
                    const float l0 = LSE[((size_t)0 * TOK + tok) * 6 + h], l1 = LSE[((size_t)1 * TOK + tok) * 6 + h], l2 = LSE[((size_t)2 * TOK + tok) * 6 + h];
                    const float mx = fmaxf(l0, fmaxf(l1, l2)); float w0 = att::ex2(l0 - mx), w1_ = att::ex2(l1 - mx), w2_ = att::ex2(l2 - mx); const float inv = 1.0f / (w0 + w1_ + w2_);
                    w0 *= inv; w1_ *= inv; w2_ *= inv;
                    const unsigned a = *(const GAS unsigned*)(PAH + ((size_t)0 * TOK + tok) * 768 + h * HD + 2 * lane), b = *(const GAS unsigned*)(PAH + ((size_t)1 * TOK + tok) * 768 + h * HD + 2 * lane),
                                   c = *(const GAS unsigned*)(PAH + ((size_t)2 * TOK + tok) * 768 + h * HD + 2 * lane);
                    const float ax = __uint_as_float(a << 16), ay = __uint_as_float(a & 0xffff0000u), bx = __uint_as_float(b << 16), by = __uint_as_float(b & 0xffff0000u), cx = __uint_as_float(c << 16), cy = __uint_as_float(c & 0xffff0000u);
                    mrow[(MIX_A + h * HD) / 2 + lane] = cvtpk_rne(w0 * ax + w1_ * bx + w2_ * cx, w0 * ay + w1_ * by + w2_ * cy);
                }
#pragma unroll
                for (int h = 0; h < NHB; ++h) {
                    const unsigned a = *(const GAS unsigned*)(PBH + ((size_t)0 * TOK + tok) * 512 + h * HD + 2 * lane), b = *(const GAS unsigned*)(PBH + ((size_t)1 * TOK + tok) * 512 + h * HD + 2 * lane);
                    const float ox = __uint_as_float(a << 16) - lam * __uint_as_float(b << 16), oy = __uint_as_float(a & 0xffff0000u) - lam * __uint_as_float(b & 0xffff0000u);
                    const float rstd = 1.0f / sqrtf(wave_sum(ox * ox + oy * oy) * (1.0f / HD) + EPS);
                    mrow[(MIX_B + h * HD) / 2 + lane] = cvtpk_rne(ox * rstd * gx, oy * rstd * gy);
                }
            }
        } else {
            for (int m = gw; m < TOK; m += NGW) { const float s = wave_sum(lane < 32 ? SS[(size_t)m * 32 + lane] : 0.f); const float rstd = 1.0f / sqrtf(s * (1.0f / DM) + EPS);
                GAS f32x4* o4 = (GAS f32x4*)(out + (size_t)m * DM) + lane; const GAS f32x4* gr = (const GAS f32x4*)g_final + lane;
#pragma unroll
                for (int j = 0; j < 8; ++j) o4[64 * j] = o4[64 * j] * rstd * gr[64 * j]; }
        }
        if (step + 1 < args.ph_hi) { XcdBarrier b2 = bar; unsigned* bb = bar.bar; asm volatile("" : "+s"(bb)); b2.bar = bb; b2.leader = (wave == 0 && lane == 0); xcd_barrier(b2); }
    }
}

#ifndef MK_PER_PHASE
#define MK_PER_PHASE 0
#endif
extern "C" void kernel_launch(void* const* d_in, const int* in_sizes, int n_in, void* d_out, int out_size, void* d_ws, size_t ws_size, hipStream_t stream) {
    static int grid = 0;
    if (grid == 0) {
        if (n_in != 14 || out_size != TOK * DM || ws_size < WS_END) { fprintf(stderr, "kernel_launch: unexpected shapes (n_in %d out %d ws %zu)\n", n_in, out_size, ws_size); grid = -1; return; }
        int dev = 0, cus = 0, per_cu = 0;
        if (hipGetDevice(&dev) != hipSuccess || hipDeviceGetAttribute(&cus, hipDeviceAttributeMultiprocessorCount, dev) != hipSuccess) { grid = -1; return; }
        if (hipFuncSetAttribute((const void*)fwd_kernel, hipFuncAttributeMaxDynamicSharedMemorySize, LDS_BYTES) != hipSuccess) { fprintf(stderr, "kernel_launch: hipFuncSetAttribute failed\n"); grid = -1; return; }
        if (hipOccupancyMaxActiveBlocksPerMultiprocessor(&per_cu, (const void*)fwd_kernel, NWAVES * 64, LDS_BYTES) != hipSuccess || per_cu < 1) { fprintf(stderr, "kernel_launch: occupancy query says %d blocks per CU\n", per_cu); grid = -1; (void)hipGetLastError(); return; }
        (void)hipGetLastError();
        grid = cus;
    }
    if (grid < 0) return;
    if (hipMemsetAsync((char*)d_ws + WS_CTL, 0, CTL_ZERO_BYTES, stream) != hipSuccess) return;
    Args a{};
    for (int i = 0; i < 14; ++i) a.in[i] = (const float*)d_in[i];
    a.out = (float*)d_out; a.ws = (unsigned char*)d_ws;
#if MK_PER_PHASE
    for (int ph = 0; ph < N_STEPS; ++ph) { a.ph_lo = ph; a.ph_hi = ph + 1; a.use_bar = 0; hipLaunchKernelGGL(fwd_kernel, dim3(grid), dim3(NWAVES * 64), LDS_BYTES, stream, a); }
#else
    a.ph_lo = 0; a.ph_hi = N_STEPS; a.use_bar = 1;
    void* kargs[] = {(void*)&a};
    const hipError_t le = hipLaunchCooperativeKernel((const void*)fwd_kernel, dim3(grid), dim3(NWAVES * 64), kargs, (unsigned)LDS_BYTES, stream);
    if (le != hipSuccess) fprintf(stderr, "kernel_launch: cooperative launch failed: %s (grid %d x %d threads, %d B LDS)\n", hipGetErrorName(le), grid, NWAVES * 64, LDS_BYTES);
#endif
}
```

```cpp
#include <hip/hip_runtime.h>
#include <cstdio>
#include <cstdint>
#include <cmath>
namespace pg8 {
#define PG8_LAS __attribute__((address_space(3)))
typedef unsigned short bf16_t;
typedef short bf16x8 __attribute__((ext_vector_type(8)));
typedef float f32x4 __attribute__((ext_vector_type(4)));
typedef unsigned u32x4 __attribute__((ext_vector_type(4)));
constexpr int BM = 256, BK = 64, HALF = 128, HTB = HALF * BK * 2  , STAGE_BYTES = 8 * HTB, NXCD = 8, WGM = 8;

__host__ __device__ __forceinline__ int lds_byte(int r, int c) { const int st = (r >> 4) * 2 + (c >> 5), rr = r & 15, cc = c & 31, ob = rr * 64 + cc * 2; return st * 1024 + (ob ^ (((ob >> 9) & 1) << 5)); }
__host__ __device__ __forceinline__ void stage_rc(int b, int& R, int& C) { const int st = b / 1024, sb = b % 1024, swz = sb ^ (((sb >> 9) & 1) << 5); R = (st >> 1) * 16 + swz / 64; C = (st & 1) * 32 + (swz % 64) / 2; }
__host__ __device__ __forceinline__ int perm32(int rho) { const int n = rho >> 4, i = rho & 15; return 8 * (i >> 2) + 4 * n + (i & 3); }

struct Unit { int pm, pn; };
struct Gemm { const bf16_t* A; const bf16_t* Bt; int M, N, K; };

struct StaticOrder {
    int nM, nN, nwg, G, c;
    __host__ __device__ void init(int M, int N, int G_, int c_) { nM = M / BM; nN = N / BM; nwg = nM * nN; G = G_; c = c_; }
    __host__ __device__ bool next(int i, Unit& u) const {
        const long L = (long)i * G + c; if (L >= nwg) return false;
        int wgid = (int)L; { const int q = nwg / NXCD, r = nwg % NXCD, xcd = wgid % NXCD, off = wgid / NXCD; wgid = (xcd < r ? xcd * (q + 1) : r * (q + 1) + (xcd - r) * q) + off; }
        const int nig = WGM * nN, gid = wgid / nig, fm = gid * WGM, gsz = (nM - fm) < WGM ? (nM - fm) : WGM;
        u.pm = fm + ((wgid % nig) % gsz); u.pn = (wgid % nig) / gsz; return true;
    }
    __device__ __forceinline__ void a_ready(const Unit&) const {}
    __device__ __forceinline__ void done(const Unit&) const {}
};

__device__ __forceinline__ unsigned cvt_pk_bf16(float lo, float hi) { unsigned r; asm volatile("v_cvt_pk_bf16_f32 %0, %1, %2" : "=v"(r) : "v"(lo), "v"(hi)); return r; }
typedef float f32x2 __attribute__((ext_vector_type(2)));


__device__ __forceinline__ float sum_fq(float s) {
    { float t = __shfl_xor(s, 16); asm volatile("s_waitcnt lgkmcnt(0)" : "+v"(t)); s += t; }
    { float t = __shfl_xor(s, 32); asm volatile("s_waitcnt lgkmcnt(0)" : "+v"(t)); s += t; }
    return s;
}
struct EpiAny {
    static constexpr bool AFTER_DRAIN = false;
    int mode; bool perm; bf16_t* O; const float* base; float* out; int ldc;
    const float* ss_in; float* ss_out; bf16_t* xb; const float* g;
    __device__ __forceinline__ void operator()(const f32x4 (&acc)[2][2][4][2], const Unit& u, int wr, int wc, int fr, int fq) const {
        if (mode != 2) {
            const int row0 = u.pm * BM + wr * 64 + fr; const int col0 = u.pn * BM + wc * 32 + 8 * fq;
#pragma unroll
            for (int ai = 0; ai < 2; ++ai)
#pragma unroll
                for (int m = 0; m < 4; ++m) { const int row = row0 + ai * HALF + m * 16;
                    const f32x4 s0 = *(const f32x4*)(ss_in + (size_t)row * 32 + 8 * fq), s1 = *(const f32x4*)(ss_in + (size_t)row * 32 + 8 * fq + 4);
                    float ss = ((s0[0] + s0[1]) + (s0[2] + s0[3])) + ((s1[0] + s1[1]) + (s1[2] + s1[3]));
                    ss = sum_fq(ss);
                    const float rstd = 1.0f / sqrtf(ss * (1.0f / 2048.0f) + 1e-6f);
                    bf16_t* rowp = O + (size_t)row * ldc + col0;
#pragma unroll
                    for (int bj = 0; bj < 2; ++bj) { f32x4 v0 = acc[ai][bj][m][0] * rstd, v1 = acc[ai][bj][m][1] * rstd;
                        if (mode == 1) {
#pragma unroll
                            for (int e = 0; e < 4; ++e) { const float a = v0[e] > 0.f ? v0[e] : 0.f, b = v1[e] > 0.f ? v1[e] : 0.f; v0[e] = a * a; v1[e] = b * b; } }
                        u32x4 w; w.x = cvt_pk_bf16(v0[0], v0[1]); w.y = cvt_pk_bf16(v0[2], v0[3]); w.z = cvt_pk_bf16(v1[0], v1[1]); w.w = cvt_pk_bf16(v1[2], v1[3]);
                        *(u32x4*)(rowp + bj * HALF) = w; } }
        } else {
            typedef unsigned u32x2 __attribute__((ext_vector_type(2)));
            const int col0 = u.pn * BM + wc * 32 + 4 * fq;
            f32x4 gv[2][2];
#pragma unroll
            for (int bj = 0; bj < 2; ++bj)
#pragma unroll
                for (int n = 0; n < 2; ++n) gv[bj][n] = xb ? *(const f32x4*)(g + col0 + bj * HALF + n * 16) : (f32x4){0.f, 0.f, 0.f, 0.f};
#pragma unroll
            for (int ai = 0; ai < 2; ++ai)
#pragma unroll
                for (int m = 0; m < 4; ++m) { const int row = u.pm * BM + ai * HALF + wr * 64 + m * 16 + fr; const size_t off = (size_t)row * ldc + col0;
                    f32x4 bs[2][2];
#pragma unroll
                    for (int bj = 0; bj < 2; ++bj)
#pragma unroll
                        for (int n = 0; n < 2; ++n) bs[bj][n] = *(const f32x4*)(base + off + bj * HALF + n * 16);
                    float ss = 0.f;
#pragma unroll
                    for (int bj = 0; bj < 2; ++bj)
#pragma unroll
                        for (int n = 0; n < 2; ++n) { const f32x4 v = bs[bj][n] + acc[ai][bj][m][n]; *(f32x4*)(out + off + bj * HALF + n * 16) = v;
                            ss += (v[0] * v[0] + v[1] * v[1]) + (v[2] * v[2] + v[3] * v[3]);
                            if (xb) { const f32x4 y = v * gv[bj][n]; u32x2 w; w.x = cvt_pk_bf16(y[0], y[1]); w.y = cvt_pk_bf16(y[2], y[3]); *(u32x2*)(xb + off + bj * HALF + n * 16) = w; } }
                    ss = sum_fq(ss);
                    if (fq == 0) ss_out[(size_t)row * 32 + 4 * u.pn + wc] = ss;
                    asm volatile("" ::: "memory"); }
        }
    }
};

template <class Epi, class Sched, bool ALIGN_EPI = false, bool SP2 = false>
__device__ __forceinline__ void gemm_phase(PG8_LAS unsigned char* lds, const Gemm g, const Sched& S, const Epi& E, int tid_in) {
    int tid = tid_in; asm volatile("" : "+v"(tid));
    const int wid = __builtin_amdgcn_readfirstlane(tid >> 6), lane = tid & 63, wr = wid >> 2, wc = wid & 3, fr = lane & 15, fq = lane >> 4;
    const int K = g.K, nt = K / BK;
    unsigned voffA[2], voffB[2];
#pragma unroll
    for (int i = 0; i < 2; ++i) { int R, C; stage_rc(tid * 16 + i * 8192, R, C); const int Rb = E.perm ? ((R & ~31) + perm32(R & 31)) : R;
        voffA[i] = (unsigned)(R * K + C) * 2u; voffB[i] = (unsigned)(Rb * K + C) * 2u; }
    const size_t kstep = (size_t)(BK * 2);
    const size_t hstep = (size_t)HALF * K * 2;
    const size_t tstep = 2 * hstep;
    const unsigned ldsw = (unsigned)wid * 1024u;
    const int aoff = lds_byte(wr * 64 + fr, fq * 8), boff = lds_byte(wc * 32 + fr, fq * 8);
#define PG8_SA(b, h) (((b) * 2 + (h)) * HTB)
#define PG8_SB(b, h) ((4 + (b) * 2 + (h)) * HTB)
#define PG8_STAGE(bufoff, gbase, voff) do { _Pragma("unroll") for (int _i = 0; _i < 2; ++_i) \
        __builtin_amdgcn_global_load_lds((const unsigned*)((const char*)(gbase) + (voff)[_i]), (PG8_LAS unsigned*)(lds + (bufoff) + ldsw + _i * 8192), 16, 0, 0); } while (0)
#define PG8_LDA(dst, b, h) do { _Pragma("unroll") for (int m = 0; m < 4; ++m) _Pragma("unroll") for (int k = 0; k < 2; ++k) dst[m][k] = *(const PG8_LAS bf16x8*)(lds + PG8_SA(b, h) + aoff + m * 2048 + k * 1024); } while (0)
#define PG8_LDB(dst, b, h) do { _Pragma("unroll") for (int n = 0; n < 2; ++n) _Pragma("unroll") for (int k = 0; k < 2; ++k) dst[n][k] = *(const PG8_LAS bf16x8*)(lds + PG8_SB(b, h) + boff + n * 2048 + k * 1024); } while (0)
#define PG8_MMA(ai, bj, At, Bt) do { __builtin_amdgcn_s_setprio(1); _Pragma("unroll") for (int m = 0; m < 4; ++m) _Pragma("unroll") for (int n = 0; n < 2; ++n) _Pragma("unroll") for (int k = 0; k < 2; ++k) \
        acc[ai][bj][m][n] = __builtin_amdgcn_mfma_f32_16x16x32_bf16(Bt[n][k], At[m][k], acc[ai][bj][m][n], 0, 0, 0); __builtin_amdgcn_s_setprio(0); } while (0)
#define PG8_WAIT_V(n) asm volatile("s_waitcnt vmcnt(" #n ")" ::: "memory")
#define PG8_WAIT_L(n) asm volatile("s_waitcnt lgkmcnt(" #n ")" ::: "memory")
#define PG8_BAR __builtin_amdgcn_s_barrier()
#define PG8_SCHED __builtin_amdgcn_sched_barrier(0)
    Unit cur, nxt; int ui = 0;
    if (!S.next(0, cur)) return;
    f32x4 acc[2][2][4][2];
#pragma unroll
    for (int a = 0; a < 2; ++a)
#pragma unroll
        for (int b = 0; b < 2; ++b)
#pragma unroll
            for (int m = 0; m < 4; ++m)
#pragma unroll
                for (int n = 0; n < 2; ++n) acc[a][b][m][n] = (f32x4){0.f, 0.f, 0.f, 0.f};
    bf16x8 At[4][2], B0[2][2], B1[2][2];
    const char* cA = (const char*)g.A + (size_t)cur.pm * tstep; const char* cB = (const char*)g.Bt + (size_t)cur.pn * tstep;
    S.a_ready(cur);
    if constexpr (SP2) {
        PG8_STAGE(PG8_SB(0, 0), cB, voffB); PG8_STAGE(PG8_SB(0, 1), cB + hstep, voffB); PG8_STAGE(PG8_SA(0, 0), cA, voffA); PG8_STAGE(PG8_SA(0, 1), cA + hstep, voffA);
        if (wr == 1) PG8_BAR;
        PG8_WAIT_V(2); PG8_BAR;
        PG8_STAGE(PG8_SB(1, 0), cB + kstep, voffB); PG8_STAGE(PG8_SA(1, 0), cA + kstep, voffA); PG8_STAGE(PG8_SB(1, 1), cB + hstep + kstep, voffB);
        PG8_WAIT_V(6); PG8_BAR;
    } else {
        PG8_STAGE(PG8_SB(0, 0), cB, voffB); PG8_STAGE(PG8_SA(0, 0), cA, voffA); PG8_STAGE(PG8_SB(0, 1), cB + hstep, voffB); PG8_STAGE(PG8_SA(0, 1), cA + hstep, voffA);
        if (wr == 1) PG8_BAR;
        PG8_WAIT_V(4); PG8_BAR;
        PG8_STAGE(PG8_SB(1, 0), cB + kstep, voffB); PG8_STAGE(PG8_SA(1, 0), cA + kstep, voffA); PG8_STAGE(PG8_SB(1, 1), cB + hstep + kstep, voffB);
        PG8_WAIT_V(6); PG8_BAR;
    }
    for (;;) {
        const bool has_next = S.next(ui + 1, nxt);
        const char* nA = has_next ? (const char*)g.A + (size_t)nxt.pm * tstep : cA; const char* nB = has_next ? (const char*)g.Bt + (size_t)nxt.pn * tstep : cB;
        for (int t = 0; t < nt; t += 2) {
            const bool last = (t == nt - 2);
            const char* a1 = cA + (size_t)(t + 1) * kstep;
            const char* a2 = last ? nA : cA + (size_t)(t + 2) * kstep; const char* b2 = last ? nB : cB + (size_t)(t + 2) * kstep;
            const char* a3 = a2 + kstep; const char* b3 = b2 + kstep;
            if (last && has_next) S.a_ready(nxt);
            if constexpr (SP2) {
            PG8_LDB(B0, 0, 0); PG8_LDB(B1, 0, 1); PG8_SCHED; PG8_LDA(At, 0, 0); PG8_STAGE(PG8_SA(1, 1), a1 + hstep, voffA);
            PG8_WAIT_V(8); PG8_WAIT_L(0); PG8_BAR; PG8_MMA(0, 0, At, B0); PG8_MMA(0, 1, At, B1); PG8_BAR; PG8_SCHED;
            PG8_LDA(At, 0, 1); PG8_STAGE(PG8_SB(0, 0), b2, voffB); PG8_STAGE(PG8_SB(0, 1), b2 + hstep, voffB); PG8_STAGE(PG8_SA(0, 0), a2, voffA);
            PG8_WAIT_V(8); PG8_WAIT_L(0); PG8_BAR; PG8_MMA(1, 0, At, B0); PG8_MMA(1, 1, At, B1); PG8_BAR; PG8_SCHED;
            PG8_LDB(B0, 1, 0); PG8_LDB(B1, 1, 1); PG8_SCHED; PG8_LDA(At, 1, 0); PG8_STAGE(PG8_SA(0, 1), a2 + hstep, voffA);
            PG8_WAIT_V(8); PG8_WAIT_L(0); PG8_BAR; PG8_MMA(0, 0, At, B0); PG8_MMA(0, 1, At, B1); PG8_BAR; PG8_SCHED;
            PG8_LDA(At, 1, 1); PG8_STAGE(PG8_SB(1, 0), b3, voffB); PG8_STAGE(PG8_SB(1, 1), b3 + hstep, voffB); PG8_STAGE(PG8_SA(1, 0), a3, voffA);
            PG8_WAIT_V(8); PG8_WAIT_L(0); PG8_BAR; PG8_MMA(1, 0, At, B0); PG8_MMA(1, 1, At, B1); PG8_BAR; PG8_SCHED;
            } else {
            PG8_LDB(B0, 0, 0); PG8_SCHED; PG8_LDA(At, 0, 0); PG8_STAGE(PG8_SA(1, 1), a1 + hstep, voffA);
            PG8_WAIT_L(8); PG8_BAR; PG8_WAIT_L(0); PG8_MMA(0, 0, At, B0); PG8_BAR; PG8_SCHED;
            PG8_LDB(B1, 0, 1); PG8_STAGE(PG8_SB(0, 0), b2, voffB);
            PG8_BAR; PG8_WAIT_L(0); PG8_MMA(0, 1, At, B1); PG8_BAR;
            PG8_LDA(At, 0, 1); PG8_STAGE(PG8_SA(0, 0), a2, voffA);
            PG8_BAR; PG8_WAIT_L(0); PG8_MMA(1, 0, At, B0); PG8_BAR; PG8_SCHED;
            PG8_STAGE(PG8_SB(0, 1), b2 + hstep, voffB);
            PG8_WAIT_V(6); PG8_BAR; PG8_MMA(1, 1, At, B1); PG8_BAR;
            PG8_LDB(B0, 1, 0); PG8_SCHED; PG8_LDA(At, 1, 0); PG8_STAGE(PG8_SA(0, 1), a2 + hstep, voffA);
            PG8_WAIT_L(8); PG8_BAR; PG8_WAIT_L(0); PG8_MMA(0, 0, At, B0); PG8_BAR; PG8_SCHED;
            PG8_LDB(B1, 1, 1); PG8_STAGE(PG8_SB(1, 0), b3, voffB);
            PG8_BAR; PG8_WAIT_L(0); PG8_MMA(0, 1, At, B1); PG8_BAR;
            PG8_LDA(At, 1, 1); PG8_STAGE(PG8_SA(1, 0), a3, voffA);
            PG8_BAR; PG8_WAIT_L(0); PG8_MMA(1, 0, At, B0); PG8_BAR; PG8_SCHED;
            PG8_STAGE(PG8_SB(1, 1), b3 + hstep, voffB);
            PG8_WAIT_V(6); PG8_BAR; PG8_MMA(1, 1, At, B1); PG8_BAR;
            }
        }
        if constexpr (ALIGN_EPI) { if (wr == 0) PG8_BAR; }
        if constexpr (!Epi::AFTER_DRAIN) { E(acc, cur, wr, wc, fr, fq); S.done(cur); }
        if (!has_next) break;
#pragma unroll
        for (int a = 0; a < 2; ++a)
#pragma unroll
            for (int b = 0; b < 2; ++b)
#pragma unroll
                for (int m = 0; m < 4; ++m)
#pragma unroll
                    for (int n = 0; n < 2; ++n) acc[a][b][m][n] = (f32x4){0.f, 0.f, 0.f, 0.f};
        cur = nxt; cA = nA; cB = nB; ++ui;
        if constexpr (ALIGN_EPI) { if (wr == 1) PG8_BAR; }
    }
    PG8_WAIT_V(0);
    if constexpr (!ALIGN_EPI) { if (wr == 0) PG8_BAR; }
    PG8_BAR;
    if constexpr (Epi::AFTER_DRAIN) { E.fused(acc, cur, wr, wc, fr, fq, lds, wid, lane); S.done(cur); }
#undef PG8_SA
#undef PG8_SB
#undef PG8_STAGE
#undef PG8_LDA
#undef PG8_LDB
#undef PG8_MMA
#undef PG8_WAIT_V
#undef PG8_WAIT_L
#undef PG8_BAR
#undef PG8_SCHED
}
}
#define GAS __attribute__((address_space(1)))
#define LAS __attribute__((address_space(3)))
typedef unsigned short bf16;
typedef unsigned v4u __attribute__((ext_vector_type(4)));
typedef float f32x4 __attribute__((ext_vector_type(4)));
typedef short bf16x8 __attribute__((ext_vector_type(8)));
typedef GAS unsigned gu32;
typedef GAS unsigned long long gu64;
#define RLX_AGENT __ATOMIC_RELAXED, __HIP_MEMORY_SCOPE_AGENT
#define LDS_WAIT() asm volatile("s_waitcnt lgkmcnt(0)" ::: "memory")
#define VM_WAIT() asm volatile("s_waitcnt vmcnt(0)" ::: "memory")
__device__ __forceinline__ unsigned long long rt() { return __builtin_amdgcn_s_memrealtime(); }
__device__ __forceinline__ unsigned f2bf(float f) { unsigned u = __builtin_bit_cast(unsigned, f); return (u + 0x7fffu + ((u >> 16) & 1u)) >> 16; }
__device__ __forceinline__ unsigned pk2(float lo, float hi) { return f2bf(lo) | (f2bf(hi) << 16); }
#define XB_TMO      128
#define XB_XCNT(j)  (256  + 64 * (j))
#define XB_XSUB(j)  (1280 + 64 * (j))
#define XB_XGEN(j)  (2304 + 64 * (j))
#define XB_TOP      3328
#define XB_TOPGEN   3392
#define XCD_BAR_WORDS 3456
#define XB_SPIN_CAP (1u << 18)

__device__ __forceinline__ unsigned xb_ld(unsigned* p)              { return __hip_atomic_load(p, __ATOMIC_RELAXED, __HIP_MEMORY_SCOPE_AGENT); }
__device__ __forceinline__ unsigned xb_add(unsigned* p, unsigned v) { return __hip_atomic_fetch_add(p, v, __ATOMIC_RELAXED, __HIP_MEMORY_SCOPE_AGENT); }
__device__ __forceinline__ unsigned xb_xcc_id() { return (unsigned)__builtin_amdgcn_s_getreg((3 << 11) | 20) & 0xFu; }
#define XB_SPIN(cond, bar) do { unsigned _sp = 0; while (cond) { __builtin_amdgcn_s_sleep(1); \
    if ((++_sp & 255u) == 0u) { if (xb_ld(&(bar)[XB_TMO])) break; if (_sp > XB_SPIN_CAP) { atomicAdd(&(bar)[XB_TMO], 1u); break; } } } } while (0)

struct XcdBarrier {
    unsigned* bar; unsigned x;
    volatile LAS unsigned* st;
    bool leader;
};

__device__ __forceinline__ XcdBarrier xcd_barrier_post(unsigned* bar, volatile LAS unsigned* st) {
    XcdBarrier b; b.bar = bar; b.x = xb_xcc_id(); b.st = st; b.leader = false;
    if (threadIdx.x == 0) (void)xb_add(&bar[XB_XCNT(b.x)], 1u);
    return b;
}
__device__ __forceinline__ void xcd_barrier_complete(unsigned* bar, unsigned x, unsigned& nloc, unsigned& nx) {
    const unsigned G = gridDim.x * gridDim.y * gridDim.z;
    unsigned sum, cnt, mine, sp = 0u;
    for (;;) {
        sum = 0u; cnt = 0u; mine = 0u;
#pragma unroll
        for (unsigned j = 0; j < 16; ++j) { const unsigned c = xb_ld(&bar[XB_XCNT(j)]); sum += c; cnt += (c > 0u) ? 1u : 0u; mine = (j == x) ? c : mine; }
        if (sum == G) break;
        __builtin_amdgcn_s_sleep(1);
        if ((++sp & 255u) == 0u) { if (xb_ld(&bar[XB_TMO])) break; if (sp > XB_SPIN_CAP) { atomicAdd(&bar[XB_TMO], 1u); break; } }
    }
    nloc = mine > 0u ? mine : 1u; nx = cnt > 0u ? cnt : 1u;
}

__device__ __forceinline__ void xcd_barrier(const XcdBarrier& b) {
    asm volatile("s_waitcnt vmcnt(0)" ::: "memory");
    __syncthreads();
    if (b.leader) {
        unsigned* bar = b.bar;
        __builtin_amdgcn_s_waitcnt(0);
        unsigned nloc = b.st[0], nx = b.st[1];
        if (nloc == 0u) { xcd_barrier_complete(bar, b.x, nloc, nx); b.st[0] = nloc; b.st[1] = nx; }
        const unsigned old = xb_add(&bar[XB_XSUB(b.x)], 1u);
        const unsigned gen = old / nloc;
        if (old + 1u == (gen + 1u) * nloc) {
            __builtin_amdgcn_fence(__ATOMIC_RELEASE, "agent");
            asm volatile("s_waitcnt vmcnt(0)" ::: "memory");
            const unsigned og = xb_add(&bar[XB_TOP], 1u);
            const unsigned tg = og / nx;
            if (og + 1u == (tg + 1u) * nx) xb_add(&bar[XB_TOPGEN], 1u);
            else XB_SPIN(xb_ld(&bar[XB_TOPGEN]) == tg, bar);
            __builtin_amdgcn_fence(__ATOMIC_ACQUIRE, "agent");
            xb_add(&bar[XB_XGEN(b.x)], 1u);
            asm volatile("s_waitcnt vmcnt(0)" ::: "memory");
        } else {
            XB_SPIN(xb_ld(&bar[XB_XGEN(b.x)]) == gen, bar);
            __builtin_amdgcn_fence(__ATOMIC_ACQUIRE, "agent");
            asm volatile("s_waitcnt vmcnt(0)" ::: "memory");
        }
    }
    __syncthreads();
}
__device__ __forceinline__ float wave_sum(float v) {
#pragma unroll
    for (int o = 1; o < 64; o <<= 1) v += __shfl_xor(v, o);
    return v;
}
__device__ __forceinline__ unsigned cvtpk_rne(float lo, float hi) { typedef float f2 __attribute__((ext_vector_type(2))); typedef __bf16 b2 __attribute__((ext_vector_type(2)));
    f2 v = {lo, hi}; b2 b = __builtin_convertvector(v, b2); return __builtin_bit_cast(unsigned, b); }
__device__ __forceinline__ void p0_transpose_item64(const float* W, int K, int N, bf16* WT, LAS unsigned* scr, int item, int lane) {
    const int nblk = N / 64, kb = item / nblk, nb = item % nblk, k0 = 64 * kb, n0 = 64 * nb;
    const int g = lane >> 4, q = lane & 15;
    const float* src = W + (size_t)(k0 + 2 * g) * N + n0 + 4 * q;
    f32x4 v[16];
#pragma unroll
    for (int i = 0; i < 16; ++i) v[i] = *(const GAS f32x4*)(src + (size_t)(8 * (i >> 1) + (i & 1)) * N);
#pragma unroll
    for (int j = 0; j < 8; ++j)
#pragma unroll
        for (int e = 0; e < 4; ++e) scr[(4 * q + e) * 33 + 4 * j + g] = cvtpk_rne(v[2 * j][e], v[2 * j + 1][e]);
    LDS_WAIT(); asm volatile("" ::: "memory");
    const int c = lane & 7, nr = lane >> 3;
#pragma unroll
    for (int jj = 0; jj < 8; ++jj) { const int n = nr + 8 * jj; const LAS unsigned* s = scr + n * 33 + 4 * c;
        v4u o; o.x = s[0]; o.y = s[1]; o.z = s[2]; o.w = s[3];
        *(GAS v4u*)(WT + (size_t)(n0 + n) * K + k0 + 8 * c) = o; }
    LDS_WAIT(); asm volatile("" ::: "memory");
}


constexpr int NWAVES = 8;
constexpr int BATCH = 4, SEQ = 2048, DM = 2048, TOK = BATCH * SEQ, PW = 6144, DFF = 8192, HD = 128, DEPTH = 2;
constexpr int NHA = 6, NHB = 4, NHC = 6;
constexpr int COL_QA = 0, COL_KA = 768, COL_VA = 1536, COL_QB = 2304, COL_KB = 2816, COL_VB = 3328, COL_QC = 3840, COL_KC = 4608, COL_VC = 5376;
constexpr int MIX_A = 0, MIX_B = 768, MIX_C = 1280;
constexpr float EPS = 1e-6f;

constexpr size_t MiB = 1u << 20;
constexpr size_t WS_CTL = 0, CTL_ZERO_BYTES = 1 * MiB;
constexpr size_t WS_LUT = 1 * MiB;
constexpr size_t WS_SS = 459 * MiB;
constexpr size_t WS_WIN = 2 * MiB, WS_WOUT = 50 * MiB, WS_W1 = 66 * MiB, WS_W2 = 130 * MiB;
constexpr size_t WS_XB = 194 * MiB;
constexpr size_t WS_QKV = 226 * MiB;
constexpr size_t WS_MIX = 322 * MiB;
constexpr size_t WS_H = 226 * MiB;
constexpr size_t WS_PA = 354 * MiB;
constexpr size_t WS_LSE = 426 * MiB;
constexpr size_t WS_PB = 427 * MiB;
constexpr size_t WS_END = 460 * MiB;
constexpr int CW_BAR = 4096;
constexpr int CW_QUEUE = 8192;

constexpr int RING_OFF = 0, RING_BYTES = 131072;
constexpr int LDSCTL_OFF = RING_BYTES, MISC_OFF = LDSCTL_OFF + 320;
constexpr int LDS_BYTES = 147456;

struct Frame {
    LAS unsigned char* lds;
    volatile LAS unsigned* MISC;
    gu32* ctl;
    int tid, lane, wave, vcu, G;
};

namespace att {
typedef short bf16x8 __attribute__((ext_vector_type(8)));
typedef short s16x4 __attribute__((ext_vector_type(4)));
typedef float f32x16 __attribute__((ext_vector_type(16)));
typedef unsigned u32x4 __attribute__((ext_vector_type(4)));
typedef short v4i16_t __attribute__((ext_vector_type(4)));
constexpr int QP = PW;
constexpr int VPB = 320;
constexpr int VBYTES = 32 * VPB;

__device__ __forceinline__ int crow(int r, int hi) { return (r & 3) + 8 * (r >> 2) + 4 * hi; }
__device__ __forceinline__ unsigned cvtpk(float lo, float hi) { typedef float f2 __attribute__((ext_vector_type(2))); typedef __bf16 b2 __attribute__((ext_vector_type(2)));
    f2 v = {lo, hi}; b2 b = __builtin_convertvector(v, b2); return __builtin_bit_cast(unsigned, b); }
__device__ __forceinline__ s16x4 vtr(LAS const unsigned char* p) { return __builtin_bit_cast(s16x4, __builtin_amdgcn_ds_read_tr16_b64_v4i16((LAS v4i16_t*)p)); }

template <int NKS> __device__ __forceinline__ f32x16 qk_tile(const bf16x8 (&qf)[NKS], const bf16* krow) {
    bf16x8 kf[NKS];
#pragma unroll
    for (int ks = 0; ks < NKS; ++ks) kf[ks] = *(const bf16x8*)(krow + 16 * ks);
    f32x16 st = {0.f, 0.f, 0.f, 0.f, 0.f, 0.f, 0.f, 0.f, 0.f, 0.f, 0.f, 0.f, 0.f, 0.f, 0.f, 0.f};
#pragma unroll
    for (int ks = 0; ks < NKS; ++ks) st = __builtin_amdgcn_mfma_f32_32x32x16_bf16(kf[ks], qf[ks], st, 0, 0, 0);
    return st;
}
constexpr int VBLK = 1088;
#ifndef NT_DIFF
#define NT_DIFF 1
#endif
#ifndef NT_DIL
#define NT_DIL 1
#endif
constexpr int NT_OFF = 8 * VBLK;
__device__ __forceinline__ void dma_v(LAS unsigned char* vl, const bf16* Vb, int tk0, int tks, int lane) {
    const bf16* p = Vb + (size_t)(tk0 + 8 * tks * (lane >> 4)) * QP + (lane & 15) * 8; const size_t step = (size_t)tks * QP;
#pragma unroll
    for (int i = 0; i < 8; ++i) { __builtin_amdgcn_global_load_lds((const unsigned*)p, (LAS unsigned*)(vl + i * VBLK), 16, 0, 0); p += step; }
}
#ifndef DMA_WAIT_EXTRA
#define DMA_WAIT_EXTRA ""
#endif
__device__ __forceinline__ void dma_wait() { asm volatile("s_waitcnt vmcnt(0)" DMA_WAIT_EXTRA ::: "memory"); }
__device__ __forceinline__ void mfma_acc(f32x16& acc, const bf16x8& a, const bf16x8& b) { asm volatile("s_nop 1\n\tv_mfma_f32_32x32x16_bf16 %0, %1, %2, %0" : "+v"(acc) : "v"(a), "v"(b)); }
#ifndef PV_ASM
#define PV_ASM 0
#endif
#if PV_ASM
#define PV_MFMA(acc, a, b) (mfma_acc(acc, a, b), acc)
#else
#define PV_MFMA(acc, a, b) __builtin_amdgcn_mfma_f32_32x32x16_bf16(a, b, acc, 0, 0, 0)
#endif
__device__ __forceinline__ void pv_settle(f32x16 (&o)[4]) { asm volatile("s_nop 15\n\ts_nop 7" : "+v"(o[0]), "+v"(o[1]), "+v"(o[2]), "+v"(o[3])); }
__device__ __forceinline__ void pv_tile(f32x16 (&o)[4], const bf16x8 (&pa)[2], LAS const unsigned char* vl, int lane) {
    const int hi = lane >> 5, g1 = (lane >> 4) & 1, i = lane & 15;
    LAS const unsigned char* base = vl + (4 * hi + (i >> 2)) * VBLK + (16 * g1 + 4 * (i & 3)) * 2;
    s16x4 lo[8], hh[8];
#pragma unroll
    for (int db = 0; db < 4; ++db)
#pragma unroll
        for (int s = 0; s < 2; ++s) { lo[2 * db + s] = vtr(base + s * 512 + db * 64); hh[2 * db + s] = vtr(base + s * 512 + 256 + db * 64); }
#pragma unroll
    for (int db = 0; db < 4; ++db)
#pragma unroll
        for (int s = 0; s < 2; ++s) { const s16x4 a = lo[2 * db + s], b = hh[2 * db + s];
            const bf16x8 vf = {a[0], a[1], a[2], a[3], b[0], b[1], b[2], b[3]};
            o[db] = PV_MFMA(o[db], pa[s], vf); }
}

constexpr float LOG2E = 1.4426950408889634f;
constexpr float THR2 = 6.0f;
__device__ __forceinline__ float ex2(float x) { return __builtin_amdgcn_exp2f(x); }
__device__ __forceinline__ float lg2(float x) { return __builtin_amdgcn_logf(x); }
__device__ __forceinline__ constexpr int ccol(int r) { return (r & 3) + 8 * (r >> 2); }

#ifndef LOADK_DRAIN
#define LOADK_DRAIN 0
#endif
__device__ __forceinline__ float xhalf(float v, int hi) { const auto rr = __builtin_amdgcn_permlane32_swap(__float_as_uint(v), __float_as_uint(v), false, false); return __uint_as_float(hi ? rr[0] : rr[1]); }
template <int NKS> __device__ __forceinline__ void load_k(bf16x8 (&kf)[NKS], const bf16* krow) {
#pragma unroll
    for (int ks = 0; ks < NKS; ++ks) kf[ks] = *(const bf16x8*)(krow + 16 * ks);
    if (LOADK_DRAIN) asm volatile("s_waitcnt vmcnt(0)" ::: "memory");
}
template <int NKS> __device__ __forceinline__ f32x16 qk_mma(const bf16x8 (&kf)[NKS], const bf16x8 (&qf)[NKS]) {
    f32x16 st = {0.f, 0.f, 0.f, 0.f, 0.f, 0.f, 0.f, 0.f, 0.f, 0.f, 0.f, 0.f, 0.f, 0.f, 0.f, 0.f};
#pragma unroll
    for (int ks = 0; ks < NKS; ++ks) st = __builtin_amdgcn_mfma_f32_32x32x16_bf16(kf[ks], qf[ks], st, 0, 0, 0);
    return st;
}
__device__ __forceinline__ void pack_p(bf16x8 (&pa)[2], const float (&t)[16]) {
    u32x4 w0 = {cvtpk(t[0], t[1]), cvtpk(t[2], t[3]), cvtpk(t[4], t[5]), cvtpk(t[6], t[7])}, w1 = {cvtpk(t[8], t[9]), cvtpk(t[10], t[11]), cvtpk(t[12], t[13]), cvtpk(t[14], t[15])};
    pa[0] = __builtin_bit_cast(bf16x8, w0); pa[1] = __builtin_bit_cast(bf16x8, w1);
}
constexpr float GROW_MAX = 64.0f;
template <bool SAFE> __device__ __forceinline__ bool sm_tile(float (&xm)[16], bool set_ref, float& m2, float& l, f32x16 (&o)[4], bf16x8 (&pa)[2], int hi) {
    float a = fmaxf(fmaxf(xm[0], xm[1]), fmaxf(xm[2], xm[3])), b = fmaxf(fmaxf(xm[4], xm[5]), fmaxf(xm[6], xm[7]));
    a = fmaxf(a, fmaxf(fmaxf(xm[8], xm[9]), fmaxf(xm[10], xm[11]))); b = fmaxf(b, fmaxf(fmaxf(xm[12], xm[13]), fmaxf(xm[14], xm[15])));
    float mt = fmaxf(a, b); mt = fmaxf(mt, xhalf(mt, hi));
    bool ovf = false;
    if (set_ref) {
        m2 += mt;
#pragma unroll
        for (int r = 0; r < 16; ++r) xm[r] -= mt;
    } else if (!SAFE) { ovf = __any(mt > GROW_MAX); }
    else if (__any(mt > 0.f)) {
        const float d = fmaxf(mt, 0.f), alpha = ex2(-d); m2 += d; l *= alpha;
#pragma unroll
        for (int r = 0; r < 16; ++r) xm[r] -= d;
        float f[16];
#pragma unroll
        for (int r = 0; r < 16; ++r) f[r] = __shfl(alpha, crow(r, hi));
        asm volatile("s_waitcnt lgkmcnt(0)" : "+v"(f[0]), "+v"(f[1]), "+v"(f[2]), "+v"(f[3]), "+v"(f[4]), "+v"(f[5]), "+v"(f[6]), "+v"(f[7]), "+v"(f[8]), "+v"(f[9]), "+v"(f[10]), "+v"(f[11]), "+v"(f[12]), "+v"(f[13]), "+v"(f[14]), "+v"(f[15]));
#pragma unroll
        for (int r = 0; r < 16; ++r)
#pragma unroll
            for (int db = 0; db < 4; ++db) o[db][r] *= f[r];
    }
    float ls = 0.f;
#pragma unroll
    for (int r = 0; r < 16; ++r) { xm[r] = ex2(xm[r]); ls += xm[r]; }
    l += ls;
    pack_p(pa, xm);
    return ovf;
}
__device__ __forceinline__ void store_o_bf16(const f32x16 (&o)[4], float fq  , bool use_f, bf16* Ob, int tok0, int tstride, int pitch, LAS unsigned char* vl, int lane) {
    const int qi = lane & 31, hi = lane >> 5;
#pragma unroll
    for (int r = 0; r < 16; ++r) { const int qq = crow(r, hi); const float f = use_f ? __shfl(fq, qq) : 1.0f;
#pragma unroll
        for (int db = 0; db < 4; ++db) *(LAS unsigned short*)(vl + qq * VPB + (32 * db + qi) * 2) = (unsigned short)(cvtpk(o[db][r] * f, 0.f) & 0xffffu); }
    asm volatile("s_waitcnt lgkmcnt(0)" ::: "memory");
#pragma unroll
    for (int i = 0; i < 8; ++i) { const int row = 4 * i + (lane >> 4); const u32x4 v = *(LAS const u32x4*)(vl + row * VPB + (lane & 15) * 16);
        *(u32x4*)(Ob + (size_t)(tok0 + tstride * row) * pitch + (lane & 15) * 8) = v; }
    asm volatile("s_waitcnt lgkmcnt(0)" ::: "memory");
}

template <bool SAFE> __device__ __forceinline__ bool diff_item(const bf16* Qb, const bf16* Kb, const bf16* Vb, int qt, const float* lut2, const int* thrtab, bf16* Ob, LAS unsigned char* vl, int lane_in) {
    int lane = lane_in; asm volatile("" : "+v"(lane));
    const int qi = lane & 31, hi = lane >> 5; const float c1 = 0.125f * LOG2E;
    bf16x8 qf[4]; load_k<4>(qf, Qb + (size_t)(32 * qt + qi) * QP + 8 * hi);
    f32x16 o[4];
#pragma unroll
    for (int db = 0; db < 4; ++db)
#pragma unroll
        for (int r = 0; r < 16; ++r) o[db][r] = 0.f;
    float m2 = 0.f, l = 0.f; bool ovf = false;
    bf16x8 kf[4];
    load_k<4>(kf, Kb + (size_t)qi * QP + 8 * hi);
    int thrL = thrtab[lane]; float b0L = lut2[32 * lane - 31 < 0 ? 0 : 32 * lane - 31], b1L = lut2[32 * lane + 31];
    LAS float* NT = (LAS float*)(vl + NT_OFF);
#pragma unroll
    for (int i = 0; i < 4; ++i) { const int idx = 64 * i + lane; NT[idx] = lut2[idx < 32 ? 0 : idx - 32]; }
    asm volatile("s_waitcnt vmcnt(0) lgkmcnt(0)" : "+v"(thrL), "+v"(b0L), "+v"(b1L) :: "memory");
#pragma nounroll
    for (int kt = 0; kt <= qt; ++kt) {
        const int D = qt - kt, ktn = kt < qt ? kt + 1 : qt;
        const int thr = __builtin_amdgcn_readlane(thrL, D);
        float xm[16]; bf16x8 pa[2];
        if (thr < 0) {
            const LAS float* nt = NT + (32 * D + qi - 4 * hi + 32 - 27);
            float bias[16];
#pragma unroll
            for (int r = 0; r < 16; ++r) bias[r] = nt[27 - ccol(r)];
            asm volatile("s_waitcnt lgkmcnt(0)" : "+v"(bias[0]), "+v"(bias[1]), "+v"(bias[2]), "+v"(bias[3]), "+v"(bias[4]), "+v"(bias[5]), "+v"(bias[6]), "+v"(bias[7]), "+v"(bias[8]), "+v"(bias[9]), "+v"(bias[10]), "+v"(bias[11]), "+v"(bias[12]), "+v"(bias[13]), "+v"(bias[14]), "+v"(bias[15]) :: "memory");
            const f32x16 st = qk_mma<4>(kf, qf);
            dma_v(vl, Vb, 32 * kt, 1, lane);
            load_k<4>(kf, Kb + (size_t)(32 * ktn + qi) * QP + 8 * hi);
#pragma unroll
            for (int r = 0; r < 16; ++r) xm[r] = st[r] * c1 + (bias[r] - m2);
            if (D == 0) {
#pragma unroll
                for (int r = 0; r < 16; ++r) xm[r] = (crow(r, hi) <= qi) ? xm[r] : -INFINITY;
            }
        } else {
            const float b0m = __builtin_bit_cast(float, __builtin_amdgcn_readlane(__builtin_bit_cast(int, b0L), D)) - m2, b1m = __builtin_bit_cast(float, __builtin_amdgcn_readlane(__builtin_bit_cast(int, b1L), D)) - m2; const int y2 = 32 * D + qi - thr - 4 * hi;
            const f32x16 st = qk_mma<4>(kf, qf);
            dma_v(vl, Vb, 32 * kt, 1, lane);
            load_k<4>(kf, Kb + (size_t)(32 * ktn + qi) * QP + 8 * hi);
#pragma unroll
            for (int r = 0; r < 16; ++r) xm[r] = st[r] * c1 + ((ccol(r) <= y2) ? b1m : b0m);
        }
        ovf |= sm_tile<SAFE>(xm, kt == 0, m2, l, o, pa, hi);
        dma_wait();
        pv_tile(o, pa, vl, lane);
    }
    pv_settle(o);
    const float lt = l + xhalf(l, hi);
    store_o_bf16(o, 1.0f / lt, true, Ob, 32 * qt, 1, 512, vl, lane);
    return ovf;
}

template <bool SAFE> __device__ __forceinline__ bool dil_item(const bf16* Qb, const bf16* Kb, const bf16* Vb, int dil, int rr, int n32, const float* lut2, bf16* Ob, float* lseb, LAS unsigned char* vl, int lane_in) {
    int lane = lane_in; asm volatile("" : "+v"(lane));
    const int qi = lane & 31, hi = lane >> 5; const float c1 = 0.08838834764831845f * LOG2E;
    const int tq0 = 32 * n32 * dil + rr;
    bf16x8 qf[8]; load_k<8>(qf, Qb + (size_t)(tq0 + qi * dil) * QP + 8 * hi);
    f32x16 o[4];
#pragma unroll
    for (int db = 0; db < 4; ++db)
#pragma unroll
        for (int r = 0; r < 16; ++r) o[db][r] = 0.f;
    float m2 = 0.f, l = 0.f; bool ovf = false;
    const int kt_lo = n32 >= 4 ? 0 : 4 - n32;
    LAS float* NT = (LAS float*)(vl + NT_OFF);
#pragma unroll
    for (int i = 0; i < 4; ++i) { const int idx = 64 * i + lane; int dl = (idx - 32) * dil; dl = dl < 0 ? 0 : (dl > 2047 ? 2047 : dl); NT[idx] = lut2[dl]; }
    asm volatile("s_waitcnt vmcnt(0) lgkmcnt(0)" ::: "memory");
#pragma nounroll
    for (int kt = kt_lo; kt <= 4; ++kt) {
        const int tkc = 32 * (n32 - 4 + kt) * dil + rr;
        const LAS float* nt = NT + (128 - 32 * kt + qi - 4 * hi + 32 - 27);
        float bias[16];
#pragma unroll
        for (int r = 0; r < 16; ++r) bias[r] = nt[27 - ccol(r)];
        asm volatile("s_waitcnt lgkmcnt(0)" : "+v"(bias[0]), "+v"(bias[1]), "+v"(bias[2]), "+v"(bias[3]), "+v"(bias[4]), "+v"(bias[5]), "+v"(bias[6]), "+v"(bias[7]), "+v"(bias[8]), "+v"(bias[9]), "+v"(bias[10]), "+v"(bias[11]), "+v"(bias[12]), "+v"(bias[13]), "+v"(bias[14]), "+v"(bias[15]) :: "memory");
        bf16x8 kf[8]; load_k<8>(kf, Kb + (size_t)(tkc + qi * dil) * QP + 8 * hi);
        dma_v(vl, Vb, tkc, dil, lane);
        const f32x16 st = qk_mma<8>(kf, qf);
        float xm[16]; bf16x8 pa[2];
#pragma unroll
        for (int r = 0; r < 16; ++r) xm[r] = st[r] * c1 + (bias[r] - m2);
        if (kt == 0) {
#pragma unroll
            for (int r = 0; r < 16; ++r) xm[r] = (crow(r, hi) >= qi) ? xm[r] : -INFINITY;
        }
        if (kt == 4) {
#pragma unroll
            for (int r = 0; r < 16; ++r) xm[r] = (crow(r, hi) <= qi) ? xm[r] : -INFINITY;
        }
        ovf |= sm_tile<SAFE>(xm, kt == kt_lo, m2, l, o, pa, hi);
        dma_wait();
        pv_tile(o, pa, vl, lane);
    }
    pv_settle(o);
    const float lt = l + xhalf(l, hi);
    if (lane < 32) lseb[(size_t)(tq0 + qi * dil) * 6] = m2 + lg2(lt);
    store_o_bf16(o, 1.0f / lt, true, Ob, tq0, dil, 768, vl, lane);
    return ovf;
}

__device__ __forceinline__ void stick_item(const bf16* Qb, const bf16* Kb, const bf16* Vb, int qt, bf16* Ob, LAS unsigned char* vl, int lane_in) {
    int lane = lane_in; asm volatile("" : "+v"(lane));
    const int qi = lane & 31, hi = lane >> 5; const float c1 = 0.08838834764831845f * LOG2E;
    bf16x8 qf[8]; load_k<8>(qf, Qb + (size_t)(32 * qt + qi) * QP + 8 * hi);
    f32x16 o[4];
#pragma unroll
    for (int db = 0; db < 4; ++db)
#pragma unroll
        for (int r = 0; r < 16; ++r) o[db][r] = 0.f;
    float R = 0.f;
    bf16x8 kf[8];
    load_k<8>(kf, Kb + (size_t)(32 * qt + qi) * QP + 8 * hi);
#pragma nounroll
    for (int kt = qt; kt >= 0; --kt) {
        const int ktn = kt > 0 ? kt - 1 : 0;
        const f32x16 st = qk_mma<8>(kf, qf);
        dma_v(vl, Vb, 32 * kt, 1, lane);
        load_k<8>(kf, Kb + (size_t)(32 * ktn + qi) * QP + 8 * hi);
        float u[16], zl[16];
#pragma unroll
        for (int r = 0; r < 16; ++r) { const float z = st[r] * c1; const float sp = fmaxf(z, 0.f) + lg2(1.0f + ex2(-fabsf(z)));
            u[r] = -sp; zl[r] = z - sp; }
        if (kt == qt) {
#pragma unroll
            for (int r = 0; r < 16; ++r) { const bool v = crow(r, hi) < qi; u[r] = v ? u[r] : 0.f; zl[r] = v ? zl[r] : -INFINITY; }
        }
        float gs[4], pg[4], tot[4], aft[4];
#pragma unroll
        for (int c = 0; c < 4; ++c) { gs[c] = (u[4 * c] + u[4 * c + 1]) + (u[4 * c + 2] + u[4 * c + 3]); pg[c] = xhalf(gs[c], hi); tot[c] = gs[c] + pg[c]; }
        aft[3] = (hi == 0) ? pg[3] : 0.f;
        aft[2] = tot[3] + ((hi == 0) ? pg[2] : 0.f);
        aft[1] = tot[3] + tot[2] + ((hi == 0) ? pg[1] : 0.f);
        aft[0] = tot[3] + tot[2] + tot[1] + ((hi == 0) ? pg[0] : 0.f);
        float a[16];
#pragma unroll
        for (int c = 0; c < 4; ++c) { const float b = R + aft[c];
            const float s2 = u[4 * c + 3], s1 = s2 + u[4 * c + 2], s0 = s1 + u[4 * c + 1];
            a[4 * c + 3] = ex2(zl[4 * c + 3] + b); a[4 * c + 2] = ex2(zl[4 * c + 2] + (b + s2));
            a[4 * c + 1] = ex2(zl[4 * c + 1] + (b + s1)); a[4 * c + 0] = ex2(zl[4 * c + 0] + (b + s0)); }
        R += (tot[0] + tot[1]) + (tot[2] + tot[3]);
        bf16x8 pa[2]; pack_p(pa, a);
        dma_wait();
        pv_tile(o, pa, vl, lane);
        if (__all(R < -150.0f)) break;
    }
    pv_settle(o);
    store_o_bf16(o, 1.0f, false, Ob, 32 * qt, 1, DM, vl, lane);
}
}

__device__ __forceinline__ void row_prep(const float* xrow, const float* g, bf16* orow, float* ss, int lane) {
    const GAS f32x4* xr = (const GAS f32x4*)xrow + lane; const GAS f32x4* gr = (const GAS f32x4*)g + lane;
    f32x4 v[8]; float s = 0.f;
#pragma unroll
    for (int j = 0; j < 8; ++j) { v[j] = xr[64 * j]; s += (v[j].x * v[j].x + v[j].y * v[j].y) + (v[j].z * v[j].z + v[j].w * v[j].w); }
    s = wave_sum(s);
    GAS unsigned long long* o8 = (GAS unsigned long long*)orow + lane;
#pragma unroll
    for (int j = 0; j < 8; ++j) { const f32x4 y = v[j] * gr[64 * j]; o8[64 * j] = (unsigned long long)cvtpk_rne(y.x, y.y) | ((unsigned long long)cvtpk_rne(y.z, y.w) << 32); }
    if (lane < 32) ss[lane] = lane == 0 ? s : 0.f;
}
__device__ __forceinline__ int t5_bucket(int n) {
    if (n < 16) return n;
    const int v = 16 + (int)(logf((float)n / 16.0f) / 4.852030263919617f * 16.0f);
    return v < 31 ? v : 31;
}

constexpr int I_IN = (DM / 64) * (PW / 64), I_OUT = (DM / 64) * (DM / 64), I_1 = (DM / 64) * (DFF / 64), I_2 = (DFF / 64) * (DM / 64);
struct Args { const float* in[14]; float* out; unsigned char* ws; int ph_lo, ph_hi, use_bar, pad; };
constexpr int PPL = 6;
constexpr int N_PHASES = 1 + PPL * DEPTH + 1;
#ifndef PROBE_MASK
#define PROBE_MASK 0
#endif
#ifndef PROBE_VAR
#define PROBE_VAR 0
#endif
#ifndef PROBE_DUP
#define PROBE_DUP -1
#endif
constexpr int N_STEPS = N_PHASES + (PROBE_DUP < 0 ? 0 : (PROBE_DUP == 100 ? 1 : 2));
__device__ __forceinline__ int step_phase(int i) {
    if (PROBE_DUP < 0) return i;
    if (PROBE_DUP == 100) return i == 0 ? 0 : i - 1;
    const int A = 1 + PROBE_DUP, B = 1 + PPL + PROBE_DUP;
    if (i <= A) return i; if (i == A + 1) return A; if (i <= B + 1) return i - 1; if (i == B + 2) return B; return i - 2;
}

__global__ void __launch_bounds__(NWAVES * 64, 2) fwd_kernel(Args args) {
    extern __shared__ __attribute__((aligned(16))) unsigned char lds_raw[];
    Frame F;
    F.lds = (LAS unsigned char*)lds_raw;
    F.MISC = (volatile LAS unsigned*)(F.lds + MISC_OFF);
    F.tid = threadIdx.x; F.lane = F.tid & 63; F.wave = __builtin_amdgcn_readfirstlane(F.tid >> 6);
    F.G = gridDim.x; { const int bx = blockIdx.x; F.vcu = (F.G % 8 == 0) ? (bx % 8) * (F.G / 8) + bx / 8 : bx; }
    F.ctl = (gu32*)(args.ws + WS_CTL);
    for (int u = F.tid; u < (LDS_BYTES - LDSCTL_OFF) / 4; u += NWAVES * 64) ((LAS unsigned*)(F.lds + LDSCTL_OFF))[u] = 0u;
    __syncthreads();
    XcdBarrier bar; bar.bar = (unsigned*)(F.ctl + CW_BAR); bar.x = 0; bar.st = nullptr; bar.leader = false;
    if (args.use_bar) bar = xcd_barrier_post((unsigned*)(F.ctl + CW_BAR), F.MISC + 8);

    const int NGW = F.G * NWAVES;

    for (int step = args.ph_lo; step < args.ph_hi; ++step) {
        const int ph = step_phase(step);
        typedef const __attribute__((address_space(4))) Args* KArgs; KArgs ap = (KArgs)__builtin_amdgcn_kernarg_segment_ptr(); asm volatile("" : "+s"(ap));
        unsigned char* ws = ap->ws;
        const float* x_in = ap->in[0]; const float* w_in = ap->in[1]; const float* w_out = ap->in[2]; const float* g_attn = ap->in[3]; const float* g_mlp = ap->in[4];
        const float* w1 = ap->in[5]; const float* w2 = ap->in[6]; const float* rel_tab = ap->in[7];
        const float* lq1 = ap->in[8]; const float* lk1 = ap->in[9]; const float* lq2 = ap->in[10]; const float* lk2 = ap->in[11]; const float* subln_g = ap->in[12]; const float* g_final = ap->in[13];
        float* out = ap->out;
        bf16* WIN_T = (bf16*)(ws + WS_WIN); bf16* WOUT_T = (bf16*)(ws + WS_WOUT); bf16* W1_T = (bf16*)(ws + WS_W1); bf16* W2_T = (bf16*)(ws + WS_W2);
        bf16* XB = (bf16*)(ws + WS_XB); bf16* QKV = (bf16*)(ws + WS_QKV); bf16* MIX = (bf16*)(ws + WS_MIX); bf16* HB = (bf16*)(ws + WS_H);
        float* SS = (float*)(ws + WS_SS); bf16* PAH = (bf16*)(ws + WS_PA); float* LSE = (float*)(ws + WS_LSE); bf16* PBH = (bf16*)(ws + WS_PB); float* LUT = (float*)(ws + WS_LUT);
        int lane = (int)__builtin_amdgcn_mbcnt_hi(~0u, __builtin_amdgcn_mbcnt_lo(~0u, 0u)); asm volatile("" : "+v"(lane));
        const int wave = F.wave, tid = wave * 64 + lane, gw = F.vcu * NWAVES + wave;
        const int l = ph > 0 ? (ph - 1) / PPL : 0, pt = (ph > 0 && ph <= PPL * DEPTH) ? (ph - 1) % PPL : (ph == 0 ? -1 : 100);
        if (pt == 0 || pt == 3 || pt == 4 || pt == 5) {
            pg8::Gemm g; pg8::EpiAny E; int N;
            E.O = nullptr; E.base = nullptr; E.out = nullptr; E.ss_in = SS; E.ss_out = SS; E.xb = nullptr; E.g = nullptr;
            if (pt == 0)      { g.A = XB;  g.Bt = WIN_T + (size_t)l * PW * DM;  N = PW;  g.K = DM;  E.mode = 0; E.O = QKV; E.ldc = PW; }
            else if (pt == 3) { g.A = MIX; g.Bt = WOUT_T + (size_t)l * DM * DM; N = DM;  g.K = DM;  E.mode = 2; E.base = (l == 0) ? x_in : (const float*)out; E.out = out; E.ldc = DM;
                                E.xb = XB; E.g = g_mlp + (size_t)l * DM; }
            else if (pt == 4) { g.A = XB;  g.Bt = W1_T + (size_t)l * DFF * DM;  N = DFF; g.K = DM;  E.mode = 1; E.O = HB; E.ldc = DFF; }
            else              { g.A = HB;  g.Bt = W2_T + (size_t)l * DM * DFF;  N = DM;  g.K = DFF; E.mode = 2; E.base = (const float*)out; E.out = out; E.ldc = DM;
                                if (l + 1 < DEPTH) { E.xb = XB; E.g = g_attn + (size_t)(l + 1) * DM; } }
            g.M = TOK; g.N = N; E.perm = (E.mode != 2);
            pg8::StaticOrder S; S.init(TOK, N, F.G, (int)blockIdx.x);
            pg8::gemm_phase<pg8::EpiAny, pg8::StaticOrder, true, true>(F.lds + RING_OFF, g, S, E, tid);
        } else if (ph == 0) {
            LAS unsigned* scr = (LAS unsigned*)(F.lds + RING_OFF + wave * 16384);
            for (int it = gw; it < I_IN; it += NGW) p0_transpose_item64(w_in, DM, PW, WIN_T, scr, it, lane);
            for (int i = blockIdx.x * (NWAVES * 64) + tid; i < 10 * 2048; i += F.G * NWAVES * 64) { const int h = i >> 11, d = i & 2047; LUT[i] = rel_tab[t5_bucket(d) * 10 + h] * att::LOG2E; }
            if (blockIdx.x == 0 && tid < 64) {
                const int D = tid, dlo = 32 * D - 31 < 0 ? 0 : 32 * D - 31, dhi = 32 * D + 31, bl = t5_bucket(dlo), bh = t5_bucket(dhi); int thr = -1;
                if (D > 0 && bl == bh) thr = 1 << 30;
                else if (D > 0 && bh == bl + 1) { thr = dhi; for (int d = dhi; d >= dlo; --d) if (t5_bucket(d) == bh) thr = d; }
                ((int*)(LUT + 10 * 2048))[D] = thr;
            }
            for (int m = gw; m < TOK; m += NGW) row_prep(x_in + (size_t)m * DM, g_attn, XB + (size_t)m * DM, SS + (size_t)m * 32, lane);
        } else if (pt == 1) {
            LAS unsigned char* vl = F.lds + RING_OFF + wave * att::VBYTES;
            const int* thrtab = (const int*)(LUT + 10 * 2048);
            const int skip = (PROBE_DUP == 1 && (step == 2 || step == 3 + PPL)) ? PROBE_MASK : 0;
            for (int s = gw; s < ((skip & 1) ? 0 : 2048); s += NGW) {
                const int combo = s >> 6, j = s & 63, x = 4 * (j >> 3) + (j & 3), qt = (j & 4) ? x : 63 - x, b = combo >> 3, vh = combo & 7, h = vh >> 1, p = vh & 1;
                const bf16* base = QKV + (size_t)b * SEQ * PW;
                const bf16 *qp = base + COL_QB + h * HD + p * 64, *kp = base + COL_KB + h * HD + p * 64, *vp = base + COL_VB + h * HD; bf16* op = PBH + ((size_t)p * TOK + (size_t)b * SEQ) * 512 + h * HD;
                if (att::diff_item<false>(qp, kp, vp, qt, LUT + (6 + h) * 2048, thrtab, op, vl, lane)) att::diff_item<true>(qp, kp, vp, qt, LUT + (6 + h) * 2048, thrtab, op, vl, lane);
            }
            const int nq = (F.G % 8 == 0) ? 8 : 1, xq = F.vcu / (F.G / nq);
            gu32* qctr = F.ctl + CW_QUEUE + 64 * (8 * step + xq);
            for (;;) {
                unsigned idx = 0; if (lane == 0) idx = __hip_atomic_fetch_add(qctr, 1u, __ATOMIC_RELAXED, __HIP_MEMORY_SCOPE_AGENT);
                idx = (unsigned)__builtin_amdgcn_readfirstlane((int)idx) * (unsigned)nq + (unsigned)xq;
                const unsigned ncv = (unsigned)((l == 0 ? I_OUT + I_1 + I_2 + I_IN : I_OUT + I_1 + I_2) / 2);
                if (idx >= 768u + 1152u + ncv) break;
                if (idx >= 768u + 1152u) {
                    LAS unsigned* scr = (LAS unsigned*)vl;
                    for (int rep = 0; rep < 2; ++rep) { int r = 2 * (int)(idx - 1920u) + rep; const float* W; bf16* WT; int K, N;
                        if (r < I_OUT) { W = w_out + (size_t)l * DM * DM; WT = WOUT_T + (size_t)l * DM * DM; K = DM; N = DM; }
                        else if ((r -= I_OUT) < I_1) { W = w1 + (size_t)l * DM * DFF; WT = W1_T + (size_t)l * DFF * DM; K = DM; N = DFF; }
                        else if ((r -= I_1) < I_2) { W = w2 + (size_t)l * DFF * DM; WT = W2_T + (size_t)l * DM * DFF; K = DFF; N = DM; }
                        else { r -= I_2; W = w_in + (size_t)(l + 1) * DM * PW; WT = WIN_T + (size_t)(l + 1) * PW * DM; K = DM; N = PW; }
                        p0_transpose_item64(W, K, N, WT, scr, r, lane); }
                    continue;
                }
                if (idx < 768u) { if (skip & 2) continue;
                    const int bh = (int)idx >> 5, jj = (int)idx & 31, b = bh / 6, h = bh % 6; const bf16* base = QKV + (size_t)b * SEQ * PW;
#pragma nounroll
                    for (int rep = 0; rep < 2; ++rep)
                        att::stick_item(base + COL_QC + h * HD, base + COL_KC + h * HD, base + COL_VC + h * HD, 63 - (2 * jj + rep), MIX + (size_t)b * SEQ * DM + MIX_C + h * HD, vl, lane);
                } else { if (skip & 4) continue;
                    const int i2 = (int)idx - 768, p = i2 / 384, rem = i2 % 384, bh = rem >> 4, j4 = rem & 15, b = bh / 6, h = bh % 6;
                    const int dil = p == 0 ? 1 : (p == 1 ? 4 : 16), tpr = 64 / dil;
                    const bf16* base = QKV + (size_t)b * SEQ * PW;
#pragma nounroll
                    for (int rep = 0; rep < 4; ++rep) { const int j = 4 * j4 + rep;
                        const bf16 *qp = base + COL_QA + h * HD, *kp = base + COL_KA + h * HD, *vp = base + COL_VA + h * HD; bf16* op = PAH + ((size_t)p * TOK + (size_t)b * SEQ) * 768 + h * HD;
                        float* lp = LSE + ((size_t)p * TOK + (size_t)b * SEQ) * 6 + h;
                        if (att::dil_item<false>(qp, kp, vp, dil, j / tpr, j % tpr, LUT + h * 2048, op, lp, vl, lane)) att::dil_item<true>(qp, kp, vp, dil, j / tpr, j % tpr, LUT + h * 2048, op, lp, vl, lane); }
                }
            }
        } else if (pt == 2) {
            const float lam_init = 0.8f - 0.6f * expf(-0.3f * (float)l);
            const float s1 = wave_sum(lq1[l * 64 + lane] * lk1[l * 64 + lane]), s2 = wave_sum(lq2[l * 64 + lane] * lk2[l * 64 + lane]);
            const float lam = expf(s1) - expf(s2) + lam_init;
            const float gx = subln_g[l * HD + 2 * lane] * (1.0f - lam_init), gy = subln_g[l * HD + 2 * lane + 1] * (1.0f - lam_init);
            typedef float f32x2 __attribute__((ext_vector_type(2)));
            for (int tok = gw; tok < TOK; tok += NGW) {
                GAS unsigned* mrow = (GAS unsigned*)(MIX + (size_t)tok * DM);
#pragma unroll
                for (int h = 0; h < NHA; ++h) {
                    const float l0 = LSE[((size_t)0 * TOK + tok) * 6 + h], l1 = LSE[((size_t)1 * TOK + tok) * 6 + h], l2 = LSE[((size_t)2 * TOK + tok) * 6 + h];
                    const float mx = fmaxf(l0, fmaxf(l1, l2)); float w0 = att::ex2(l0 - mx), w1_ = att::ex2(l1 - mx), w2_ = att::ex2(l2 - mx); const float inv = 1.0f / (w0 + w1_ + w2_);
                    w0 *= inv; w1_ *= inv; w2_ *= inv;
                    const unsigned a = *(const GAS unsigned*)(PAH + ((size_t)0 * TOK + tok) * 768 + h * HD + 2 * lane), b = *(const GAS unsigned*)(PAH + ((size_t)1 * TOK + tok) * 768 + h * HD + 2 * lane),
                                   c = *(const GAS unsigned*)(PAH + ((size_t)2 * TOK + tok) * 768 + h * HD + 2 * lane);
                    const float ax = __uint_as_float(a << 16), ay = __uint_as_float(a & 0xffff0000u), bx = __uint_as_float(b << 16), by = __uint_as_float(b & 0xffff0000u), cx = __uint_as_float(c << 16), cy = __uint_as_float(c & 0xffff0000u);
                    mrow[(MIX_A + h * HD) / 2 + lane] = cvtpk_rne(w0 * ax + w1_ * bx + w2_ * cx, w0 * ay + w1_ * by + w2_ * cy);
                }
#pragma unroll
                for (int h = 0; h < NHB; ++h) {
                    const unsigned a = *(const GAS unsigned*)(PBH + ((size_t)0 * TOK + tok) * 512 + h * HD + 2 * lane), b = *(const GAS unsigned*)(PBH + ((size_t)1 * TOK + tok) * 512 + h * HD + 2 * lane);
                    const float ox = __uint_as_float(a << 16) - lam * __uint_as_float(b << 16), oy = __uint_as_float(a & 0xffff0000u) - lam * __uint_as_float(b & 0xffff0000u);
                    const float rstd = 1.0f / sqrtf(wave_sum(ox * ox + oy * oy) * (1.0f / HD) + EPS);
                    mrow[(MIX_B + h * HD) / 2 + lane] = cvtpk_rne(ox * rstd * gx, oy * rstd * gy);
                }
            }
        } else {
            for (int m = gw; m < TOK; m += NGW) { const float s = wave_sum(lane < 32 ? SS[(size_t)m * 32 + lane] : 0.f); const float rstd = 1.0f / sqrtf(s * (1.0f / DM) + EPS);
                GAS f32x4* o4 = (GAS f32x4*)(out + (size_t)m * DM) + lane; const GAS f32x4* gr = (const GAS f32x4*)g_final + lane;
#pragma unroll
                for (int j = 0; j < 8; ++j) o4[64 * j] = o4[64 * j] * rstd * gr[64 * j]; }
        }
        if (step + 1 < args.ph_hi) { XcdBarrier b2 = bar; unsigned* bb = bar.bar; asm volatile("" : "+s"(bb)); b2.bar = bb; b2.leader = (wave == 0 && lane == 0); xcd_barrier(b2); }
    }
}

#ifndef MK_PER_PHASE
#define MK_PER_PHASE 0
#endif
extern "C" void kernel_launch(void* const* d_in, const int* in_sizes, int n_in, void* d_out, int out_size, void* d_ws, size_t ws_size, hipStream_t stream) {
    static int grid = 0;
    if (grid == 0) {
        if (n_in != 14 || out_size != TOK * DM || ws_size < WS_END) { fprintf(stderr, "kernel_launch: unexpected shapes (n_in %d out %d ws %zu)\n", n_in, out_size, ws_size); grid = -1; return; }
        int dev = 0, cus = 0, per_cu = 0;
        if (hipGetDevice(&dev) != hipSuccess || hipDeviceGetAttribute(&cus, hipDeviceAttributeMultiprocessorCount, dev) != hipSuccess) { grid = -1; return; }
        if (hipFuncSetAttribute((const void*)fwd_kernel, hipFuncAttributeMaxDynamicSharedMemorySize, LDS_BYTES) != hipSuccess) { fprintf(stderr, "kernel_launch: hipFuncSetAttribute failed\n"); grid = -1; return; }
        if (hipOccupancyMaxActiveBlocksPerMultiprocessor(&per_cu, (const void*)fwd_kernel, NWAVES * 64, LDS_BYTES) != hipSuccess || per_cu < 1) { fprintf(stderr, "kernel_launch: occupancy query says %d blocks per CU\n", per_cu); grid = -1; (void)hipGetLastError(); return; }
        (void)hipGetLastError();
        grid = cus;
    }
    if (grid < 0) return;
    if (hipMemsetAsync((char*)d_ws + WS_CTL, 0, CTL_ZERO_BYTES, stream) != hipSuccess) return;
    Args a{};
    for (int i = 0; i < 14; ++i) a.in[i] = (const float*)d_in[i];
    a.out = (float*)d_out; a.ws = (unsigned char*)d_ws;
#if MK_PER_PHASE
    for (int ph = 0; ph < N_STEPS; ++ph) { a.ph_lo = ph; a.ph_hi = ph + 1; a.use_bar = 0; hipLaunchKernelGGL(fwd_kernel, dim3(grid), dim3(NWAVES * 64), LDS_BYTES, stream, a); }
#else
    a.ph_lo = 0; a.ph_hi = N_STEPS; a.use_bar = 1;
    void* kargs[] = {(void*)&a};
    const hipError_t le = hipLaunchCooperativeKernel((const void*)fwd_kernel, dim3(grid), dim3(NWAVES * 64), kargs, (unsigned)LDS_BYTES, stream);
    if (le != hipSuccess) fprintf(stderr, "kernel_launch: cooperative launch failed: %s (grid %d x %d threads, %d B LDS)\n", hipGetErrorName(le), grid, NWAVES * 64, LDS_BYTES);
#endif
}
```

```cpp
#include <hip/hip_runtime.h>
#include <cstdio>
#include <cstdint>
#include <cmath>
namespace pg8 {
#define PG8_LAS __attribute__((address_space(3)))
typedef unsigned short bf16_t;
typedef short bf16x8 __attribute__((ext_vector_type(8)));
typedef float f32x4 __attribute__((ext_vector_type(4)));
typedef unsigned u32x4 __attribute__((ext_vector_type(4)));
constexpr int BM = 256, BK = 64, HALF = 128, HTB = HALF * BK * 2  , STAGE_BYTES = 8 * HTB, NXCD = 8, WGM = 8;

__host__ __device__ __forceinline__ int lds_byte(int r, int c) { const int st = (r >> 4) * 2 + (c >> 5), rr = r & 15, cc = c & 31, ob = rr * 64 + cc * 2; return st * 1024 + (ob ^ (((ob >> 9) & 1) << 5)); }
__host__ __device__ __forceinline__ void stage_rc(int b, int& R, int& C) { const int st = b / 1024, sb = b % 1024, swz = sb ^ (((sb >> 9) & 1) << 5); R = (st >> 1) * 16 + swz / 64; C = (st & 1) * 32 + (swz % 64) / 2; }
__host__ __device__ __forceinline__ int perm32(int rho) { const int n = rho >> 4, i = rho & 15; return 8 * (i >> 2) + 4 * n + (i & 3); }

struct Unit { int pm, pn; };
struct Gemm { const bf16_t* A; const bf16_t* Bt; int M, N, K; };

struct StaticOrder {
    int nM, nN, nwg, G, c;
    __host__ __device__ void init(int M, int N, int G_, int c_) { nM = M / BM; nN = N / BM; nwg = nM * nN; G = G_; c = c_; }
    __host__ __device__ bool next(int i, Unit& u) const {
        const long L = (long)i * G + c; if (L >= nwg) return false;
        int wgid = (int)L; { const int q = nwg / NXCD, r = nwg % NXCD, xcd = wgid % NXCD, off = wgid / NXCD; wgid = (xcd < r ? xcd * (q + 1) : r * (q + 1) + (xcd - r) * q) + off; }
        const int nig = WGM * nN, gid = wgid / nig, fm = gid * WGM, gsz = (nM - fm) < WGM ? (nM - fm) : WGM;
        u.pm = fm + ((wgid % nig) % gsz); u.pn = (wgid % nig) / gsz; return true;
    }
    __device__ __forceinline__ void a_ready(const Unit&) const {}
    __device__ __forceinline__ void done(const Unit&) const {}
};

__device__ __forceinline__ unsigned cvt_pk_bf16(float lo, float hi) { unsigned r; asm volatile("v_cvt_pk_bf16_f32 %0, %1, %2" : "=v"(r) : "v"(lo), "v"(hi)); return r; }
typedef float f32x2 __attribute__((ext_vector_type(2)));


__device__ __forceinline__ float sum_fq(float s) {
    { float t = __shfl_xor(s, 16); asm volatile("s_waitcnt lgkmcnt(0)" : "+v"(t)); s += t; }
    { float t = __shfl_xor(s, 32); asm volatile("s_waitcnt lgkmcnt(0)" : "+v"(t)); s += t; }
    return s;
}
struct EpiAny {
    static constexpr bool AFTER_DRAIN = false;
    int mode; bool perm; bf16_t* O; const float* base; float* out; int ldc;
    const float* ss_in; float* ss_out; bf16_t* xb; const float* g;
    const bf16_t* baseb; const float* gprev;
    __device__ __forceinline__ void operator()(const f32x4 (&acc)[2][2][4][2], const Unit& u, int wr, int wc, int fr, int fq) const {
        if (mode != 2) {
            const int row0 = u.pm * BM + wr * 64 + fr; const int col0 = u.pn * BM + wc * 32 + 8 * fq;
#pragma unroll
            for (int ai = 0; ai < 2; ++ai)
#pragma unroll
                for (int m = 0; m < 4; ++m) { const int row = row0 + ai * HALF + m * 16;
                    const f32x4 s0 = *(const f32x4*)(ss_in + (size_t)row * 32 + 8 * fq), s1 = *(const f32x4*)(ss_in + (size_t)row * 32 + 8 * fq + 4);
                    float ss = ((s0[0] + s0[1]) + (s0[2] + s0[3])) + ((s1[0] + s1[1]) + (s1[2] + s1[3]));
                    ss = sum_fq(ss);
                    const float rstd = 1.0f / sqrtf(ss * (1.0f / 2048.0f) + 1e-6f);
                    bf16_t* rowp = O + (size_t)row * ldc + col0;
#pragma unroll
                    for (int bj = 0; bj < 2; ++bj) { f32x4 v0 = acc[ai][bj][m][0] * rstd, v1 = acc[ai][bj][m][1] * rstd;
                        if (mode == 1) {
#pragma unroll
                            for (int e = 0; e < 4; ++e) { const float a = v0[e] > 0.f ? v0[e] : 0.f, b = v1[e] > 0.f ? v1[e] : 0.f; v0[e] = a * a; v1[e] = b * b; } }
                        u32x4 w; w.x = cvt_pk_bf16(v0[0], v0[1]); w.y = cvt_pk_bf16(v0[2], v0[3]); w.z = cvt_pk_bf16(v1[0], v1[1]); w.w = cvt_pk_bf16(v1[2], v1[3]);
                        *(u32x4*)(rowp + bj * HALF) = w; } }
        } else {
            typedef unsigned u32x2 __attribute__((ext_vector_type(2)));
            const int col0 = u.pn * BM + wc * 32 + 4 * fq;
            f32x4 gv[2][2], rg[2][2];
#pragma unroll
            for (int bj = 0; bj < 2; ++bj)
#pragma unroll
                for (int n = 0; n < 2; ++n) { gv[bj][n] = xb ? *(const f32x4*)(g + col0 + bj * HALF + n * 16) : (f32x4){0.f, 0.f, 0.f, 0.f};
                    if (baseb) { const f32x4 gp = *(const f32x4*)(gprev + col0 + bj * HALF + n * 16); rg[bj][n] = (f32x4){1.0f / gp[0], 1.0f / gp[1], 1.0f / gp[2], 1.0f / gp[3]}; } else rg[bj][n] = (f32x4){0.f, 0.f, 0.f, 0.f}; }
#pragma unroll
            for (int ai = 0; ai < 2; ++ai)
#pragma unroll
                for (int m = 0; m < 4; ++m) { const int row = u.pm * BM + ai * HALF + wr * 64 + m * 16 + fr; const size_t off = (size_t)row * ldc + col0;
                    f32x4 bs[2][2];
                    if (baseb) {
                        u32x2 bw[2][2];
#pragma unroll
                        for (int bj = 0; bj < 2; ++bj)
#pragma unroll
                            for (int n = 0; n < 2; ++n) bw[bj][n] = *(const u32x2*)(baseb + off + bj * HALF + n * 16);
#pragma unroll
                        for (int bj = 0; bj < 2; ++bj)
#pragma unroll
                            for (int n = 0; n < 2; ++n) bs[bj][n] = (f32x4){__builtin_bit_cast(float, bw[bj][n].x << 16), __builtin_bit_cast(float, bw[bj][n].x & 0xffff0000u), __builtin_bit_cast(float, bw[bj][n].y << 16), __builtin_bit_cast(float, bw[bj][n].y & 0xffff0000u)} * rg[bj][n];
                    } else {
#pragma unroll
                        for (int bj = 0; bj < 2; ++bj)
#pragma unroll
                            for (int n = 0; n < 2; ++n) bs[bj][n] = *(const f32x4*)(base + off + bj * HALF + n * 16);
                    }
                    float ss = 0.f;
#pragma unroll
                    for (int bj = 0; bj < 2; ++bj)
#pragma unroll
                        for (int n = 0; n < 2; ++n) { const f32x4 v = bs[bj][n] + acc[ai][bj][m][n]; if (out) *(f32x4*)(out + off + bj * HALF + n * 16) = v;
                            ss += (v[0] * v[0] + v[1] * v[1]) + (v[2] * v[2] + v[3] * v[3]);
                            if (xb) { const f32x4 y = v * gv[bj][n]; u32x2 w; w.x = cvt_pk_bf16(y[0], y[1]); w.y = cvt_pk_bf16(y[2], y[3]); *(u32x2*)(xb + off + bj * HALF + n * 16) = w; } }
                    ss = sum_fq(ss);
                    if (fq == 0) ss_out[(size_t)row * 32 + 4 * u.pn + wc] = ss;
                    asm volatile("" ::: "memory"); }
        }
    }
};

template <class Epi, class Sched, bool ALIGN_EPI = false, bool SP2 = false>
__device__ __forceinline__ void gemm_phase(PG8_LAS unsigned char* lds, const Gemm g, const Sched& S, const Epi& E, int tid_in) {
    int tid = tid_in; asm volatile("" : "+v"(tid));
    const int wid = __builtin_amdgcn_readfirstlane(tid >> 6), lane = tid & 63, wr = wid >> 2, wc = wid & 3, fr = lane & 15, fq = lane >> 4;
    const int K = g.K, nt = K / BK;
    unsigned voffA[2], voffB[2];
#pragma unroll
    for (int i = 0; i < 2; ++i) { int R, C; stage_rc(tid * 16 + i * 8192, R, C); const int Rb = E.perm ? ((R & ~31) + perm32(R & 31)) : R;
        voffA[i] = (unsigned)(R * K + C) * 2u; voffB[i] = (unsigned)(Rb * K + C) * 2u; }
    const size_t kstep = (size_t)(BK * 2);
    const size_t hstep = (size_t)HALF * K * 2;
    const size_t tstep = 2 * hstep;
    const unsigned ldsw = (unsigned)wid * 1024u;
    const int aoff = lds_byte(wr * 64 + fr, fq * 8), boff = lds_byte(wc * 32 + fr, fq * 8);
#define PG8_SA(b, h) (((b) * 2 + (h)) * HTB)
#define PG8_SB(b, h) ((4 + (b) * 2 + (h)) * HTB)
#define PG8_STAGE(bufoff, gbase, voff) do { _Pragma("unroll") for (int _i = 0; _i < 2; ++_i) \
        __builtin_amdgcn_global_load_lds((const unsigned*)((const char*)(gbase) + (voff)[_i]), (PG8_LAS unsigned*)(lds + (bufoff) + ldsw + _i * 8192), 16, 0, 0); } while (0)
#define PG8_LDA(dst, b, h) do { _Pragma("unroll") for (int m = 0; m < 4; ++m) _Pragma("unroll") for (int k = 0; k < 2; ++k) dst[m][k] = *(const PG8_LAS bf16x8*)(lds + PG8_SA(b, h) + aoff + m * 2048 + k * 1024); } while (0)
#define PG8_LDB(dst, b, h) do { _Pragma("unroll") for (int n = 0; n < 2; ++n) _Pragma("unroll") for (int k = 0; k < 2; ++k) dst[n][k] = *(const PG8_LAS bf16x8*)(lds + PG8_SB(b, h) + boff + n * 2048 + k * 1024); } while (0)
#define PG8_MMA(ai, bj, At, Bt) do { __builtin_amdgcn_s_setprio(1); _Pragma("unroll") for (int m = 0; m < 4; ++m) _Pragma("unroll") for (int n = 0; n < 2; ++n) _Pragma("unroll") for (int k = 0; k < 2; ++k) \
        acc[ai][bj][m][n] = __builtin_amdgcn_mfma_f32_16x16x32_bf16(Bt[n][k], At[m][k], acc[ai][bj][m][n], 0, 0, 0); __builtin_amdgcn_s_setprio(0); } while (0)
#define PG8_WAIT_V(n) asm volatile("s_waitcnt vmcnt(" #n ")" ::: "memory")
#define PG8_WAIT_L(n) asm volatile("s_waitcnt lgkmcnt(" #n ")" ::: "memory")
#define PG8_BAR __builtin_amdgcn_s_barrier()
#define PG8_SCHED __builtin_amdgcn_sched_barrier(0)
    Unit cur, nxt; int ui = 0;
    if (!S.next(0, cur)) return;
    f32x4 acc[2][2][4][2];
#pragma unroll
    for (int a = 0; a < 2; ++a)
#pragma unroll
        for (int b = 0; b < 2; ++b)
#pragma unroll
            for (int m = 0; m < 4; ++m)
#pragma unroll
                for (int n = 0; n < 2; ++n) acc[a][b][m][n] = (f32x4){0.f, 0.f, 0.f, 0.f};
    bf16x8 At[4][2], B0[2][2], B1[2][2];
    const char* cA = (const char*)g.A + (size_t)cur.pm * tstep; const char* cB = (const char*)g.Bt + (size_t)cur.pn * tstep;
    S.a_ready(cur);
    if constexpr (SP2) {
        PG8_STAGE(PG8_SB(0, 0), cB, voffB); PG8_STAGE(PG8_SB(0, 1), cB + hstep, voffB); PG8_STAGE(PG8_SA(0, 0), cA, voffA); PG8_STAGE(PG8_SA(0, 1), cA + hstep, voffA);
        if (wr == 1) PG8_BAR;
        PG8_WAIT_V(2); PG8_BAR;
        PG8_STAGE(PG8_SB(1, 0), cB + kstep, voffB); PG8_STAGE(PG8_SA(1, 0), cA + kstep, voffA); PG8_STAGE(PG8_SB(1, 1), cB + hstep + kstep, voffB);
        PG8_WAIT_V(6); PG8_BAR;
    } else {
        PG8_STAGE(PG8_SB(0, 0), cB, voffB); PG8_STAGE(PG8_SA(0, 0), cA, voffA); PG8_STAGE(PG8_SB(0, 1), cB + hstep, voffB); PG8_STAGE(PG8_SA(0, 1), cA + hstep, voffA);
        if (wr == 1) PG8_BAR;
        PG8_WAIT_V(4); PG8_BAR;
        PG8_STAGE(PG8_SB(1, 0), cB + kstep, voffB); PG8_STAGE(PG8_SA(1, 0), cA + kstep, voffA); PG8_STAGE(PG8_SB(1, 1), cB + hstep + kstep, voffB);
        PG8_WAIT_V(6); PG8_BAR;
    }
    for (;;) {
        const bool has_next = S.next(ui + 1, nxt);
        const char* nA = has_next ? (const char*)g.A + (size_t)nxt.pm * tstep : cA; const char* nB = has_next ? (const char*)g.Bt + (size_t)nxt.pn * tstep : cB;
        for (int t = 0; t < nt; t += 2) {
            const bool last = (t == nt - 2);
            const char* a1 = cA + (size_t)(t + 1) * kstep;
            const char* a2 = last ? nA : cA + (size_t)(t + 2) * kstep; const char* b2 = last ? nB : cB + (size_t)(t + 2) * kstep;
            const char* a3 = a2 + kstep; const char* b3 = b2 + kstep;
            if (last && has_next) S.a_ready(nxt);
            if constexpr (SP2) {
            PG8_LDB(B0, 0, 0); PG8_LDB(B1, 0, 1); PG8_SCHED; PG8_LDA(At, 0, 0); PG8_STAGE(PG8_SA(1, 1), a1 + hstep, voffA);
            PG8_WAIT_V(8); PG8_WAIT_L(0); PG8_BAR; PG8_MMA(0, 0, At, B0); PG8_MMA(0, 1, At, B1); PG8_BAR; PG8_SCHED;
            PG8_LDA(At, 0, 1); PG8_STAGE(PG8_SB(0, 0), b2, voffB); PG8_STAGE(PG8_SB(0, 1), b2 + hstep, voffB); PG8_STAGE(PG8_SA(0, 0), a2, voffA);
            PG8_WAIT_V(8); PG8_WAIT_L(0); PG8_BAR; PG8_MMA(1, 0, At, B0); PG8_MMA(1, 1, At, B1); PG8_BAR; PG8_SCHED;
            PG8_LDB(B0, 1, 0); PG8_LDB(B1, 1, 1); PG8_SCHED; PG8_LDA(At, 1, 0); PG8_STAGE(PG8_SA(0, 1), a2 + hstep, voffA);
            PG8_WAIT_V(8); PG8_WAIT_L(0); PG8_BAR; PG8_MMA(0, 0, At, B0); PG8_MMA(0, 1, At, B1); PG8_BAR; PG8_SCHED;
            PG8_LDA(At, 1, 1); PG8_STAGE(PG8_SB(1, 0), b3, voffB); PG8_STAGE(PG8_SB(1, 1), b3 + hstep, voffB); PG8_STAGE(PG8_SA(1, 0), a3, voffA);
            PG8_WAIT_V(8); PG8_WAIT_L(0); PG8_BAR; PG8_MMA(1, 0, At, B0); PG8_MMA(1, 1, At, B1); PG8_BAR; PG8_SCHED;
            } else {
            PG8_LDB(B0, 0, 0); PG8_SCHED; PG8_LDA(At, 0, 0); PG8_STAGE(PG8_SA(1, 1), a1 + hstep, voffA);
            PG8_WAIT_L(8); PG8_BAR; PG8_WAIT_L(0); PG8_MMA(0, 0, At, B0); PG8_BAR; PG8_SCHED;
            PG8_LDB(B1, 0, 1); PG8_STAGE(PG8_SB(0, 0), b2, voffB);
            PG8_BAR; PG8_WAIT_L(0); PG8_MMA(0, 1, At, B1); PG8_BAR;
            PG8_LDA(At, 0, 1); PG8_STAGE(PG8_SA(0, 0), a2, voffA);
            PG8_BAR; PG8_WAIT_L(0); PG8_MMA(1, 0, At, B0); PG8_BAR; PG8_SCHED;
            PG8_STAGE(PG8_SB(0, 1), b2 + hstep, voffB);
            PG8_WAIT_V(6); PG8_BAR; PG8_MMA(1, 1, At, B1); PG8_BAR;
            PG8_LDB(B0, 1, 0); PG8_SCHED; PG8_LDA(At, 1, 0); PG8_STAGE(PG8_SA(0, 1), a2 + hstep, voffA);
            PG8_WAIT_L(8); PG8_BAR; PG8_WAIT_L(0); PG8_MMA(0, 0, At, B0); PG8_BAR; PG8_SCHED;
            PG8_LDB(B1, 1, 1); PG8_STAGE(PG8_SB(1, 0), b3, voffB);
            PG8_BAR; PG8_WAIT_L(0); PG8_MMA(0, 1, At, B1); PG8_BAR;
            PG8_LDA(At, 1, 1); PG8_STAGE(PG8_SA(1, 0), a3, voffA);
            PG8_BAR; PG8_WAIT_L(0); PG8_MMA(1, 0, At, B0); PG8_BAR; PG8_SCHED;
            PG8_STAGE(PG8_SB(1, 1), b3 + hstep, voffB);
            PG8_WAIT_V(6); PG8_BAR; PG8_MMA(1, 1, At, B1); PG8_BAR;
            }
        }
        if constexpr (ALIGN_EPI) { if (wr == 0) PG8_BAR; }
        if constexpr (!Epi::AFTER_DRAIN) { E(acc, cur, wr, wc, fr, fq); S.done(cur); }
        if (!has_next) break;
#pragma unroll
        for (int a = 0; a < 2; ++a)
#pragma unroll
            for (int b = 0; b < 2; ++b)
#pragma unroll
                for (int m = 0; m < 4; ++m)
#pragma unroll
                    for (int n = 0; n < 2; ++n) acc[a][b][m][n] = (f32x4){0.f, 0.f, 0.f, 0.f};
        cur = nxt; cA = nA; cB = nB; ++ui;
        if constexpr (ALIGN_EPI) { if (wr == 1) PG8_BAR; }
    }
    PG8_WAIT_V(0);
    if constexpr (!ALIGN_EPI) { if (wr == 0) PG8_BAR; }
    PG8_BAR;
    if constexpr (Epi::AFTER_DRAIN) { E.fused(acc, cur, wr, wc, fr, fq, lds, wid, lane); S.done(cur); }
#undef PG8_SA
#undef PG8_SB
#undef PG8_STAGE
#undef PG8_LDA
#undef PG8_LDB
#undef PG8_MMA
#undef PG8_WAIT_V
#undef PG8_WAIT_L
#undef PG8_BAR
#undef PG8_SCHED
}
}
#define GAS __attribute__((address_space(1)))
#define LAS __attribute__((address_space(3)))
typedef unsigned short bf16;
typedef unsigned v4u __attribute__((ext_vector_type(4)));
typedef float f32x4 __attribute__((ext_vector_type(4)));
typedef short bf16x8 __attribute__((ext_vector_type(8)));
typedef GAS unsigned gu32;
typedef GAS unsigned long long gu64;
#define RLX_AGENT __ATOMIC_RELAXED, __HIP_MEMORY_SCOPE_AGENT
#define LDS_WAIT() asm volatile("s_waitcnt lgkmcnt(0)" ::: "memory")
#define VM_WAIT() asm volatile("s_waitcnt vmcnt(0)" ::: "memory")
__device__ __forceinline__ unsigned long long rt() { return __builtin_amdgcn_s_memrealtime(); }
__device__ __forceinline__ unsigned f2bf(float f) { unsigned u = __builtin_bit_cast(unsigned, f); return (u + 0x7fffu + ((u >> 16) & 1u)) >> 16; }
__device__ __forceinline__ unsigned pk2(float lo, float hi) { return f2bf(lo) | (f2bf(hi) << 16); }
#define XB_TMO      128
#define XB_XCNT(j)  (256  + 64 * (j))
#define XB_XSUB(j)  (1280 + 64 * (j))
#define XB_XGEN(j)  (2304 + 64 * (j))
#define XB_TOP      3328
#define XB_TOPGEN   3392
#define XCD_BAR_WORDS 3456
#define XB_SPIN_CAP (1u << 18)

__device__ __forceinline__ unsigned xb_ld(unsigned* p)              { return __hip_atomic_load(p, __ATOMIC_RELAXED, __HIP_MEMORY_SCOPE_AGENT); }
__device__ __forceinline__ unsigned xb_add(unsigned* p, unsigned v) { return __hip_atomic_fetch_add(p, v, __ATOMIC_RELAXED, __HIP_MEMORY_SCOPE_AGENT); }
__device__ __forceinline__ unsigned xb_xcc_id() { return (unsigned)__builtin_amdgcn_s_getreg((3 << 11) | 20) & 0xFu; }
#define XB_SPIN(cond, bar) do { unsigned _sp = 0; while (cond) { __builtin_amdgcn_s_sleep(1); \
    if ((++_sp & 255u) == 0u) { if (xb_ld(&(bar)[XB_TMO])) break; if (_sp > XB_SPIN_CAP) { atomicAdd(&(bar)[XB_TMO], 1u); break; } } } } while (0)

struct XcdBarrier {
    unsigned* bar; unsigned x;
    volatile LAS unsigned* st;
    bool leader;
};

__device__ __forceinline__ XcdBarrier xcd_barrier_post(unsigned* bar, volatile LAS unsigned* st) {
    XcdBarrier b; b.bar = bar; b.x = xb_xcc_id(); b.st = st; b.leader = false;
    if (threadIdx.x == 0) (void)xb_add(&bar[XB_XCNT(b.x)], 1u);
    return b;
}
__device__ __forceinline__ void xcd_barrier_complete(unsigned* bar, unsigned x, unsigned& nloc, unsigned& nx) {
    const unsigned G = gridDim.x * gridDim.y * gridDim.z;
    unsigned sum, cnt, mine, sp = 0u;
    for (;;) {
        sum = 0u; cnt = 0u; mine = 0u;
#pragma unroll
        for (unsigned j = 0; j < 16; ++j) { const unsigned c = xb_ld(&bar[XB_XCNT(j)]); sum += c; cnt += (c > 0u) ? 1u : 0u; mine = (j == x) ? c : mine; }
        if (sum == G) break;
        __builtin_amdgcn_s_sleep(1);
        if ((++sp & 255u) == 0u) { if (xb_ld(&bar[XB_TMO])) break; if (sp > XB_SPIN_CAP) { atomicAdd(&bar[XB_TMO], 1u); break; } }
    }
    nloc = mine > 0u ? mine : 1u; nx = cnt > 0u ? cnt : 1u;
}

__device__ __forceinline__ void xcd_barrier(const XcdBarrier& b) {
    asm volatile("s_waitcnt vmcnt(0)" ::: "memory");
    __syncthreads();
    if (b.leader) {
        unsigned* bar = b.bar;
        __builtin_amdgcn_s_waitcnt(0);
        unsigned nloc = b.st[0], nx = b.st[1];
        if (nloc == 0u) { xcd_barrier_complete(bar, b.x, nloc, nx); b.st[0] = nloc; b.st[1] = nx; }
        const unsigned old = xb_add(&bar[XB_XSUB(b.x)], 1u);
        const unsigned gen = old / nloc;
        if (old + 1u == (gen + 1u) * nloc) {
            __builtin_amdgcn_fence(__ATOMIC_RELEASE, "agent");
            asm volatile("s_waitcnt vmcnt(0)" ::: "memory");
            const unsigned og = xb_add(&bar[XB_TOP], 1u);
            const unsigned tg = og / nx;
            if (og + 1u == (tg + 1u) * nx) xb_add(&bar[XB_TOPGEN], 1u);
            else XB_SPIN(xb_ld(&bar[XB_TOPGEN]) == tg, bar);
            __builtin_amdgcn_fence(__ATOMIC_ACQUIRE, "agent");
            xb_add(&bar[XB_XGEN(b.x)], 1u);
            asm volatile("s_waitcnt vmcnt(0)" ::: "memory");
        } else {
            XB_SPIN(xb_ld(&bar[XB_XGEN(b.x)]) == gen, bar);
            __builtin_amdgcn_fence(__ATOMIC_ACQUIRE, "agent");
            asm volatile("s_waitcnt vmcnt(0)" ::: "memory");
        }
    }
    __syncthreads();
}
__device__ __forceinline__ float wave_sum(float v) {
#pragma unroll
    for (int o = 1; o < 64; o <<= 1) v += __shfl_xor(v, o);
    return v;
}
__device__ __forceinline__ unsigned cvtpk_rne(float lo, float hi) { typedef float f2 __attribute__((ext_vector_type(2))); typedef __bf16 b2 __attribute__((ext_vector_type(2)));
    f2 v = {lo, hi}; b2 b = __builtin_convertvector(v, b2); return __builtin_bit_cast(unsigned, b); }
__device__ __forceinline__ void p0_transpose_item64(const float* W, int K, int N, bf16* WT, LAS unsigned* scr, int item, int lane) {
    const int nblk = N / 64, kb = item / nblk, nb = item % nblk, k0 = 64 * kb, n0 = 64 * nb;
    const int g = lane >> 4, q = lane & 15;
    const float* src = W + (size_t)(k0 + 2 * g) * N + n0 + 4 * q;
    f32x4 v[16];
#pragma unroll
    for (int i = 0; i < 16; ++i) v[i] = *(const GAS f32x4*)(src + (size_t)(8 * (i >> 1) + (i & 1)) * N);
#pragma unroll
    for (int j = 0; j < 8; ++j)
#pragma unroll
        for (int e = 0; e < 4; ++e) scr[(4 * q + e) * 33 + 4 * j + g] = cvtpk_rne(v[2 * j][e], v[2 * j + 1][e]);
    LDS_WAIT(); asm volatile("" ::: "memory");
    const int c = lane & 7, nr = lane >> 3;
#pragma unroll
    for (int jj = 0; jj < 8; ++jj) { const int n = nr + 8 * jj; const LAS unsigned* s = scr + n * 33 + 4 * c;
        v4u o; o.x = s[0]; o.y = s[1]; o.z = s[2]; o.w = s[3];
        *(GAS v4u*)(WT + (size_t)(n0 + n) * K + k0 + 8 * c) = o; }
    LDS_WAIT(); asm volatile("" ::: "memory");
}


constexpr int NWAVES = 8;
constexpr int BATCH = 4, SEQ = 2048, DM = 2048, TOK = BATCH * SEQ, PW = 6144, DFF = 8192, HD = 128, DEPTH = 2;
constexpr int NHA = 6, NHB = 4, NHC = 6;
constexpr int COL_QA = 0, COL_KA = 768, COL_VA = 1536, COL_QB = 2304, COL_KB = 2816, COL_VB = 3328, COL_QC = 3840, COL_KC = 4608, COL_VC = 5376;
constexpr int MIX_A = 0, MIX_B = 768, MIX_C = 1280;
constexpr float EPS = 1e-6f;

constexpr size_t MiB = 1u << 20;
constexpr size_t WS_CTL = 0, CTL_ZERO_BYTES = 1 * MiB;
constexpr size_t WS_LUT = 1 * MiB;
constexpr size_t WS_SS = 459 * MiB;
constexpr size_t WS_WIN = 2 * MiB, WS_WOUT = 50 * MiB, WS_W1 = 66 * MiB, WS_W2 = 130 * MiB;
constexpr size_t WS_XB = 194 * MiB;
constexpr size_t WS_QKV = 226 * MiB;
constexpr size_t WS_MIX = 322 * MiB;
constexpr size_t WS_H = 226 * MiB;
constexpr size_t WS_PA = 354 * MiB;
constexpr size_t WS_LSE = 426 * MiB;
constexpr size_t WS_PB = 427 * MiB;
constexpr size_t WS_END = 460 * MiB;
constexpr int CW_BAR = 4096;
constexpr int CW_QUEUE = 8192;

constexpr int RING_OFF = 0, RING_BYTES = 131072;
constexpr int LDSCTL_OFF = RING_BYTES, MISC_OFF = LDSCTL_OFF + 320;
constexpr int LDS_BYTES = 147456;

struct Frame {
    LAS unsigned char* lds;
    volatile LAS unsigned* MISC;
    gu32* ctl;
    int tid, lane, wave, vcu, G;
};

namespace att {
typedef short bf16x8 __attribute__((ext_vector_type(8)));
typedef short s16x4 __attribute__((ext_vector_type(4)));
typedef float f32x16 __attribute__((ext_vector_type(16)));
typedef unsigned u32x4 __attribute__((ext_vector_type(4)));
typedef short v4i16_t __attribute__((ext_vector_type(4)));
constexpr int QP = PW;
constexpr int VPB = 320;
constexpr int VBYTES = 32 * VPB;

__device__ __forceinline__ int crow(int r, int hi) { return (r & 3) + 8 * (r >> 2) + 4 * hi; }
__device__ __forceinline__ unsigned cvtpk(float lo, float hi) { typedef float f2 __attribute__((ext_vector_type(2))); typedef __bf16 b2 __attribute__((ext_vector_type(2)));
    f2 v = {lo, hi}; b2 b = __builtin_convertvector(v, b2); return __builtin_bit_cast(unsigned, b); }
__device__ __forceinline__ s16x4 vtr(LAS const unsigned char* p) { return __builtin_bit_cast(s16x4, __builtin_amdgcn_ds_read_tr16_b64_v4i16((LAS v4i16_t*)p)); }

template <int NKS> __device__ __forceinline__ f32x16 qk_tile(const bf16x8 (&qf)[NKS], const bf16* krow) {
    bf16x8 kf[NKS];
#pragma unroll
    for (int ks = 0; ks < NKS; ++ks) kf[ks] = *(const bf16x8*)(krow + 16 * ks);
    f32x16 st = {0.f, 0.f, 0.f, 0.f, 0.f, 0.f, 0.f, 0.f, 0.f, 0.f, 0.f, 0.f, 0.f, 0.f, 0.f, 0.f};
#pragma unroll
    for (int ks = 0; ks < NKS; ++ks) st = __builtin_amdgcn_mfma_f32_32x32x16_bf16(kf[ks], qf[ks], st, 0, 0, 0);
    return st;
}
constexpr int VBLK = 1088;
#ifndef NT_DIFF
#define NT_DIFF 1
#endif
#ifndef NT_DIL
#define NT_DIL 1
#endif
constexpr int NT_OFF = 8 * VBLK;
__device__ __forceinline__ void dma_v(LAS unsigned char* vl, const bf16* Vb, int tk0, int tks, int lane) {
    const bf16* p = Vb + (size_t)(tk0 + 8 * tks * (lane >> 4)) * QP + (lane & 15) * 8; const size_t step = (size_t)tks * QP;
#pragma unroll
    for (int i = 0; i < 8; ++i) { __builtin_amdgcn_global_load_lds((const unsigned*)p, (LAS unsigned*)(vl + i * VBLK), 16, 0, 0); p += step; }
}
#ifndef DMA_WAIT_EXTRA
#define DMA_WAIT_EXTRA ""
#endif
__device__ __forceinline__ void dma_wait() { asm volatile("s_waitcnt vmcnt(0)" DMA_WAIT_EXTRA ::: "memory"); }
__device__ __forceinline__ void mfma_acc(f32x16& acc, const bf16x8& a, const bf16x8& b) { asm volatile("s_nop 1\n\tv_mfma_f32_32x32x16_bf16 %0, %1, %2, %0" : "+v"(acc) : "v"(a), "v"(b)); }
#ifndef PV_ASM
#define PV_ASM 0
#endif
#if PV_ASM
#define PV_MFMA(acc, a, b) (mfma_acc(acc, a, b), acc)
#else
#define PV_MFMA(acc, a, b) __builtin_amdgcn_mfma_f32_32x32x16_bf16(a, b, acc, 0, 0, 0)
#endif
__device__ __forceinline__ void pv_settle(f32x16 (&o)[4]) { asm volatile("s_nop 15\n\ts_nop 7" : "+v"(o[0]), "+v"(o[1]), "+v"(o[2]), "+v"(o[3])); }
__device__ __forceinline__ void pv_tile(f32x16 (&o)[4], const bf16x8 (&pa)[2], LAS const unsigned char* vl, int lane) {
    const int hi = lane >> 5, g1 = (lane >> 4) & 1, i = lane & 15;
    LAS const unsigned char* base = vl + (4 * hi + (i >> 2)) * VBLK + (16 * g1 + 4 * (i & 3)) * 2;
    s16x4 lo[8], hh[8];
#pragma unroll
    for (int db = 0; db < 4; ++db)
#pragma unroll
        for (int s = 0; s < 2; ++s) { lo[2 * db + s] = vtr(base + s * 512 + db * 64); hh[2 * db + s] = vtr(base + s * 512 + 256 + db * 64); }
#pragma unroll
    for (int db = 0; db < 4; ++db)
#pragma unroll
        for (int s = 0; s < 2; ++s) { const s16x4 a = lo[2 * db + s], b = hh[2 * db + s];
            const bf16x8 vf = {a[0], a[1], a[2], a[3], b[0], b[1], b[2], b[3]};
            o[db] = PV_MFMA(o[db], pa[s], vf); }
}

constexpr float LOG2E = 1.4426950408889634f;
constexpr float THR2 = 6.0f;
__device__ __forceinline__ float ex2(float x) { return __builtin_amdgcn_exp2f(x); }
__device__ __forceinline__ float lg2(float x) { return __builtin_amdgcn_logf(x); }
__device__ __forceinline__ constexpr int ccol(int r) { return (r & 3) + 8 * (r >> 2); }

#ifndef LOADK_DRAIN
#define LOADK_DRAIN 0
#endif
__device__ __forceinline__ float xhalf(float v, int hi) { const auto rr = __builtin_amdgcn_permlane32_swap(__float_as_uint(v), __float_as_uint(v), false, false); return __uint_as_float(hi ? rr[0] : rr[1]); }
template <int NKS> __device__ __forceinline__ void load_k(bf16x8 (&kf)[NKS], const bf16* krow) {
#pragma unroll
    for (int ks = 0; ks < NKS; ++ks) kf[ks] = *(const bf16x8*)(krow + 16 * ks);
    if (LOADK_DRAIN) asm volatile("s_waitcnt vmcnt(0)" ::: "memory");
}
template <int NKS> __device__ __forceinline__ f32x16 qk_mma(const bf16x8 (&kf)[NKS], const bf16x8 (&qf)[NKS]) {
    f32x16 st = {0.f, 0.f, 0.f, 0.f, 0.f, 0.f, 0.f, 0.f, 0.f, 0.f, 0.f, 0.f, 0.f, 0.f, 0.f, 0.f};
#pragma unroll
    for (int ks = 0; ks < NKS; ++ks) st = __builtin_amdgcn_mfma_f32_32x32x16_bf16(kf[ks], qf[ks], st, 0, 0, 0);
    return st;
}
__device__ __forceinline__ void pack_p(bf16x8 (&pa)[2], const float (&t)[16]) {
    u32x4 w0 = {cvtpk(t[0], t[1]), cvtpk(t[2], t[3]), cvtpk(t[4], t[5]), cvtpk(t[6], t[7])}, w1 = {cvtpk(t[8], t[9]), cvtpk(t[10], t[11]), cvtpk(t[12], t[13]), cvtpk(t[14], t[15])};
    pa[0] = __builtin_bit_cast(bf16x8, w0); pa[1] = __builtin_bit_cast(bf16x8, w1);
}
constexpr float GROW_MAX = 64.0f;
template <bool SAFE> __device__ __forceinline__ bool sm_tile(float (&xm)[16], bool set_ref, float& m2, float& l, f32x16 (&o)[4], bf16x8 (&pa)[2], int hi) {
    float a = fmaxf(fmaxf(xm[0], xm[1]), fmaxf(xm[2], xm[3])), b = fmaxf(fmaxf(xm[4], xm[5]), fmaxf(xm[6], xm[7]));
    a = fmaxf(a, fmaxf(fmaxf(xm[8], xm[9]), fmaxf(xm[10], xm[11]))); b = fmaxf(b, fmaxf(fmaxf(xm[12], xm[13]), fmaxf(xm[14], xm[15])));
    float mt = fmaxf(a, b); mt = fmaxf(mt, xhalf(mt, hi));
    bool ovf = false;
    if (set_ref) {
        m2 += mt;
#pragma unroll
        for (int r = 0; r < 16; ++r) xm[r] -= mt;
    } else if (!SAFE) { ovf = __any(mt > GROW_MAX); }
    else if (__any(mt > 0.f)) {
        const float d = fmaxf(mt, 0.f), alpha = ex2(-d); m2 += d; l *= alpha;
#pragma unroll
        for (int r = 0; r < 16; ++r) xm[r] -= d;
        float f[16];
#pragma unroll
        for (int r = 0; r < 16; ++r) f[r] = __shfl(alpha, crow(r, hi));
        asm volatile("s_waitcnt lgkmcnt(0)" : "+v"(f[0]), "+v"(f[1]), "+v"(f[2]), "+v"(f[3]), "+v"(f[4]), "+v"(f[5]), "+v"(f[6]), "+v"(f[7]), "+v"(f[8]), "+v"(f[9]), "+v"(f[10]), "+v"(f[11]), "+v"(f[12]), "+v"(f[13]), "+v"(f[14]), "+v"(f[15]));
#pragma unroll
        for (int r = 0; r < 16; ++r)
#pragma unroll
            for (int db = 0; db < 4; ++db) o[db][r] *= f[r];
    }
    float ls = 0.f;
#pragma unroll
    for (int r = 0; r < 16; ++r) { xm[r] = ex2(xm[r]); ls += xm[r]; }
    l += ls;
    pack_p(pa, xm);
    return ovf;
}
__device__ __forceinline__ void store_o_bf16(const f32x16 (&o)[4], float fq  , bool use_f, bf16* Ob, int tok0, int tstride, int pitch, LAS unsigned char* vl, int lane) {
    const int qi = lane & 31, hi = lane >> 5;
#pragma unroll
    for (int r = 0; r < 16; ++r) { const int qq = crow(r, hi); const float f = use_f ? __shfl(fq, qq) : 1.0f;
#pragma unroll
        for (int db = 0; db < 4; ++db) *(LAS unsigned short*)(vl + qq * VPB + (32 * db + qi) * 2) = (unsigned short)(cvtpk(o[db][r] * f, 0.f) & 0xffffu); }
    asm volatile("s_waitcnt lgkmcnt(0)" ::: "memory");
#pragma unroll
    for (int i = 0; i < 8; ++i) { const int row = 4 * i + (lane >> 4); const u32x4 v = *(LAS const u32x4*)(vl + row * VPB + (lane & 15) * 16);
        *(u32x4*)(Ob + (size_t)(tok0 + tstride * row) * pitch + (lane & 15) * 8) = v; }
    asm volatile("s_waitcnt lgkmcnt(0)" ::: "memory");
}

template <bool SAFE> __device__ __forceinline__ bool diff_item(const bf16* Qb, const bf16* Kb, const bf16* Vb, int qt, const float* lut2, const int* thrtab, bf16* Ob, LAS unsigned char* vl, int lane_in) {
    int lane = lane_in; asm volatile("" : "+v"(lane));
    const int qi = lane & 31, hi = lane >> 5; const float c1 = 0.125f * LOG2E;
    bf16x8 qf[4]; load_k<4>(qf, Qb + (size_t)(32 * qt + qi) * QP + 8 * hi);
    f32x16 o[4];
#pragma unroll
    for (int db = 0; db < 4; ++db)
#pragma unroll
        for (int r = 0; r < 16; ++r) o[db][r] = 0.f;
    float m2 = 0.f, l = 0.f; bool ovf = false;
    bf16x8 kf[4];
    load_k<4>(kf, Kb + (size_t)qi * QP + 8 * hi);
    int thrL = thrtab[lane]; float b0L = lut2[32 * lane - 31 < 0 ? 0 : 32 * lane - 31], b1L = lut2[32 * lane + 31];
    LAS float* NT = (LAS float*)(vl + NT_OFF);
#pragma unroll
    for (int i = 0; i < 4; ++i) { const int idx = 64 * i + lane; NT[idx] = lut2[idx < 32 ? 0 : idx - 32]; }
    asm volatile("s_waitcnt vmcnt(0) lgkmcnt(0)" : "+v"(thrL), "+v"(b0L), "+v"(b1L) :: "memory");
#pragma nounroll
    for (int kt = 0; kt <= qt; ++kt) {
        const int D = qt - kt, ktn = kt < qt ? kt + 1 : qt;
        const int thr = __builtin_amdgcn_readlane(thrL, D);
        float xm[16]; bf16x8 pa[2];
        if (thr < 0) {
            const LAS float* nt = NT + (32 * D + qi - 4 * hi + 32 - 27);
            float bias[16];
#pragma unroll
            for (int r = 0; r < 16; ++r) bias[r] = nt[27 - ccol(r)];
            asm volatile("s_waitcnt lgkmcnt(0)" : "+v"(bias[0]), "+v"(bias[1]), "+v"(bias[2]), "+v"(bias[3]), "+v"(bias[4]), "+v"(bias[5]), "+v"(bias[6]), "+v"(bias[7]), "+v"(bias[8]), "+v"(bias[9]), "+v"(bias[10]), "+v"(bias[11]), "+v"(bias[12]), "+v"(bias[13]), "+v"(bias[14]), "+v"(bias[15]) :: "memory");
            const f32x16 st = qk_mma<4>(kf, qf);
            dma_v(vl, Vb, 32 * kt, 1, lane);
            load_k<4>(kf, Kb + (size_t)(32 * ktn + qi) * QP + 8 * hi);
#pragma unroll
            for (int r = 0; r < 16; ++r) xm[r] = st[r] * c1 + (bias[r] - m2);
            if (D == 0) {
#pragma unroll
                for (int r = 0; r < 16; ++r) xm[r] = (crow(r, hi) <= qi) ? xm[r] : -INFINITY;
            }
        } else {
            const float b0m = __builtin_bit_cast(float, __builtin_amdgcn_readlane(__builtin_bit_cast(int, b0L), D)) - m2, b1m = __builtin_bit_cast(float, __builtin_amdgcn_readlane(__builtin_bit_cast(int, b1L), D)) - m2; const int y2 = 32 * D + qi - thr - 4 * hi;
            const f32x16 st = qk_mma<4>(kf, qf);
            dma_v(vl, Vb, 32 * kt, 1, lane);
            load_k<4>(kf, Kb + (size_t)(32 * ktn + qi) * QP + 8 * hi);
#pragma unroll
            for (int r = 0; r < 16; ++r) xm[r] = st[r] * c1 + ((ccol(r) <= y2) ? b1m : b0m);
        }
        ovf |= sm_tile<SAFE>(xm, kt == 0, m2, l, o, pa, hi);
        dma_wait();
        pv_tile(o, pa, vl, lane);
    }
    pv_settle(o);
    const float lt = l + xhalf(l, hi);
    store_o_bf16(o, 1.0f / lt, true, Ob, 32 * qt, 1, 512, vl, lane);
    return ovf;
}

template <bool SAFE> __device__ __forceinline__ bool dil_item(const bf16* Qb, const bf16* Kb, const bf16* Vb, int dil, int rr, int n32, const float* lut2, bf16* Ob, float* lseb, LAS unsigned char* vl, int lane_in) {
    int lane = lane_in; asm volatile("" : "+v"(lane));
    const int qi = lane & 31, hi = lane >> 5; const float c1 = 0.08838834764831845f * LOG2E;
    const int tq0 = 32 * n32 * dil + rr;
    bf16x8 qf[8]; load_k<8>(qf, Qb + (size_t)(tq0 + qi * dil) * QP + 8 * hi);
    f32x16 o[4];
#pragma unroll
    for (int db = 0; db < 4; ++db)
#pragma unroll
        for (int r = 0; r < 16; ++r) o[db][r] = 0.f;
    float m2 = 0.f, l = 0.f; bool ovf = false;
    const int kt_lo = n32 >= 4 ? 0 : 4 - n32;
    LAS float* NT = (LAS float*)(vl + NT_OFF);
#pragma unroll
    for (int i = 0; i < 4; ++i) { const int idx = 64 * i + lane; int dl = (idx - 32) * dil; dl = dl < 0 ? 0 : (dl > 2047 ? 2047 : dl); NT[idx] = lut2[dl]; }
    asm volatile("s_waitcnt vmcnt(0) lgkmcnt(0)" ::: "memory");
#pragma nounroll
    for (int kt = kt_lo; kt <= 4; ++kt) {
        const int tkc = 32 * (n32 - 4 + kt) * dil + rr;
        const LAS float* nt = NT + (128 - 32 * kt + qi - 4 * hi + 32 - 27);
        float bias[16];
#pragma unroll
        for (int r = 0; r < 16; ++r) bias[r] = nt[27 - ccol(r)];
        asm volatile("s_waitcnt lgkmcnt(0)" : "+v"(bias[0]), "+v"(bias[1]), "+v"(bias[2]), "+v"(bias[3]), "+v"(bias[4]), "+v"(bias[5]), "+v"(bias[6]), "+v"(bias[7]), "+v"(bias[8]), "+v"(bias[9]), "+v"(bias[10]), "+v"(bias[11]), "+v"(bias[12]), "+v"(bias[13]), "+v"(bias[14]), "+v"(bias[15]) :: "memory");
        bf16x8 kf[8]; load_k<8>(kf, Kb + (size_t)(tkc + qi * dil) * QP + 8 * hi);
        dma_v(vl, Vb, tkc, dil, lane);
        const f32x16 st = qk_mma<8>(kf, qf);
        float xm[16]; bf16x8 pa[2];
#pragma unroll
        for (int r = 0; r < 16; ++r) xm[r] = st[r] * c1 + (bias[r] - m2);
        if (kt == 0) {
#pragma unroll
            for (int r = 0; r < 16; ++r) xm[r] = (crow(r, hi) >= qi) ? xm[r] : -INFINITY;
        }
        if (kt == 4) {
#pragma unroll
            for (int r = 0; r < 16; ++r) xm[r] = (crow(r, hi) <= qi) ? xm[r] : -INFINITY;
        }
        ovf |= sm_tile<SAFE>(xm, kt == kt_lo, m2, l, o, pa, hi);
        dma_wait();
        pv_tile(o, pa, vl, lane);
    }
    pv_settle(o);
    const float lt = l + xhalf(l, hi);
    if (lane < 32) lseb[(size_t)(tq0 + qi * dil) * 6] = m2 + lg2(lt);
    store_o_bf16(o, 1.0f / lt, true, Ob, tq0, dil, 768, vl, lane);
    return ovf;
}

__device__ __forceinline__ void stick_item(const bf16* Qb, const bf16* Kb, const bf16* Vb, int qt, bf16* Ob, LAS unsigned char* vl, int lane_in) {
    int lane = lane_in; asm volatile("" : "+v"(lane));
    const int qi = lane & 31, hi = lane >> 5; const float c1 = 0.08838834764831845f * LOG2E;
    bf16x8 qf[8]; load_k<8>(qf, Qb + (size_t)(32 * qt + qi) * QP + 8 * hi);
    f32x16 o[4];
#pragma unroll
    for (int db = 0; db < 4; ++db)
#pragma unroll
        for (int r = 0; r < 16; ++r) o[db][r] = 0.f;
    float R = 0.f;
    bf16x8 kf[8];
    load_k<8>(kf, Kb + (size_t)(32 * qt + qi) * QP + 8 * hi);
#pragma nounroll
    for (int kt = qt; kt >= 0; --kt) {
        const int ktn = kt > 0 ? kt - 1 : 0;
        const f32x16 st = qk_mma<8>(kf, qf);
        dma_v(vl, Vb, 32 * kt, 1, lane);
        load_k<8>(kf, Kb + (size_t)(32 * ktn + qi) * QP + 8 * hi);
        float u[16], zl[16];
#pragma unroll
        for (int r = 0; r < 16; ++r) { const float z = st[r] * c1; const float sp = fmaxf(z, 0.f) + lg2(1.0f + ex2(-fabsf(z)));
            u[r] = -sp; zl[r] = z - sp; }
        if (kt == qt) {
#pragma unroll
            for (int r = 0; r < 16; ++r) { const bool v = crow(r, hi) < qi; u[r] = v ? u[r] : 0.f; zl[r] = v ? zl[r] : -INFINITY; }
        }
        float gs[4], pg[4], tot[4], aft[4];
#pragma unroll
        for (int c = 0; c < 4; ++c) { gs[c] = (u[4 * c] + u[4 * c + 1]) + (u[4 * c + 2] + u[4 * c + 3]); pg[c] = xhalf(gs[c], hi); tot[c] = gs[c] + pg[c]; }
        aft[3] = (hi == 0) ? pg[3] : 0.f;
        aft[2] = tot[3] + ((hi == 0) ? pg[2] : 0.f);
        aft[1] = tot[3] + tot[2] + ((hi == 0) ? pg[1] : 0.f);
        aft[0] = tot[3] + tot[2] + tot[1] + ((hi == 0) ? pg[0] : 0.f);
        float a[16];
#pragma unroll
        for (int c = 0; c < 4; ++c) { const float b = R + aft[c];
            const float s2 = u[4 * c + 3], s1 = s2 + u[4 * c + 2], s0 = s1 + u[4 * c + 1];
            a[4 * c + 3] = ex2(zl[4 * c + 3] + b); a[4 * c + 2] = ex2(zl[4 * c + 2] + (b + s2));
            a[4 * c + 1] = ex2(zl[4 * c + 1] + (b + s1)); a[4 * c + 0] = ex2(zl[4 * c + 0] + (b + s0)); }
        R += (tot[0] + tot[1]) + (tot[2] + tot[3]);
        bf16x8 pa[2]; pack_p(pa, a);
        dma_wait();
        pv_tile(o, pa, vl, lane);
        if (__all(R < -150.0f)) break;
    }
    pv_settle(o);
    store_o_bf16(o, 1.0f, false, Ob, 32 * qt, 1, DM, vl, lane);
}
}

__device__ __forceinline__ void row_prep(const float* xrow, const float* g, bf16* orow, float* ss, int lane) {
    const GAS f32x4* xr = (const GAS f32x4*)xrow + lane; const GAS f32x4* gr = (const GAS f32x4*)g + lane;
    f32x4 v[8]; float s = 0.f;
#pragma unroll
    for (int j = 0; j < 8; ++j) { v[j] = xr[64 * j]; s += (v[j].x * v[j].x + v[j].y * v[j].y) + (v[j].z * v[j].z + v[j].w * v[j].w); }
    s = wave_sum(s);
    GAS unsigned long long* o8 = (GAS unsigned long long*)orow + lane;
#pragma unroll
    for (int j = 0; j < 8; ++j) { const f32x4 y = v[j] * gr[64 * j]; o8[64 * j] = (unsigned long long)cvtpk_rne(y.x, y.y) | ((unsigned long long)cvtpk_rne(y.z, y.w) << 32); }
    if (lane < 32) ss[lane] = lane == 0 ? s : 0.f;
}
__device__ __forceinline__ int t5_bucket(int n) {
    if (n < 16) return n;
    const int v = 16 + (int)(logf((float)n / 16.0f) / 4.852030263919617f * 16.0f);
    return v < 31 ? v : 31;
}

constexpr int I_IN = (DM / 64) * (PW / 64), I_OUT = (DM / 64) * (DM / 64), I_1 = (DM / 64) * (DFF / 64), I_2 = (DFF / 64) * (DM / 64);
struct Args { const float* in[14]; float* out; unsigned char* ws; int ph_lo, ph_hi, use_bar, pad; };
constexpr int PPL = 6;
constexpr int N_PHASES = 1 + PPL * DEPTH + 1;
#ifndef PROBE_MASK
#define PROBE_MASK 0
#endif
#ifndef PROBE_VAR
#define PROBE_VAR 0
#endif
#ifndef PROBE_DUP
#define PROBE_DUP -1
#endif
constexpr int N_STEPS = N_PHASES + (PROBE_DUP < 0 ? 0 : (PROBE_DUP == 100 ? 1 : 2));
__device__ __forceinline__ int step_phase(int i) {
    if (PROBE_DUP < 0) return i;
    if (PROBE_DUP == 100) return i == 0 ? 0 : i - 1;
    const int A = 1 + PROBE_DUP, B = 1 + PPL + PROBE_DUP;
    if (i <= A) return i; if (i == A + 1) return A; if (i <= B + 1) return i - 1; if (i == B + 2) return B; return i - 2;
}

__global__ void __launch_bounds__(NWAVES * 64, 2) fwd_kernel(Args args) {
    extern __shared__ __attribute__((aligned(16))) unsigned char lds_raw[];
    Frame F;
    F.lds = (LAS unsigned char*)lds_raw;
    F.MISC = (volatile LAS unsigned*)(F.lds + MISC_OFF);
    F.tid = threadIdx.x; F.lane = F.tid & 63; F.wave = __builtin_amdgcn_readfirstlane(F.tid >> 6);
    F.G = gridDim.x; { const int bx = blockIdx.x; F.vcu = (F.G % 8 == 0) ? (bx % 8) * (F.G / 8) + bx / 8 : bx; }
    F.ctl = (gu32*)(args.ws + WS_CTL);
    for (int u = F.tid; u < (LDS_BYTES - LDSCTL_OFF) / 4; u += NWAVES * 64) ((LAS unsigned*)(F.lds + LDSCTL_OFF))[u] = 0u;
    __syncthreads();
    XcdBarrier bar; bar.bar = (unsigned*)(F.ctl + CW_BAR); bar.x = 0; bar.st = nullptr; bar.leader = false;
    if (args.use_bar) bar = xcd_barrier_post((unsigned*)(F.ctl + CW_BAR), F.MISC + 8);

    const int NGW = F.G * NWAVES;

    for (int step = args.ph_lo; step < args.ph_hi; ++step) {
        const int ph = step_phase(step);
        typedef const __attribute__((address_space(4))) Args* KArgs; KArgs ap = (KArgs)__builtin_amdgcn_kernarg_segment_ptr(); asm volatile("" : "+s"(ap));
        unsigned char* ws = ap->ws;
        const float* x_in = ap->in[0]; const float* w_in = ap->in[1]; const float* w_out = ap->in[2]; const float* g_attn = ap->in[3]; const float* g_mlp = ap->in[4];
        const float* w1 = ap->in[5]; const float* w2 = ap->in[6]; const float* rel_tab = ap->in[7];
        const float* lq1 = ap->in[8]; const float* lk1 = ap->in[9]; const float* lq2 = ap->in[10]; const float* lk2 = ap->in[11]; const float* subln_g = ap->in[12]; const float* g_final = ap->in[13];
        float* out = ap->out;
        bf16* WIN_T = (bf16*)(ws + WS_WIN); bf16* WOUT_T = (bf16*)(ws + WS_WOUT); bf16* W1_T = (bf16*)(ws + WS_W1); bf16* W2_T = (bf16*)(ws + WS_W2);
        bf16* XB = (bf16*)(ws + WS_XB); bf16* QKV = (bf16*)(ws + WS_QKV); bf16* MIX = (bf16*)(ws + WS_MIX); bf16* HB = (bf16*)(ws + WS_H);
        float* SS = (float*)(ws + WS_SS); bf16* PAH = (bf16*)(ws + WS_PA); float* LSE = (float*)(ws + WS_LSE); bf16* PBH = (bf16*)(ws + WS_PB); float* LUT = (float*)(ws + WS_LUT);
        int lane = (int)__builtin_amdgcn_mbcnt_hi(~0u, __builtin_amdgcn_mbcnt_lo(~0u, 0u)); asm volatile("" : "+v"(lane));
        const int wave = F.wave, tid = wave * 64 + lane, gw = F.vcu * NWAVES + wave;
        const int l = ph > 0 ? (ph - 1) / PPL : 0, pt = (ph > 0 && ph <= PPL * DEPTH) ? (ph - 1) % PPL : (ph == 0 ? -1 : 100);
        if (pt == 0 || pt == 3 || pt == 4 || pt == 5) {
            pg8::Gemm g; pg8::EpiAny E; int N;
            E.O = nullptr; E.base = nullptr; E.out = nullptr; E.ss_in = SS; E.ss_out = SS; E.xb = nullptr; E.g = nullptr; E.baseb = nullptr; E.gprev = nullptr;
            if (pt == 0)      { g.A = XB;  g.Bt = WIN_T + (size_t)l * PW * DM;  N = PW;  g.K = DM;  E.mode = 0; E.O = QKV; E.ldc = PW; }
            else if (pt == 3) { g.A = MIX; g.Bt = WOUT_T + (size_t)l * DM * DM; N = DM;  g.K = DM;  E.mode = 2; E.ldc = DM;
                                if (l == 0) E.base = x_in; else { E.baseb = XB; E.gprev = g_attn + (size_t)l * DM; }
                                E.xb = XB; E.g = g_mlp + (size_t)l * DM; }
            else if (pt == 4) { g.A = XB;  g.Bt = W1_T + (size_t)l * DFF * DM;  N = DFF; g.K = DM;  E.mode = 1; E.O = HB; E.ldc = DFF; }
            else              { g.A = HB;  g.Bt = W2_T + (size_t)l * DM * DFF;  N = DM;  g.K = DFF; E.mode = 2; E.ldc = DM; E.baseb = XB; E.gprev = g_mlp + (size_t)l * DM;
                                if (l + 1 < DEPTH) { E.xb = XB; E.g = g_attn + (size_t)(l + 1) * DM; } else E.out = out; }
            g.M = TOK; g.N = N; E.perm = (E.mode != 2);
            pg8::StaticOrder S; S.init(TOK, N, F.G, (int)blockIdx.x);
            pg8::gemm_phase<pg8::EpiAny, pg8::StaticOrder, true, true>(F.lds + RING_OFF, g, S, E, tid);
        } else if (ph == 0) {
            LAS unsigned* scr = (LAS unsigned*)(F.lds + RING_OFF + wave * 16384);
            for (int it = gw; it < I_IN; it += NGW) p0_transpose_item64(w_in, DM, PW, WIN_T, scr, it, lane);
            for (int i = blockIdx.x * (NWAVES * 64) + tid; i < 10 * 2048; i += F.G * NWAVES * 64) { const int h = i >> 11, d = i & 2047; LUT[i] = rel_tab[t5_bucket(d) * 10 + h] * att::LOG2E; }
            if (blockIdx.x == 0 && tid < 64) {
                const int D = tid, dlo = 32 * D - 31 < 0 ? 0 : 32 * D - 31, dhi = 32 * D + 31, bl = t5_bucket(dlo), bh = t5_bucket(dhi); int thr = -1;
                if (D > 0 && bl == bh) thr = 1 << 30;
                else if (D > 0 && bh == bl + 1) { thr = dhi; for (int d = dhi; d >= dlo; --d) if (t5_bucket(d) == bh) thr = d; }
                ((int*)(LUT + 10 * 2048))[D] = thr;
            }
            for (int m = gw; m < TOK; m += NGW) row_prep(x_in + (size_t)m * DM, g_attn, XB + (size_t)m * DM, SS + (size_t)m * 32, lane);
        } else if (pt == 1) {
            LAS unsigned char* vl = F.lds + RING_OFF + wave * att::VBYTES;
            const int* thrtab = (const int*)(LUT + 10 * 2048);
            const int skip = (PROBE_DUP == 1 && (step == 2 || step == 3 + PPL)) ? PROBE_MASK : 0;
            for (int s = gw; s < ((skip & 1) ? 0 : 2048); s += NGW) {
                const int combo = s >> 6, j = s & 63, x = 4 * (j >> 3) + (j & 3), qt = (j & 4) ? x : 63 - x, b = combo >> 3, vh = combo & 7, h = vh >> 1, p = vh & 1;
                const bf16* base = QKV + (size_t)b * SEQ * PW;
                const bf16 *qp = base + COL_QB + h * HD + p * 64, *kp = base + COL_KB + h * HD + p * 64, *vp = base + COL_VB + h * HD; bf16* op = PBH + ((size_t)p * TOK + (size_t)b * SEQ) * 512 + h * HD;
                if (att::diff_item<false>(qp, kp, vp, qt, LUT + (6 + h) * 2048, thrtab, op, vl, lane)) att::diff_item<true>(qp, kp, vp, qt, LUT + (6 + h) * 2048, thrtab, op, vl, lane);
            }
            const int nq = (F.G % 8 == 0) ? 8 : 1, xq = F.vcu / (F.G / nq);
            gu32* qctr = F.ctl + CW_QUEUE + 64 * (8 * step + xq);
            for (;;) {
                unsigned idx = 0; if (lane == 0) idx = __hip_atomic_fetch_add(qctr, 1u, __ATOMIC_RELAXED, __HIP_MEMORY_SCOPE_AGENT);
                idx = (unsigned)__builtin_amdgcn_readfirstlane((int)idx) * (unsigned)nq + (unsigned)xq;
                const unsigned ncv = (unsigned)((l == 0 ? I_OUT + I_1 + I_2 + I_IN : I_OUT + I_1 + I_2) / 2);
                if (idx >= 768u + 1152u + ncv) break;
                if (idx >= 768u + 1152u) {
                    LAS unsigned* scr = (LAS unsigned*)vl;
                    for (int rep = 0; rep < 2; ++rep) { int r = 2 * (int)(idx - 1920u) + rep; const float* W; bf16* WT; int K, N;
                        if (r < I_OUT) { W = w_out + (size_t)l * DM * DM; WT = WOUT_T + (size_t)l * DM * DM; K = DM; N = DM; }
                        else if ((r -= I_OUT) < I_1) { W = w1 + (size_t)l * DM * DFF; WT = W1_T + (size_t)l * DFF * DM; K = DM; N = DFF; }
                        else if ((r -= I_1) < I_2) { W = w2 + (size_t)l * DFF * DM; WT = W2_T + (size_t)l * DM * DFF; K = DFF; N = DM; }
                        else { r -= I_2; W = w_in + (size_t)(l + 1) * DM * PW; WT = WIN_T + (size_t)(l + 1) * PW * DM; K = DM; N = PW; }
                        p0_transpose_item64(W, K, N, WT, scr, r, lane); }
                    continue;
                }
                if (idx < 768u) { if (skip & 2) continue;
                    const int bh = (int)idx >> 5, jj = (int)idx & 31, b = bh / 6, h = bh % 6; const bf16* base = QKV + (size_t)b * SEQ * PW;
#pragma nounroll
                    for (int rep = 0; rep < 2; ++rep)
                        att::stick_item(base + COL_QC + h * HD, base + COL_KC + h * HD, base + COL_VC + h * HD, 63 - (2 * jj + rep), MIX + (size_t)b * SEQ * DM + MIX_C + h * HD, vl, lane);
                } else { if (skip & 4) continue;
                    const int i2 = (int)idx - 768, p = i2 / 384, rem = i2 % 384, bh = rem >> 4, j4 = rem & 15, b = bh / 6, h = bh % 6;
                    const int dil = p == 0 ? 1 : (p == 1 ? 4 : 16), tpr = 64 / dil;
                    const bf16* base = QKV + (size_t)b * SEQ * PW;
#pragma nounroll
                    for (int rep = 0; rep < 4; ++rep) { const int j = 4 * j4 + rep;
                        const bf16 *qp = base + COL_QA + h * HD, *kp = base + COL_KA + h * HD, *vp = base + COL_VA + h * HD; bf16* op = PAH + ((size_t)p * TOK + (size_t)b * SEQ) * 768 + h * HD;
                        float* lp = LSE + ((size_t)p * TOK + (size_t)b * SEQ) * 6 + h;
                        if (att::dil_item<false>(qp, kp, vp, dil, j / tpr, j % tpr, LUT + h * 2048, op, lp, vl, lane)) att::dil_item<true>(qp, kp, vp, dil, j / tpr, j % tpr, LUT + h * 2048, op, lp, vl, lane); }
                }
            }
        } else if (pt == 2) {
            const float lam_init = 0.8f - 0.6f * expf(-0.3f * (float)l);
            const float s1 = wave_sum(lq1[l * 64 + lane] * lk1[l * 64 + lane]), s2 = wave_sum(lq2[l * 64 + lane] * lk2[l * 64 + lane]);
            const float lam = expf(s1) - expf(s2) + lam_init;
            const float gx = subln_g[l * HD + 2 * lane] * (1.0f - lam_init), gy = subln_g[l * HD + 2 * lane + 1] * (1.0f - lam_init);
            typedef float f32x2 __attribute__((ext_vector_type(2)));
            for (int tok = gw; tok < TOK; tok += NGW) {
                GAS unsigned* mrow = (GAS unsigned*)(MIX + (size_t)tok * DM);
#pragma unroll
                for (int h = 0; h < NHA; ++h) {
                    const float l0 = LSE[((size_t)0 * TOK + tok) * 6 + h], l1 = LSE[((size_t)1 * TOK + tok) * 6 + h], l2 = LSE[((size_t)2 * TOK + tok) * 6 + h];
                    const float mx = fmaxf(l0, fmaxf(l1, l2)); float w0 = att::ex2(l0 - mx), w1_ = att::ex2(l1 - mx), w2_ = att::ex2(l2 - mx); const float inv = 1.0f / (w0 + w1_ + w2_);
                    w0 *= inv; w1_ *= inv; w2_ *= inv;
                    const unsigned a = *(const GAS unsigned*)(PAH + ((size_t)0 * TOK + tok) * 768 + h * HD + 2 * lane), b = *(const GAS unsigned*)(PAH + ((size_t)1 * TOK + tok) * 768 + h * HD + 2 * lane),
                                   c = *(const GAS unsigned*)(PAH + ((size_t)2 * TOK + tok) * 768 + h * HD + 2 * lane);
                    const float ax = __uint_as_float(a << 16), ay = __uint_as_float(a & 0xffff0000u), bx = __uint_as_float(b << 16), by = __uint_as_float(b & 0xffff0000u), cx = __uint_as_float(c << 16), cy = __uint_as_float(c & 0xffff0000u);
                    mrow[(MIX_A + h * HD) / 2 + lane] = cvtpk_rne(w0 * ax + w1_ * bx + w2_ * cx, w0 * ay + w1_ * by + w2_ * cy);
                }
#pragma unroll
                for (int h = 0; h < NHB; ++h) {
                    const unsigned a = *(const GAS unsigned*)(PBH + ((size_t)0 * TOK + tok) * 512 + h * HD + 2 * lane), b = *(const GAS unsigned*)(PBH + ((size_t)1 * TOK + tok) * 512 + h * HD + 2 * lane);
                    const float ox = __uint_as_float(a << 16) - lam * __uint_as_float(b << 16), oy = __uint_as_float(a & 0xffff0000u) - lam * __uint_as_float(b & 0xffff0000u);
                    const float rstd = 1.0f / sqrtf(wave_sum(ox * ox + oy * oy) * (1.0f / HD) + EPS);
                    mrow[(MIX_B + h * HD) / 2 + lane] = cvtpk_rne(ox * rstd * gx, oy * rstd * gy);
                }
            }
        } else {
            for (int m = gw; m < TOK; m += NGW) { const float s = wave_sum(lane < 32 ? SS[(size_t)m * 32 + lane] : 0.f); const float rstd = 1.0f / sqrtf(s * (1.0f / DM) + EPS);
                GAS f32x4* o4 = (GAS f32x4*)(out + (size_t)m * DM) + lane; const GAS f32x4* gr = (const GAS f32x4*)g_final + lane;
#pragma unroll
                for (int j = 0; j < 8; ++j) o4[64 * j] = o4[64 * j] * rstd * gr[64 * j]; }
        }
        if (step + 1 < args.ph_hi) { XcdBarrier b2 = bar; unsigned* bb = bar.bar; asm volatile("" : "+s"(bb)); b2.bar = bb; b2.leader = (wave == 0 && lane == 0); xcd_barrier(b2); }
    }
}

#ifndef MK_PER_PHASE
#define MK_PER_PHASE 0
#endif
extern "C" void kernel_launch(void* const* d_in, const int* in_sizes, int n_in, void* d_out, int out_size, void* d_ws, size_t ws_size, hipStream_t stream) {
    static int grid = 0;
    if (grid == 0) {
        if (n_in != 14 || out_size != TOK * DM || ws_size < WS_END) { fprintf(stderr, "kernel_launch: unexpected shapes (n_in %d out %d ws %zu)\n", n_in, out_size, ws_size); grid = -1; return; }
        int dev = 0, cus = 0, per_cu = 0;
        if (hipGetDevice(&dev) != hipSuccess || hipDeviceGetAttribute(&cus, hipDeviceAttributeMultiprocessorCount, dev) != hipSuccess) { grid = -1; return; }
        if (hipFuncSetAttribute((const void*)fwd_kernel, hipFuncAttributeMaxDynamicSharedMemorySize, LDS_BYTES) != hipSuccess) { fprintf(stderr, "kernel_launch: hipFuncSetAttribute failed\n"); grid = -1; return; }
        if (hipOccupancyMaxActiveBlocksPerMultiprocessor(&per_cu, (const void*)fwd_kernel, NWAVES * 64, LDS_BYTES) != hipSuccess || per_cu < 1) { fprintf(stderr, "kernel_launch: occupancy query says %d blocks per CU\n", per_cu); grid = -1; (void)hipGetLastError(); return; }
        (void)hipGetLastError();
        grid = cus;
    }
    if (grid < 0) return;
    if (hipMemsetAsync((char*)d_ws + WS_CTL, 0, CTL_ZERO_BYTES, stream) != hipSuccess) return;
    Args a{};
    for (int i = 0; i < 14; ++i) a.in[i] = (const float*)d_in[i];
    a.out = (float*)d_out; a.ws = (unsigned char*)d_ws;
#if MK_PER_PHASE
    for (int ph = 0; ph < N_STEPS; ++ph) { a.ph_lo = ph; a.ph_hi = ph + 1; a.use_bar = 0; hipLaunchKernelGGL(fwd_kernel, dim3(grid), dim3(NWAVES * 64), LDS_BYTES, stream, a); }
#else
    a.ph_lo = 0; a.ph_hi = N_STEPS; a.use_bar = 1;
    void* kargs[] = {(void*)&a};
    const hipError_t le = hipLaunchCooperativeKernel((const void*)fwd_kernel, dim3(grid), dim3(NWAVES * 64), kargs, (unsigned)LDS_BYTES, stream);
    if (le != hipSuccess) fprintf(stderr, "kernel_launch: cooperative launch failed: %s (grid %d x %d threads, %d B LDS)\n", hipGetErrorName(le), grid, NWAVES * 64, LDS_BYTES);
#endif
}
```
